# Optimizing an MI355X kernel written in HIP

```python
import jax, jax.numpy as jnp
from jax import lax
import numpy as np

D_MODEL = 1024
BATCH = 8
SEQ = 4096
DEPTH = 2

GRID_W = 64
CTX_LEN = 256
D_MIX = D_MODEL
HEAD_DIM = 64
ATT_WIDTH = D_MIX // 2
RWKV_WIDTH = D_MIX - ATT_WIDTH
ATT_HEADS = ATT_WIDTH // HEAD_DIM
ATT_KV_HEADS = 2
ATT_GROUP = ATT_HEADS // ATT_KV_HEADS
ATT_KV_WIDTH = ATT_KV_HEADS * HEAD_DIM
WINDOW = 128
QBLK = 128
ROPE_BASE = 10000.0
ROPE_FREQS = HEAD_DIM // 4
RWKV_HEADS = RWKV_WIDTH // HEAD_DIM
LORA_DECAY = 64
LORA_ICLR = 64
LORA_VRES = 32
LORA_GATE = 128
N_DIRS = 2
ATT_COLS = ATT_WIDTH + 2 * ATT_KV_WIDTH
RWKV_COLS = 3 * RWKV_WIDTH + N_DIRS * (LORA_DECAY + LORA_ICLR) + LORA_GATE
IN_COLS = ATT_COLS + RWKV_COLS
ATT_SPLITS = (ATT_WIDTH, ATT_WIDTH + ATT_KV_WIDTH, ATT_COLS)
RWKV_SPLITS = (RWKV_WIDTH, 2 * RWKV_WIDTH, 3 * RWKV_WIDTH,
               3 * RWKV_WIDTH + N_DIRS * LORA_DECAY,
               3 * RWKV_WIDTH + N_DIRS * (LORA_DECAY + LORA_ICLR))
N_EXPERTS = 16
N_GROUPS = 4
EXPERTS_PER_GROUP = N_EXPERTS // N_GROUPS
TOP_K = 2
GROUP_SCORE_K = 2
D_EXPERT = D_MODEL
MOE_BLK = 256
NORM_EPS = 1e-6
GN_EPS = 64e-5
NEG_INF = -1e30
ATT_SCALE = HEAD_DIM ** -0.5

kernel_name = 'hybrid_swa_rwkv7_moe_prefix_dit'


def rmsnorm(x, g):
    xf = x.astype(jnp.float32)
    y = xf * lax.rsqrt(jnp.mean(xf * xf, axis=-1, keepdims=True) + NORM_EPS)
    return (y * g).astype(x.dtype)


def modulate(h, shift, scale):
    return h * (1.0 + scale) + shift


def axial_rope_tables(rows_count):
    row = jnp.repeat(jnp.arange(rows_count, dtype=jnp.float32), GRID_W)
    col = jnp.tile(jnp.arange(GRID_W, dtype=jnp.float32), rows_count)
    inv_freq = ROPE_BASE ** (-jnp.arange(ROPE_FREQS, dtype=jnp.float32) / ROPE_FREQS)
    ang_r = row[:, None] * inv_freq[None, :]
    ang_c = col[:, None] * inv_freq[None, :]
    ang = jnp.concatenate([ang_r, ang_r, ang_c, ang_c], axis=-1)
    return jnp.cos(ang), jnp.sin(ang)


def rotate_half_axial(t):
    t = t.reshape(t.shape[:-1] + (2, 2, ROPE_FREQS))
    t = jnp.stack([-t[..., 1, :], t[..., 0, :]], axis=-2)
    return t.reshape(t.shape[:-3] + (HEAD_DIM,))


def apply_rope(t, cos, sin):
    return t * cos[:, None, :] + rotate_half_axial(t) * sin[:, None, :]


def windowed_attention(q, k, v, kc, vc, sink):
    B, L = q.shape[0], q.shape[1]
    C = kc.shape[1]
    nb = L // QBLK

    def key_windows(t):
        tp = jnp.pad(t, ((0, 0), (QBLK, QBLK), (0, 0), (0, 0)))
        tp = tp.reshape(B, nb + 2, QBLK, ATT_KV_HEADS, HEAD_DIM)
        tw = jnp.concatenate([tp[:, :-2], tp[:, 1:-1], tp[:, 2:]], axis=2)
        return jnp.moveaxis(tw, 1, 0)

    kw, vw = key_windows(k), key_windows(v)
    qb = jnp.moveaxis(q.reshape(B, nb, QBLK, ATT_KV_HEADS, ATT_GROUP, HEAD_DIM), 1, 0)
    qi = jnp.arange(QBLK)[:, None]
    kj = jnp.arange(3 * QBLK)[None, :] - QBLK
    in_window = jnp.abs(kj - qi) <= WINDOW
    s_sink = jnp.broadcast_to(sink.astype(jnp.float32)[None, :, :, None, None],
                              (B, ATT_KV_HEADS, ATT_GROUP, QBLK, 1))
    W = 3 * QBLK

    def one_block(args):
        n, qn, kn, vn = args
        kpos = n * QBLK + kj
        valid = in_window & (kpos >= 0) & (kpos < L)
        s_loc = jnp.einsum('bqhgd,bkhd->bhgqk', qn, kn).astype(jnp.float32) * ATT_SCALE
        s_loc = jnp.where(valid, s_loc, NEG_INF)
        s_ctx = jnp.einsum('bqhgd,bchd->bhgqc', qn, kc).astype(jnp.float32) * ATT_SCALE
        p = jax.nn.softmax(jnp.concatenate([s_loc, s_ctx, s_sink], axis=-1), axis=-1)
        o = jnp.einsum('bhgqk,bkhd->bqhgd', p[..., :W].astype(vn.dtype), vn)
        o = o + jnp.einsum('bhgqc,bchd->bqhgd', p[..., W:W + C].astype(vc.dtype), vc)
        return o

    out = lax.map(one_block, (jnp.arange(nb), qb, kw, vw))
    return jnp.moveaxis(out, 0, 1).reshape(B, L, ATT_WIDTH)


def context_attention(qc, kc, vc, sink):
    B, C = qc.shape[0], qc.shape[1]
    s = jnp.einsum('bqhgd,bkhd->bhgqk', qc, kc).astype(jnp.float32) * ATT_SCALE
    s_sink = jnp.broadcast_to(sink.astype(jnp.float32)[None, :, :, None, None], s.shape[:-1] + (1,))
    p = jax.nn.softmax(jnp.concatenate([s, s_sink], axis=-1), axis=-1)[..., :C]
    o = jnp.einsum('bhgqk,bkhd->bqhgd', p.astype(vc.dtype), vc)
    return o.reshape(B, C, ATT_WIDTH)


def centred_shift(u, mu_prev, mu_next):
    prev = jnp.pad(u, ((0, 0), (1, 0), (0, 0)))[:, :-1]
    nxt = jnp.pad(u, ((0, 0), (0, 1), (0, 0)))[:, 1:]
    return u + mu_prev * (prev - u) + mu_next * (nxt - u)


def rwkv_features(u, v_first, P):
    u = u.astype(jnp.float32)
    B, T = u.shape[0], u.shape[1]
    r, k, v, wd, ad, gd = jnp.split(u, RWKV_SPLITS, axis=-1)
    if v_first is None:
        v_first = v
    else:
        v = v + (v_first - v) * jax.nn.sigmoid(P['v0'] + (v @ P['v1']) @ P['v2'])
    wd = wd.reshape(B, T, N_DIRS, LORA_DECAY)
    ad = ad.reshape(B, T, N_DIRS, LORA_ICLR)
    decay_in = P['w0'] + jnp.einsum('btdr,drc->btdc', jnp.tanh(wd), P['w2'])
    decay = jnp.exp(-jnp.exp(-jax.nn.softplus(-decay_in) - 0.5))
    a = jax.nn.sigmoid(P['a0'] + jnp.einsum('btdr,drc->btdc', ad, P['a2']))
    heads = lambda t: t.reshape(t.shape[:-1] + (RWKV_HEADS, HEAD_DIM))
    kk = heads(k * P['k_k'])
    kk = kk / jnp.maximum(jnp.sqrt(jnp.sum(kk * kk, axis=-1, keepdims=True)), 1e-12)
    k_dir = k[:, :, None, :] * (1.0 + (a - 1.0) * P['k_a'])
    g = jax.nn.sigmoid(gd) @ P['g2']
    f = {'r': heads(r), 'k': heads(k_dir), 'v': heads(v), 'decay': heads(decay),
         'a': heads(a), 'kk': kk, 'g': heads(g)}
    return f, v_first


def rwkv_scan(S0, r, decay, k, v, kk, a, reverse):
    tm = lambda t: jnp.moveaxis(t, 1, 0)
    emit = r is not None
    xs = (tm(decay), tm(k), tm(v), tm(kk), tm(kk * a))
    if emit:
        xs = xs + (tm(r),)

    def step(S, inp):
        w_t, k_t, v_t, kk_t, b_t = inp[:5]
        s_kk = jnp.einsum('bhvk,bhk->bhv', S, kk_t)
        S = (S * w_t[:, :, None, :] - s_kk[..., None] * b_t[:, :, None, :]
             + v_t[..., None] * k_t[:, :, None, :])
        y = jnp.einsum('bhvk,bhk->bhv', S, inp[5]) if emit else None
        return S, y

    S, ys = lax.scan(step, S0, xs, reverse=reverse)
    return S, (jnp.moveaxis(ys, 0, 1) if emit else None)


def rwkv_readout(y, f, P):
    B, T = y.shape[0], y.shape[1]
    mu = jnp.mean(y, axis=-1, keepdims=True)
    var = jnp.mean(jnp.square(y - mu), axis=-1, keepdims=True)
    gn = (y - mu) * lax.rsqrt(var + GN_EPS) * P['ln_w'] + P['ln_b']
    bonus = jnp.sum(f['r'][:, :, None] * f['k'] * P['r_k'], axis=(2, 4))[..., None] * f['v']
    return ((gn + bonus) * f['g']).reshape(B, T, RWKV_WIDTH)


def rwkv_mixer(fl, fc, P, emit_ctx):
    B = fl['v'].shape[0]
    S_zero = jnp.zeros((B, RWKV_HEADS, HEAD_DIM, HEAD_DIM), jnp.float32)
    ys_l, ys_c = [], []
    for d in range(N_DIRS):
        rev = d == 1
        S_ctx, yc = rwkv_scan(S_zero, fc['r'] if emit_ctx else None, fc['decay'][:, :, d],
                              fc['k'][:, :, d], fc['v'], fc['kk'], fc['a'][:, :, d], rev)
        _, yl = rwkv_scan(S_ctx, fl['r'], fl['decay'][:, :, d], fl['k'][:, :, d],
                          fl['v'], fl['kk'], fl['a'][:, :, d], rev)
        ys_l.append(yl)
        ys_c.append(yc)
    out_l = rwkv_readout(ys_l[0] + ys_l[1], fl, P)
    out_c = rwkv_readout(ys_c[0] + ys_c[1], fc, P) if emit_ctx else None
    return out_l, out_c


def route(h, router_w, router_b):
    T = h.shape[0]
    scores = jax.nn.sigmoid((h @ router_w).astype(jnp.float32))
    grouped = (scores + router_b).reshape(T, N_GROUPS, EXPERTS_PER_GROUP)
    group_score = jnp.sum(lax.top_k(grouped, GROUP_SCORE_K)[0], axis=-1)
    g_idx = jnp.argmax(group_score, axis=-1)
    in_group = jnp.take_along_axis(grouped, g_idx[:, None, None], axis=1)[:, 0]
    _, local = lax.top_k(in_group, TOP_K)
    e_idx = g_idx[:, None] * EXPERTS_PER_GROUP + local
    gates = jnp.take_along_axis(scores, e_idx, axis=1)
    gates = gates / jnp.sum(gates, axis=-1, keepdims=True)
    return e_idx, gates


def moe_ffn(h, router_w, router_b, w_gate, w_up, w_down):
    T, D = h.shape
    e_idx, gates = route(h, router_w, router_b)
    flat_e = e_idx.reshape(-1)
    n_rows = TOP_K * T
    nb = -(-n_rows // MOE_BLK) + N_EXPERTS
    counts = jnp.bincount(flat_e, length=N_EXPERTS)
    padded = (counts + MOE_BLK - 1) // MOE_BLK * MOE_BLK
    pad_ends = jnp.cumsum(padded)
    pad_starts = pad_ends - padded
    starts = jnp.cumsum(counts) - counts
    order = jnp.argsort(flat_e)
    sorted_e = flat_e[order]
    dest = pad_starts[sorted_e] + jnp.arange(n_rows) - starts[sorted_e]
    row_token = jnp.full((nb * MOE_BLK,), T, jnp.int32).at[dest].set((order // TOP_K).astype(jnp.int32))
    row_gate = jnp.zeros((nb * MOE_BLK,), jnp.float32).at[dest].set(gates.reshape(-1)[order])
    blk_expert = jnp.minimum(jnp.searchsorted(pad_ends, jnp.arange(nb) * MOE_BLK, side='right'),
                             N_EXPERTS - 1)
    h_pad = jnp.concatenate([h, jnp.zeros((1, D), h.dtype)], axis=0)
    xb = h_pad[row_token].reshape(nb, MOE_BLK, D)

    def expert_block(args):
        xe, e = args
        return (jax.nn.silu(xe @ w_gate[e]) * (xe @ w_up[e])) @ w_down[e]

    yb = lax.map(expert_block, (xb, blk_expert)).reshape(nb * MOE_BLK, D)
    out = jnp.zeros((T + 1, D), yb.dtype).at[row_token].add(yb * row_gate[:, None].astype(yb.dtype))
    return out[:T]


def hybrid_layer(xl, xc, c, c_ctx, vfl, vfc, P, router_w, router_b, cos, sin, is_last):
    B, L = xl.shape[0], xl.shape[1]
    C = xc.shape[1]
    mod_l = (jax.nn.silu(c) @ P['w_mod'] + P['b_mod'])[:, None, :]
    mod_c = (jax.nn.silu(c_ctx) @ P['w_mod'] + P['b_mod'])[None, None, :]
    sh_a, sc_a, ga, sh_f, sc_f, gf = jnp.split(mod_l, 6, axis=-1)
    csh_a, csc_a, cga, csh_f, csc_f, cgf = jnp.split(mod_c, 6, axis=-1)

    pl = modulate(rmsnorm(xl, P['norm_mix']), sh_a, sc_a) @ P['w_in']
    pc = modulate(rmsnorm(xc, P['norm_mix']), csh_a, csc_a) @ P['w_in']
    ql, kl, vl, rwl = jnp.split(pl, ATT_SPLITS, axis=-1)
    qc, kc, vc, rwc = jnp.split(pc, ATT_SPLITS, axis=-1)

    ql = apply_rope(ql.reshape(B, L, ATT_HEADS, HEAD_DIM), cos, sin)
    ql = ql.reshape(B, L, ATT_KV_HEADS, ATT_GROUP, HEAD_DIM)
    kl = apply_rope(kl.reshape(B, L, ATT_KV_HEADS, HEAD_DIM), cos, sin)
    vl = vl.reshape(B, L, ATT_KV_HEADS, HEAD_DIM)
    kc = kc.reshape(B, C, ATT_KV_HEADS, HEAD_DIM)
    vc = vc.reshape(B, C, ATT_KV_HEADS, HEAD_DIM)
    att_l = windowed_attention(ql, kl, vl, kc, vc, P['sink'])

    fc, vfc = rwkv_features(centred_shift(rwc, P['mu_prev'], P['mu_next']), vfc, P)
    fl, vfl = rwkv_features(centred_shift(rwl, P['mu_prev'], P['mu_next']), vfl, P)
    rwkv_l, rwkv_c = rwkv_mixer(fl, fc, P, not is_last)

    mix_l = jnp.concatenate([att_l, rwkv_l.astype(att_l.dtype)], axis=-1) @ P['w_out']
    xl = xl + ga * mix_l
    if not is_last:
        att_c = context_attention(qc.reshape(B, C, ATT_KV_HEADS, ATT_GROUP, HEAD_DIM), kc, vc, P['sink'])
        mix_c = jnp.concatenate([att_c, rwkv_c.astype(att_c.dtype)], axis=-1) @ P['w_out']
        xc = xc + cga * mix_c

    hfl = modulate(rmsnorm(xl, P['norm_ffn']), sh_f, sc_f).reshape(B * L, D_MODEL)
    if is_last:
        y = moe_ffn(hfl, router_w, router_b, P['e_gate'], P['e_up'], P['e_down'])
        xl = xl + gf * y.reshape(B, L, D_MODEL)
    else:
        hfc = modulate(rmsnorm(xc, P['norm_ffn']), csh_f, csc_f).reshape(B * C, D_MODEL)
        y = moe_ffn(jnp.concatenate([hfl, hfc], axis=0), router_w, router_b,
                    P['e_gate'], P['e_up'], P['e_down'])
        xl = xl + gf * y[:B * L].reshape(B, L, D_MODEL)
        xc = xc + cgf * y[B * L:].reshape(B, C, D_MODEL)
    return xl, xc, vfl, vfc


def setup_inputs(seed: int = 0) -> dict:
    key = jax.random.key(seed)
    ks = jax.random.split(key, 32)
    D = D_MODEL
    RW = RWKV_WIDTH
    E = N_EXPERTS
    nrm = lambda k, shape, s: jax.random.normal(k, shape, jnp.float32) * s
    uni = lambda k, shape, lo, hi: jax.random.uniform(k, shape, jnp.float32, lo, hi)
    return {
        'x': nrm(ks[0], (BATCH, SEQ, D), 1.0),
        'c': nrm(ks[1], (BATCH, D), 1.0),
        'ctx': nrm(ks[2], (BATCH, CTX_LEN, D), 1.0),
        'c_ctx': nrm(ks[3], (D,), 1.0),
        'w_mod': nrm(ks[4], (DEPTH, D, 6 * D), 0.5 * D ** -0.5),
        'b_mod': nrm(ks[5], (DEPTH, 6 * D), 0.02),
        'norm_mix_g': 1.0 + nrm(ks[6], (DEPTH, D), 0.02),
        'norm_ffn_g': 1.0 + nrm(ks[7], (DEPTH, D), 0.02),
        'w_in': nrm(ks[8], (DEPTH, D, IN_COLS), D ** -0.5),
        'w_out': nrm(ks[9], (DEPTH, D_MIX, D), D_MIX ** -0.5),
        'att_sink': nrm(ks[10], (DEPTH, ATT_HEADS), 0.5),
        'shift_mu_prev': uni(ks[11], (DEPTH, RWKV_COLS), 0.0, 0.5),
        'shift_mu_next': uni(ks[12], (DEPTH, RWKV_COLS), 0.0, 0.5),
        'decay_w0': uni(ks[13], (DEPTH, N_DIRS, RW), -2.0, 1.0),
        'decay_w2': nrm(ks[14], (DEPTH, N_DIRS, LORA_DECAY, RW), 0.5 * LORA_DECAY ** -0.5),
        'iclr_a0': nrm(ks[15], (DEPTH, N_DIRS, RW), 0.1),
        'iclr_a2': nrm(ks[16], (DEPTH, N_DIRS, LORA_ICLR, RW), 0.5 * LORA_ICLR ** -0.5),
        'vres_v0': nrm(ks[17], (DEPTH - 1, RW), 0.1),
        'vres_v1': nrm(ks[18], (DEPTH - 1, RW, LORA_VRES), RW ** -0.5),
        'vres_v2': nrm(ks[19], (DEPTH - 1, LORA_VRES, RW), 0.5 * LORA_VRES ** -0.5),
        'gate_g2': nrm(ks[20], (DEPTH, LORA_GATE, RW), LORA_GATE ** -0.5),
        'k_k': 0.85 + nrm(ks[21], (DEPTH, RW), 0.02),
        'k_a': 1.0 + nrm(ks[22], (DEPTH, RW), 0.02),
        'r_k': nrm(ks[23], (DEPTH, RWKV_HEADS, HEAD_DIM), 0.1),
        'ln_x_w': 1.0 + nrm(ks[24], (DEPTH, RW), 0.02),
        'ln_x_b': nrm(ks[25], (DEPTH, RW), 0.02),
        'router_w': nrm(ks[26], (D, E), D ** -0.5),
        'router_b': nrm(ks[27], (E,), 0.01),
        'expert_w_gate': nrm(ks[28], (DEPTH, E, D, D_EXPERT), D ** -0.5),
        'expert_w_up': nrm(ks[29], (DEPTH, E, D, D_EXPERT), D ** -0.5),
        'expert_w_down': nrm(ks[30], (DEPTH, E, D_EXPERT, D), D_EXPERT ** -0.5),
        'final_norm_g': 1.0 + nrm(ks[31], (D,), 0.02),
    }


def reference(x, c, ctx, c_ctx, w_mod, b_mod, norm_mix_g, norm_ffn_g, w_in, w_out, att_sink,
              shift_mu_prev, shift_mu_next, decay_w0, decay_w2, iclr_a0, iclr_a2,
              vres_v0, vres_v1, vres_v2, gate_g2, k_k, k_a, r_k, ln_x_w, ln_x_b,
              router_w, router_b, expert_w_gate, expert_w_up, expert_w_down, final_norm_g):
    L = x.shape[1]
    ROWS = L // GRID_W
    cos, sin = axial_rope_tables(ROWS)
    xl, xc = x, ctx
    vfl, vfc = None, None
    for l in range(DEPTH):
        P = {'w_mod': w_mod[l], 'b_mod': b_mod[l], 'norm_mix': norm_mix_g[l], 'norm_ffn': norm_ffn_g[l],
             'w_in': w_in[l], 'w_out': w_out[l],
             'sink': att_sink[l].reshape(ATT_KV_HEADS, ATT_GROUP),
             'mu_prev': shift_mu_prev[l], 'mu_next': shift_mu_next[l],
             'w0': decay_w0[l], 'w2': decay_w2[l], 'a0': iclr_a0[l], 'a2': iclr_a2[l],
             'g2': gate_g2[l], 'k_k': k_k[l], 'k_a': k_a[l], 'r_k': r_k[l],
             'ln_w': ln_x_w[l].reshape(RWKV_HEADS, HEAD_DIM),
             'ln_b': ln_x_b[l].reshape(RWKV_HEADS, HEAD_DIM),
             'e_gate': expert_w_gate[l], 'e_up': expert_w_up[l], 'e_down': expert_w_down[l]}
        if l > 0:
            P['v0'] = vres_v0[l - 1]
            P['v1'] = vres_v1[l - 1]
            P['v2'] = vres_v2[l - 1]
        xl, xc, vfl, vfc = hybrid_layer(xl, xc, c, c_ctx, vfl, vfc, P, router_w, router_b,
                                        cos, sin, l == DEPTH - 1)
    return rmsnorm(xl, final_norm_g)
```

```cpp
#include <hip/hip_runtime.h>
#include <cstdio>
#include <cstdint>

#ifndef MK_MULTI
#define MK_MULTI 0
#endif

#ifndef PHMASK
#define PHMASK 0x1ffff
#endif
#define HAS(k) ((((PHMASK) & MASK) >> (k)) & 1)
#ifndef REPK
#define REPK -1
#endif
#ifndef REPN
#define REPN 1
#endif
#define REPS(k) ((REPK) == (k) ? (REPN) : 1)
#define LAS __attribute__((address_space(3)))
#define GAS __attribute__((address_space(1)))
typedef unsigned short bf16;
typedef short bf16x8 __attribute__((ext_vector_type(8)));
typedef float f32x4 __attribute__((ext_vector_type(4)));
typedef float f32x16 __attribute__((ext_vector_type(16)));
typedef unsigned u32x4 __attribute__((ext_vector_type(4)));
typedef unsigned u32x2 __attribute__((ext_vector_type(2)));

constexpr int NB = 8, SEQ = 4096, CTXL = 256, DM = 1024;
constexpr int NTL = NB * SEQ, NTC = NB * CTXL, NT = NTL + NTC;
constexpr int INC = 2688, INCP = 2816;
constexpr int POSN = CTXL + SEQ;
constexpr int NCH = 16, CHL = 272;
constexpr int LWC = 2560;
constexpr int APC = 384;
constexpr int MOE_ROWS = 73728;
constexpr int NPHASE = 28;

constexpr size_t MiB = 1u << 20;
constexpr size_t WS_CTL = 0, CTL_BYTES = 1 * MiB;
constexpr size_t WS_MODV = 1 * MiB;
constexpr size_t WS_WIN = 2 * MiB;
constexpr size_t WS_WOUT = 14 * MiB;
constexpr size_t WS_WL = 18 * MiB;
constexpr size_t WS_XC = 21 * MiB;
constexpr size_t WS_ROUTE = 29 * MiB;
constexpr size_t WS_H = 31 * MiB;
constexpr size_t WS_V0 = 99 * MiB;
constexpr size_t WS_T = 133 * MiB;
constexpr size_t WS_P = WS_T;
constexpr size_t WS_R = WS_T + 187 * MiB;
constexpr size_t WS_K = WS_R + 34 * MiB;
constexpr size_t WS_V1 = WS_K + 34 * MiB;
constexpr size_t WS_QR = WS_V1 + 34 * MiB;
constexpr size_t WS_KR = WS_QR + 34 * MiB;
constexpr size_t WS_VT = WS_KR + 9 * MiB;
constexpr size_t WS_AP = WS_VT + 9 * MiB;
constexpr size_t WS_Y = WS_QR;
constexpr size_t WS_PC = WS_AP + 26 * MiB;
constexpr size_t WS_LC = WS_PC + 32 * MiB;
constexpr size_t WS_KN = WS_LC + 32 * MiB;
constexpr size_t WS_MIX_END = WS_KN + 2 * MiB;
constexpr size_t WS_WE = WS_T;
constexpr size_t WS_XS = WS_T + 96 * MiB;
constexpr size_t WS_HM = WS_XS + 144 * MiB;
constexpr size_t WS_MOE_END = WS_HM + 144 * MiB;
constexpr size_t WS_END = WS_MIX_END > WS_MOE_END ? WS_MIX_END : WS_MOE_END;
static_assert((size_t)NT * INCP * 2 <= 187 * MiB && (size_t)NT * 512 * 2 <= 34 * MiB && (size_t)NT * 128 * 2 <= 9 * MiB && (size_t)NB * 2 * 64 * POSN * 2 <= 9 * MiB, "ws map");
static_assert((size_t)NT * APC * 2 <= 26 * MiB && (size_t)2 * NT * 512 * 2 <= 78 * MiB && (size_t)MOE_ROWS * 1024 * 2 <= 144 * MiB && (size_t)NT * 32 <= 2 * MiB, "ws map");
static_assert(WS_END <= (size_t)590 * MiB, "ws budget");

constexpr int CW_BAR = 4096;
constexpr int CW_CNT = 8192;
constexpr int CW_PLAN = 8448;

constexpr int RING_BYTES = 131072;
constexpr int MISC_OFF = 147456 - 256;
constexpr int LDS_BYTES = 147456;

__device__ __forceinline__ unsigned f2bf(float f) { unsigned u = __builtin_bit_cast(unsigned, f); return (u + 0x7fffu + ((u >> 16) & 1u)) >> 16; }
typedef float f32x2_t __attribute__((ext_vector_type(2)));
typedef __bf16 bf16x2_t __attribute__((ext_vector_type(2)));
__device__ __forceinline__ unsigned pk2(float lo, float hi) { const f32x2_t v = {lo, hi}; const bf16x2_t b = __builtin_convertvector(v, bf16x2_t); return __builtin_bit_cast(unsigned, b); }
__device__ __forceinline__ unsigned short f2bf1(float f) { return (unsigned short)(pk2(f, 0.f) & 0xffffu); }
__device__ __forceinline__ float bf2f(unsigned short h) { return __builtin_bit_cast(float, (unsigned)h << 16); }
__device__ __forceinline__ float bflo(unsigned w) { return __builtin_bit_cast(float, w << 16); }
__device__ __forceinline__ float bfhi(unsigned w) { return __builtin_bit_cast(float, w & 0xffff0000u); }
__device__ __forceinline__ void unpack8(u32x4 w, float* f) { f[0] = bflo(w.x); f[1] = bfhi(w.x); f[2] = bflo(w.y); f[3] = bfhi(w.y); f[4] = bflo(w.z); f[5] = bfhi(w.z); f[6] = bflo(w.w); f[7] = bfhi(w.w); }
__device__ __forceinline__ u32x4 pack8(const float* f) { u32x4 w; w.x = pk2(f[0], f[1]); w.y = pk2(f[2], f[3]); w.z = pk2(f[4], f[5]); w.w = pk2(f[6], f[7]); return w; }
__device__ __forceinline__ void swap32(float a, float b, float& ra, float& rb) {
    auto r = __builtin_amdgcn_permlane32_swap(__builtin_bit_cast(unsigned, a), __builtin_bit_cast(unsigned, b), false, false);
    const unsigned u0 = r[0], u1 = r[1];
    ra = __builtin_bit_cast(float, u0); rb = __builtin_bit_cast(float, u1);
}
__device__ __forceinline__ float dpp_add_(float x, int ctrl_sel) {
    const int xi = __builtin_bit_cast(int, x); int y;
    if (ctrl_sel == 0) y = __builtin_amdgcn_update_dpp(0, xi, 0xB1, 0xf, 0xf, false);
    else if (ctrl_sel == 1) y = __builtin_amdgcn_update_dpp(0, xi, 0x4E, 0xf, 0xf, false);
    else if (ctrl_sel == 2) y = __builtin_amdgcn_update_dpp(0, xi, 0x141, 0xf, 0xf, false);
    else y = __builtin_amdgcn_update_dpp(0, xi, 0x140, 0xf, 0xf, false);
    return x + __builtin_bit_cast(float, y);
}
__device__ __forceinline__ void swap16(float a, float b, float& ra, float& rb) {
    auto r = __builtin_amdgcn_permlane16_swap(__builtin_bit_cast(unsigned, a), __builtin_bit_cast(unsigned, b), false, false);
    const unsigned u0 = r[0], u1 = r[1];
    ra = __builtin_bit_cast(float, u0); rb = __builtin_bit_cast(float, u1);
}
__device__ __forceinline__ float xor2_(float x) { return __builtin_bit_cast(float, __builtin_amdgcn_update_dpp(0, __builtin_bit_cast(int, x), 0x4E, 0xf, 0xf, false)); }
__device__ __forceinline__ float sum8_(float x) { x = dpp_add_(x, 0); x = dpp_add_(x, 1); return dpp_add_(x, 2); }
__device__ __forceinline__ float wave_sum(float v) {
    v = dpp_add_(v, 0); v = dpp_add_(v, 1); v = dpp_add_(v, 2); v = dpp_add_(v, 3);
    float t0, t1; swap16(v, v, t0, t1); v = t0 + t1; swap32(v, v, t0, t1); return t0 + t1;
}
__device__ __forceinline__ float sigmoidf_(float x) { return __builtin_amdgcn_rcpf(1.0f + __expf(-x)); }
__device__ __forceinline__ int row_of(int b, int pos) { return pos < CTXL ? NTL + b * CTXL + pos : b * SEQ + (pos - CTXL); }

namespace pg8 {
#define PG8_LAS __attribute__((address_space(3)))
typedef unsigned short bf16_t;
constexpr int BM = 256, BK = 64, HALF = 128, HTB = HALF * BK * 2, STAGE_BYTES = 8 * HTB, NXCD = 8, WGM = 8;
__host__ __device__ __forceinline__ int lds_byte(int r, int c) { const int st = (r >> 4) * 2 + (c >> 5), rr = r & 15, cc = c & 31, ob = rr * 64 + cc * 2; return st * 1024 + (ob ^ (((ob >> 9) & 1) << 5)); }
__host__ __device__ __forceinline__ void stage_rc(int b, int& R, int& C) { const int st = b / 1024, sb = b % 1024, swz = sb ^ (((sb >> 9) & 1) << 5); R = (st >> 1) * 16 + swz / 64; C = (st & 1) * 32 + (swz % 64) / 2; }
__host__ __device__ __forceinline__ int perm32(int rho) { const int n = rho >> 4, i = rho & 15; return 8 * (i >> 2) + 4 * n + (i & 3); }

struct Unit { int pm, pn; unsigned aoff, boff; int aux; };
struct Gemm { const bf16_t* A; const bf16_t* Bt; int lda, ldb, K; };

__device__ __forceinline__ unsigned cvt_pk_bf16(float lo, float hi) { unsigned r; asm volatile("v_cvt_pk_bf16_f32 %0, %1, %2" : "=v"(r) : "v"(lo), "v"(hi)); return r; }

template <class Epi, class Sched, bool ALIGN_EPI = false, bool SP2 = false>
__device__ __forceinline__ void gemm_phase(PG8_LAS unsigned char* lds, const Gemm g, const Sched& S, const Epi& E) {
    const int tid = threadIdx.x, wid = __builtin_amdgcn_readfirstlane(tid >> 6), lane = tid & 63, wr = wid >> 2, wc = wid & 3, fr = lane & 15, fq = lane >> 4;
    const int K = g.K, nt = K / BK;
    unsigned voffA[2], voffB[2];
#pragma unroll
    for (int i = 0; i < 2; ++i) { int R, C; stage_rc(tid * 16 + i * 8192, R, C); const int Rb = Epi::PERM ? ((R & ~31) + perm32(R & 31)) : R;
        voffA[i] = (unsigned)(R * g.lda + C) * 2u; voffB[i] = (unsigned)(Rb * g.ldb + C) * 2u; }
    const size_t kstep = (size_t)(BK * 2);
    const size_t hstepA = (size_t)HALF * g.lda * 2, hstepB = (size_t)HALF * g.ldb * 2;
    const unsigned ldsw = (unsigned)wid * 1024u;
    const int aoff = lds_byte(wr * 64 + fr, fq * 8), boff = lds_byte(wc * 32 + fr, fq * 8);
#define PG8_SA(b, h) (((b) * 2 + (h)) * HTB)
#define PG8_SB(b, h) ((4 + (b) * 2 + (h)) * HTB)
#define PG8_STAGE(bufoff, gbase, voff) do { _Pragma("unroll") for (int _i = 0; _i < 2; ++_i) \
        __builtin_amdgcn_global_load_lds((const unsigned*)((const char*)(gbase) + (voff)[_i]), (PG8_LAS unsigned*)(lds + (bufoff) + ldsw + _i * 8192), 16, 0, 0); } while (0)
#define PG8_LDA(dst, b, h) do { _Pragma("unroll") for (int m = 0; m < 4; ++m) _Pragma("unroll") for (int k = 0; k < 2; ++k) dst[m][k] = *(const PG8_LAS bf16x8*)(lds + PG8_SA(b, h) + aoff + m * 2048 + k * 1024); } while (0)
#define PG8_LDB(dst, b, h) do { _Pragma("unroll") for (int n = 0; n < 2; ++n) _Pragma("unroll") for (int k = 0; k < 2; ++k) dst[n][k] = *(const PG8_LAS bf16x8*)(lds + PG8_SB(b, h) + boff + n * 2048 + k * 1024); } while (0)
#define PG8_MMA(ai, bj, At, Bt) do { __builtin_amdgcn_s_setprio(1); _Pragma("unroll") for (int m = 0; m < 4; ++m) _Pragma("unroll") for (int n = 0; n < 2; ++n) _Pragma("unroll") for (int k = 0; k < 2; ++k) \
        acc[ai][bj][m][n] = __builtin_amdgcn_mfma_f32_16x16x32_bf16(Bt[n][k], At[m][k], acc[ai][bj][m][n], 0, 0, 0); __builtin_amdgcn_s_setprio(0); } while (0)
#define PG8_WAIT_V(n) asm volatile("s_waitcnt vmcnt(" #n ")" ::: "memory")
#define PG8_WAIT_L(n) asm volatile("s_waitcnt lgkmcnt(" #n ")" ::: "memory")
#define PG8_BAR __builtin_amdgcn_s_barrier()
#define PG8_SCHED __builtin_amdgcn_sched_barrier(0)
    Unit cur, nxt; int ui = 0;
    if (!S.next(0, cur)) return;
    f32x4 acc[2][2][4][2];
#pragma unroll
    for (int a = 0; a < 2; ++a)
#pragma unroll
        for (int b = 0; b < 2; ++b)
#pragma unroll
            for (int m = 0; m < 4; ++m)
#pragma unroll
                for (int n = 0; n < 2; ++n) acc[a][b][m][n] = (f32x4){0.f, 0.f, 0.f, 0.f};
    bf16x8 At[4][2], B0[2][2], B1[2][2];
    const char* cA = (const char*)g.A + (size_t)cur.aoff; const char* cB = (const char*)g.Bt + (size_t)cur.boff;
    if constexpr (SP2) {
        PG8_STAGE(PG8_SB(0, 0), cB, voffB); PG8_STAGE(PG8_SB(0, 1), cB + hstepB, voffB); PG8_STAGE(PG8_SA(0, 0), cA, voffA); PG8_STAGE(PG8_SA(0, 1), cA + hstepA, voffA);
        if (wr == 1) PG8_BAR;
        PG8_WAIT_V(2); PG8_BAR;
        PG8_STAGE(PG8_SB(1, 0), cB + kstep, voffB); PG8_STAGE(PG8_SA(1, 0), cA + kstep, voffA); PG8_STAGE(PG8_SB(1, 1), cB + hstepB + kstep, voffB);
        PG8_WAIT_V(6); PG8_BAR;
    } else {
        PG8_STAGE(PG8_SB(0, 0), cB, voffB); PG8_STAGE(PG8_SA(0, 0), cA, voffA); PG8_STAGE(PG8_SB(0, 1), cB + hstepB, voffB); PG8_STAGE(PG8_SA(0, 1), cA + hstepA, voffA);
        if (wr == 1) PG8_BAR;
        PG8_WAIT_V(4); PG8_BAR;
        PG8_STAGE(PG8_SB(1, 0), cB + kstep, voffB); PG8_STAGE(PG8_SA(1, 0), cA + kstep, voffA); PG8_STAGE(PG8_SB(1, 1), cB + hstepB + kstep, voffB);
        PG8_WAIT_V(6); PG8_BAR;
    }
    for (;;) {
        const bool has_next = S.next(ui + 1, nxt);
        const char* nA = has_next ? (const char*)g.A + (size_t)nxt.aoff : cA; const char* nB = has_next ? (const char*)g.Bt + (size_t)nxt.boff : cB;
#pragma unroll 1
        for (int t = 0; t < nt; t += 2) {
            const bool last = (t == nt - 2);
            const char* a1 = cA + (size_t)(t + 1) * kstep;
            const char* a2 = last ? nA : cA + (size_t)(t + 2) * kstep; const char* b2 = last ? nB : cB + (size_t)(t + 2) * kstep;
            const char* a3 = a2 + kstep; const char* b3 = b2 + kstep;
            if constexpr (SP2) {
            PG8_LDB(B0, 0, 0); PG8_LDB(B1, 0, 1); PG8_SCHED; PG8_LDA(At, 0, 0); PG8_STAGE(PG8_SA(1, 1), a1 + hstepA, voffA);
            PG8_WAIT_V(8); PG8_WAIT_L(0); PG8_BAR; PG8_MMA(0, 0, At, B0); PG8_MMA(0, 1, At, B1); PG8_BAR; PG8_SCHED;
            PG8_LDA(At, 0, 1); PG8_STAGE(PG8_SB(0, 0), b2, voffB); PG8_STAGE(PG8_SB(0, 1), b2 + hstepB, voffB); PG8_STAGE(PG8_SA(0, 0), a2, voffA);
            PG8_WAIT_V(8); PG8_WAIT_L(0); PG8_BAR; PG8_MMA(1, 0, At, B0); PG8_MMA(1, 1, At, B1); PG8_BAR; PG8_SCHED;
            PG8_LDB(B0, 1, 0); PG8_LDB(B1, 1, 1); PG8_SCHED; PG8_LDA(At, 1, 0); PG8_STAGE(PG8_SA(0, 1), a2 + hstepA, voffA);
            PG8_WAIT_V(8); PG8_WAIT_L(0); PG8_BAR; PG8_MMA(0, 0, At, B0); PG8_MMA(0, 1, At, B1); PG8_BAR; PG8_SCHED;
            PG8_LDA(At, 1, 1); PG8_STAGE(PG8_SB(1, 0), b3, voffB); PG8_STAGE(PG8_SB(1, 1), b3 + hstepB, voffB); PG8_STAGE(PG8_SA(1, 0), a3, voffA);
            PG8_WAIT_V(8); PG8_WAIT_L(0); PG8_BAR; PG8_MMA(1, 0, At, B0); PG8_MMA(1, 1, At, B1); PG8_BAR; PG8_SCHED;
            } else {
            PG8_LDB(B0, 0, 0); PG8_SCHED; PG8_LDA(At, 0, 0); PG8_STAGE(PG8_SA(1, 1), a1 + hstepA, voffA);
            PG8_WAIT_L(8); PG8_BAR; PG8_WAIT_L(0); PG8_MMA(0, 0, At, B0); PG8_BAR; PG8_SCHED;
            PG8_LDB(B1, 0, 1); PG8_STAGE(PG8_SB(0, 0), b2, voffB);
            PG8_BAR; PG8_WAIT_L(0); PG8_MMA(0, 1, At, B1); PG8_BAR;
            PG8_LDA(At, 0, 1); PG8_STAGE(PG8_SA(0, 0), a2, voffA);
            PG8_BAR; PG8_WAIT_L(0); PG8_MMA(1, 0, At, B0); PG8_BAR; PG8_SCHED;
            PG8_STAGE(PG8_SB(0, 1), b2 + hstepB, voffB);
            PG8_WAIT_V(6); PG8_BAR; PG8_MMA(1, 1, At, B1); PG8_BAR;
            PG8_LDB(B0, 1, 0); PG8_SCHED; PG8_LDA(At, 1, 0); PG8_STAGE(PG8_SA(0, 1), a2 + hstepA, voffA);
            PG8_WAIT_L(8); PG8_BAR; PG8_WAIT_L(0); PG8_MMA(0, 0, At, B0); PG8_BAR; PG8_SCHED;
            PG8_LDB(B1, 1, 1); PG8_STAGE(PG8_SB(1, 0), b3, voffB);
            PG8_BAR; PG8_WAIT_L(0); PG8_MMA(0, 1, At, B1); PG8_BAR;
            PG8_LDA(At, 1, 1); PG8_STAGE(PG8_SA(1, 0), a3, voffA);
            PG8_BAR; PG8_WAIT_L(0); PG8_MMA(1, 0, At, B0); PG8_BAR; PG8_SCHED;
            PG8_STAGE(PG8_SB(1, 1), b3 + hstepB, voffB);
            PG8_WAIT_V(6); PG8_BAR; PG8_MMA(1, 1, At, B1); PG8_BAR;
            }
        }
        if constexpr (ALIGN_EPI) { if (wr == 0) PG8_BAR; }
        E(acc, cur, wr, wc, fr, fq);
        if (!has_next) break;
#pragma unroll
        for (int a = 0; a < 2; ++a)
#pragma unroll
            for (int b = 0; b < 2; ++b)
#pragma unroll
                for (int m = 0; m < 4; ++m)
#pragma unroll
                    for (int n = 0; n < 2; ++n) acc[a][b][m][n] = (f32x4){0.f, 0.f, 0.f, 0.f};
        cur = nxt; cA = nA; cB = nB; ++ui;
        if constexpr (ALIGN_EPI) { if (wr == 1) PG8_BAR; }
    }
    PG8_WAIT_V(0);
    if constexpr (!ALIGN_EPI) { if (wr == 0) PG8_BAR; }
    PG8_BAR;
#undef PG8_SA
#undef PG8_SB
#undef PG8_STAGE
#undef PG8_LDA
#undef PG8_LDB
#undef PG8_MMA
#undef PG8_WAIT_V
#undef PG8_WAIT_L
#undef PG8_BAR
#undef PG8_SCHED
}

struct DenseOrder {
    int nM, nN, nwg, G, c; unsigned atile, btile; int lora;
    __device__ __forceinline__ void init(int nM_, int nN_, int G_, int c_, int lda, int ldb, int lora_) { nM = nM_; nN = nN_; nwg = nM * nN; G = G_; c = c_; atile = (unsigned)(BM * lda * 2); btile = (unsigned)(BM * ldb * 2); lora = lora_; }
    __device__ __forceinline__ bool next(int i, Unit& u) const {
        const long L = (long)i * G + c; if (L >= nwg) return false;
        int wgid = (int)L; { const int q = nwg / NXCD, r = nwg % NXCD, xcd = wgid % NXCD, off = wgid / NXCD; wgid = (xcd < r ? xcd * (q + 1) : r * (q + 1) + (xcd - r) * q) + off; }
        const int nig = WGM * nN, gid = wgid / nig, fm = gid * WGM, gsz = (nM - fm) < WGM ? (nM - fm) : WGM;
        u.pm = fm + ((wgid % nig) % gsz); u.pn = (wgid % nig) / gsz;
        u.aoff = (unsigned)u.pm * atile + (lora ? (u.pn < 4 ? 0u : (u.pn < 8 ? 256u : 512u)) : 0u); u.boff = (unsigned)u.pn * btile; u.aux = 0; return true;
    }
};
struct MoeOrder {
    const int* plan; int ntiles, npn, G, c; unsigned atile, brow; int nper;
    __device__ __forceinline__ void init(const int* plan_, int npn_, int G_, int c_, int lda, int ldb, int nper_) { plan = plan_; ntiles = plan_[0]; npn = npn_; G = G_; c = c_; atile = (unsigned)(BM * lda * 2); brow = (unsigned)(ldb * 2); nper = nper_; }
    __device__ __forceinline__ bool next(int i, Unit& u) const {
        const int L = i * G + c, x = L & 7, off = L >> 3;
        const int ntx = (ntiles - x + 7) >> 3;
        if (off >= ntx * npn) return false;
        u.pm = (off / npn) * 8 + x; u.pn = off % npn; const int e = plan[16 + u.pm]; u.aux = e;
        u.aoff = (unsigned)u.pm * atile; u.boff = (unsigned)(e * nper + u.pn * BM) * brow; return true;
    }
};

struct EpiStore {
    static constexpr bool PERM = true;
    bf16_t* O; int ldc;
    __device__ __forceinline__ void operator()(const f32x4 (&acc)[2][2][4][2], const Unit& u, int wr, int wc, int fr, int fq) const {
        const int row0 = u.pm * BM + wr * 64 + fr, col0 = u.pn * BM + wc * 32 + 8 * fq;
#pragma unroll
        for (int ai = 0; ai < 2; ++ai)
#pragma unroll
            for (int m = 0; m < 4; ++m) { bf16_t* rowp = O + (size_t)(row0 + ai * HALF + m * 16) * ldc + col0;
#pragma unroll
                for (int bj = 0; bj < 2; ++bj) { const f32x4 v0 = acc[ai][bj][m][0], v1 = acc[ai][bj][m][1];
                    u32x4 w; w.x = cvt_pk_bf16(v0[0], v0[1]); w.y = cvt_pk_bf16(v0[2], v0[3]); w.z = cvt_pk_bf16(v1[0], v1[1]); w.w = cvt_pk_bf16(v1[2], v1[3]);
                    __builtin_nontemporal_store(w, (u32x4*)(rowp + bj * HALF)); } }
    }
};
struct EpiGateUp {
    static constexpr bool PERM = true;
    bf16_t* O;
    __device__ __forceinline__ void operator()(const f32x4 (&acc)[2][2][4][2], const Unit& u, int wr, int wc, int fr, int fq) const {
        const int row0 = u.pm * BM + wr * 64 + fr, col0 = u.pn * HALF + wc * 32 + 8 * fq;
#pragma unroll
        for (int ai = 0; ai < 2; ++ai)
#pragma unroll
            for (int m = 0; m < 4; ++m) { bf16_t* rowp = O + (size_t)(row0 + ai * HALF + m * 16) * 1024 + col0;
                f32x4 h0, h1;
#pragma unroll
                for (int i = 0; i < 4; ++i) { const float g0 = acc[ai][0][m][0][i], g1 = acc[ai][0][m][1][i];
                    h0[i] = g0 * sigmoidf_(g0) * acc[ai][1][m][0][i]; h1[i] = g1 * sigmoidf_(g1) * acc[ai][1][m][1][i]; }
                u32x4 w; w.x = cvt_pk_bf16(h0[0], h0[1]); w.y = cvt_pk_bf16(h0[2], h0[3]); w.z = cvt_pk_bf16(h1[0], h1[1]); w.w = cvt_pk_bf16(h1[2], h1[3]);
                __builtin_nontemporal_store(w, (u32x4*)rowp); }
    }
};
struct EpiResid {
    static constexpr bool PERM = false;
    const float* baseL; const float* baseC; float* outL; float* outC; const float* modv; int dummy;
    __device__ __forceinline__ void operator()(const f32x4 (&acc)[2][2][4][2], const Unit& u, int wr, int wc, int fr, int fq) const {
        const bool lat = u.pm < NTL / BM;
        const int rowt = (lat ? u.pm : u.pm - NTL / BM) * BM + wr * 64 + fr, col0 = u.pn * BM + wc * 32 + 4 * fq;
        const float* base = lat ? baseL : baseC; float* out = lat ? outL : outC;
        const int mr = lat ? (u.pm >> 4) : 8;
        const float* gp = modv + (size_t)mr * 6144 + 2048 + col0;
        f32x4 gv[2][2];
#pragma unroll
        for (int bj = 0; bj < 2; ++bj)
#pragma unroll
            for (int n = 0; n < 2; ++n) gv[bj][n] = *(const f32x4*)(gp + bj * HALF + n * 16);
#pragma unroll
        for (int ai = 0; ai < 2; ++ai)
#pragma unroll
            for (int m = 0; m < 4; ++m) { const size_t off = (size_t)(rowt + ai * HALF + m * 16) * DM + col0;
#pragma unroll
                for (int bj = 0; bj < 2; ++bj)
#pragma unroll
                    for (int n = 0; n < 2; ++n) { const f32x4 bs = *(const f32x4*)(base + off + bj * HALF + n * 16);
                        const f32x4 ov = bs + gv[bj][n] * acc[ai][bj][m][n]; if (!dummy || ov[0] == 12345.678f) *(f32x4*)(out + off + bj * HALF + n * 16) = ov; } }
    }
};
}

#define XB_TMO      128
#define XB_XCNT(j)  (256  + 64 * (j))
#define XB_XSUB(j)  (1280 + 64 * (j))
#define XB_XGEN(j)  (2304 + 64 * (j))
#define XB_TOP      3328
#define XB_TOPGEN   3392
#define XCD_BAR_WORDS 3456
#define XB_SPIN_CAP (1u << 20)
__device__ __forceinline__ unsigned xb_ld(unsigned* p)              { return __hip_atomic_load(p, __ATOMIC_RELAXED, __HIP_MEMORY_SCOPE_AGENT); }
__device__ __forceinline__ unsigned xb_add(unsigned* p, unsigned v) { return __hip_atomic_fetch_add(p, v, __ATOMIC_RELAXED, __HIP_MEMORY_SCOPE_AGENT); }
__device__ __forceinline__ unsigned xb_xcc_id() { return (unsigned)__builtin_amdgcn_s_getreg((3 << 11) | 20) & 0xFu; }
#define XB_SPIN(cond, bar) do { unsigned _sp = 0; while (cond) { __builtin_amdgcn_s_sleep(1); \
    if ((++_sp & 255u) == 0u) { if (xb_ld(&(bar)[XB_TMO])) break; if (_sp > XB_SPIN_CAP) { atomicAdd(&(bar)[XB_TMO], 1u); break; } } } } while (0)
struct XcdBarrier { unsigned* bar; unsigned x; volatile LAS unsigned* st; };
__device__ __forceinline__ XcdBarrier xcd_barrier_post(unsigned* bar, volatile LAS unsigned* st) {
    XcdBarrier b; b.bar = bar; b.x = xb_xcc_id(); b.st = st;
    if (threadIdx.x == 0) (void)xb_add(&bar[XB_XCNT(b.x)], 1u);
    return b;
}
__device__ __forceinline__ void xcd_barrier_complete(unsigned* bar, unsigned x, unsigned& nloc, unsigned& nx) {
    const unsigned G = gridDim.x * gridDim.y * gridDim.z;
    unsigned sum, cnt, mine, sp = 0u;
    for (;;) {
        sum = 0u; cnt = 0u; mine = 0u;
#pragma unroll
        for (unsigned j = 0; j < 16; ++j) { const unsigned c = xb_ld(&bar[XB_XCNT(j)]); sum += c; cnt += (c > 0u) ? 1u : 0u; mine = (j == x) ? c : mine; }
        if (sum == G) break;
        __builtin_amdgcn_s_sleep(1);
        if ((++sp & 255u) == 0u) { if (xb_ld(&bar[XB_TMO])) break; if (sp > XB_SPIN_CAP) { atomicAdd(&bar[XB_TMO], 1u); break; } }
    }
    nloc = mine > 0u ? mine : 1u; nx = cnt > 0u ? cnt : 1u;
}
__device__ __forceinline__ void xcd_barrier(const XcdBarrier& b) {
    asm volatile("s_waitcnt vmcnt(0)" ::: "memory");
    __syncthreads();
    if (threadIdx.x == 0) {
        unsigned* bar = b.bar;
        __builtin_amdgcn_s_waitcnt(0);
        unsigned nloc = b.st[0], nx = b.st[1];
        if (nloc == 0u) { xcd_barrier_complete(bar, b.x, nloc, nx); b.st[0] = nloc; b.st[1] = nx; }
        const unsigned old = xb_add(&bar[XB_XSUB(b.x)], 1u);
        const unsigned gen = old / nloc;
        if (old + 1u == (gen + 1u) * nloc) {
            __builtin_amdgcn_fence(__ATOMIC_RELEASE, "agent");
            asm volatile("s_waitcnt vmcnt(0)" ::: "memory");
            const unsigned og = xb_add(&bar[XB_TOP], 1u);
            const unsigned tg = og / nx;
            if (og + 1u == (tg + 1u) * nx) xb_add(&bar[XB_TOPGEN], 1u);
            else XB_SPIN(xb_ld(&bar[XB_TOPGEN]) == tg, bar);
            __builtin_amdgcn_fence(__ATOMIC_ACQUIRE, "agent");
            xb_add(&bar[XB_XGEN(b.x)], 1u);
            asm volatile("s_waitcnt vmcnt(0)" ::: "memory");
        } else {
            XB_SPIN(xb_ld(&bar[XB_XGEN(b.x)]) == gen, bar);
            __builtin_amdgcn_fence(__ATOMIC_ACQUIRE, "agent");
            asm volatile("s_waitcnt vmcnt(0)" ::: "memory");
        }
    }
    __syncthreads();
}

struct Args { const float* in[32]; float* out; unsigned char* ws; int ph_lo, ph_hi; };
enum { I_X = 0, I_C, I_CTX, I_CCTX, I_WMOD, I_BMOD, I_NMIX, I_NFFN, I_WIN, I_WOUT, I_SINK, I_MUP, I_MUN, I_W0, I_W2, I_A0, I_A2, I_V0, I_V1, I_V2, I_G2,
       I_KK, I_KA, I_RK, I_LNW, I_LNB, I_RW, I_RB, I_EG, I_EU, I_ED, I_FNG };

__device__ __forceinline__ void transpose_item(const float* W, int N, int k0, int n0, bf16* dst, int Kp, LAS float* scr, int lane) {
#pragma unroll 8
    for (int i = 0; i < 32; ++i) { const int kk = 2 * i + (lane >> 5); scr[kk * 33 + (lane & 31)] = __builtin_nontemporal_load(W + (size_t)(k0 + kk) * N + n0 + (lane & 31)); }
    asm volatile("s_waitcnt lgkmcnt(0)" ::: "memory");
    const int c = lane & 7;
#pragma unroll
    for (int j = 0; j < 4; ++j) { const int n = (lane >> 3) + 8 * j; const LAS float* s = scr + (8 * c) * 33 + n;
        u32x4 o; o.x = pk2(s[0 * 33], s[1 * 33]); o.y = pk2(s[2 * 33], s[3 * 33]); o.z = pk2(s[4 * 33], s[5 * 33]); o.w = pk2(s[6 * 33], s[7 * 33]);
        __builtin_nontemporal_store(o, (u32x4*)(dst + (size_t)n * Kp + k0 + 8 * c)); }
    asm volatile("s_waitcnt lgkmcnt(0)" ::: "memory");
}

__device__ __forceinline__ void ph_prologue(const Args& a, LAS unsigned char* lds, int tid, int lane, int wave) {
    const int gw = blockIdx.x * 8 + wave, NGW = gridDim.x * 8;
    unsigned char* ws = a.ws;
    LAS float* scr = (LAS float*)(lds + wave * 16384);
    bf16* WinT = (bf16*)(ws + WS_WIN); bf16* WoutT = (bf16*)(ws + WS_WOUT); bf16* WL = (bf16*)(ws + WS_WL);
    constexpr int I_IN = 16 * 84, I_OUT = 16 * 32, I_L = I_IN + I_OUT;
    for (int it = gw; it < 2 * I_L; it += NGW) {
        const int l = it / I_L; int r = it % I_L;
        if (r < I_IN) { const int kb = r / 84, nb = r % 84; transpose_item(a.in[I_WIN] + (size_t)l * DM * INC, INC, kb * 64, nb * 32, WinT + ((size_t)l * INCP + nb * 32) * DM, DM, scr, lane); }
        else { r -= I_IN; const int kb = r / 32, nb = r % 32; transpose_item(a.in[I_WOUT] + (size_t)l * DM * DM, DM, kb * 64, nb * 32, WoutT + ((size_t)l * DM + nb * 32) * DM, DM, scr, lane); }
    }
    for (int i = blockIdx.x * 512 + tid; i < 2 * 128 * DM / 8; i += gridDim.x * 512) { const int l = i / (128 * DM / 8), r = i % (128 * DM / 8);
        *(u32x4*)(WinT + ((size_t)l * INCP + INC) * DM + (size_t)r * 8) = (u32x4){0u, 0u, 0u, 0u}; }
    for (int i = blockIdx.x * 512 + tid; i < 2 * LWC * 128; i += gridDim.x * 512) {
        const int l = i / (LWC * 128), r = i % (LWC * 128), n = r >> 7, k = r & 127; float v = 0.f;
        if (n < 1024) { const int dir = n >> 9, c = n & 511; if ((k >> 6) == dir) v = a.in[I_W2][((size_t)(l * 2 + dir) * 64 + (k & 63)) * 512 + c]; }
        else if (n < 2048) { const int n2 = n - 1024, dir = n2 >> 9, c = n2 & 511; if ((k >> 6) == dir) v = a.in[I_A2][((size_t)(l * 2 + dir) * 64 + (k & 63)) * 512 + c]; }
        else { const int c = n - 2048; v = a.in[I_G2][((size_t)l * 128 + k) * 512 + c]; }
        WL[i] = (bf16)f2bf(v);
    }
    __syncthreads();
    {
        LAS float* sc = (LAS float*)lds; LAS float* red = (LAS float*)(lds + 9 * 1024 * 4);
        float* modv = (float*)(ws + WS_MODV);
        for (int idx = tid; idx < 9 * 1024; idx += 512) { const int r = idx >> 10, k = idx & 1023; const float cv = r < 8 ? a.in[I_C][r * 1024 + k] : a.in[I_CCTX][k]; sc[idx] = cv / (1.0f + __expf(-cv)); }
        __syncthreads();
        for (int it = blockIdx.x; it < 192; it += gridDim.x) {
            const int l = it / 96, n0 = (it % 96) * 64;
            float acc[9];
#pragma unroll
            for (int r = 0; r < 9; ++r) acc[r] = 0.f;
            const float* wp = a.in[I_WMOD] + ((size_t)l * 1024 + wave * 128) * 6144 + n0 + lane;
#pragma unroll 4
            for (int kk = 0; kk < 128; ++kk) { const float wv = wp[(size_t)kk * 6144];
#pragma unroll
                for (int r = 0; r < 9; ++r) acc[r] += sc[r * 1024 + wave * 128 + kk] * wv; }
#pragma unroll
            for (int r = 0; r < 9; ++r) red[(wave * 9 + r) * 64 + lane] = acc[r];
            __syncthreads();
            for (int idx = tid; idx < 576; idx += 512) { const int r = idx >> 6, ln = idx & 63; float s = a.in[I_BMOD][l * 6144 + n0 + ln];
#pragma unroll
                for (int w = 0; w < 8; ++w) s += red[(w * 9 + r) * 64 + ln];
                modv[((size_t)l * 9 + r) * 6144 + n0 + ln] = s; }
            __syncthreads();
        }
    }
}

__device__ __forceinline__ void convert_experts(const Args& a, int l, LAS unsigned char* lds, int lane, int wave) {
    const int gw = blockIdx.x * 8 + wave, NGW = gridDim.x * 8;
    LAS float* scr = (LAS float*)(lds + wave * 16384);
    bf16* WEgu = (bf16*)(a.ws + WS_WE); bf16* WEd = WEgu + (size_t)16 * 2048 * 1024;
    for (int it = gw; it < 3 * 16 * 512; it += NGW) {
        const int mat = it / 8192, r = it % 8192, e = r >> 9, kb = (r >> 5) & 15, nb = r & 31, n0 = nb * 32;
        const float* W = a.in[I_EG + mat] + ((size_t)(l * 16 + e) << 20);
        bf16* dst = mat < 2 ? WEgu + ((size_t)e * 2048 + (n0 >> 7) * 256 + (n0 & 127) + mat * 128) * 1024 : WEd + ((size_t)e * 1024 + n0) * 1024;
        transpose_item(W, 1024, kb * 64, n0, dst, 1024, scr, lane);
    }
}

__device__ __forceinline__ void norm_mod_store(const f32x4 (&v)[4], const float* g, const float* sc, const float* sh, bf16* orow, int lane, f32x4 (&hout)[4], bool dostore = true) {
    float ss = 0.f;
#pragma unroll
    for (int j = 0; j < 4; ++j) ss += (v[j].x * v[j].x + v[j].y * v[j].y) + (v[j].z * v[j].z + v[j].w * v[j].w);
    const float rms = rsqrtf(wave_sum(ss) * (1.0f / DM) + 1e-6f);
#pragma unroll
    for (int j = 0; j < 4; ++j) { const int c = 4 * (lane + 64 * j);
        const f32x4 gg = *(const f32x4*)(g + c), s1 = *(const f32x4*)(sc + c), s0 = *(const f32x4*)(sh + c);
        const f32x4 h = (v[j] * rms * gg) * (s1 + 1.0f) + s0; hout[j] = h;
        u32x2 w; w.x = pk2(h.x, h.y); w.y = pk2(h.z, h.w); if (dostore || h.x == 12345.678f) *(u32x2*)(orow + c) = w; }
}

__device__ __forceinline__ void ph_norm1_l0(const Args& a, int lane, int wave) {
    const int gw = blockIdx.x * 8 + wave, NGW = gridDim.x * 8;
    const float* modv = (const float*)(a.ws + WS_MODV); bf16* H = (bf16*)(a.ws + WS_H);
    for (int row = gw; row < NT; row += NGW) {
        const float* src = row < NTL ? a.in[I_X] + (size_t)row * DM : a.in[I_CTX] + (size_t)(row - NTL) * DM;
        const int mr = row < NTL ? (row >> 12) : 8;
        f32x4 v[4], h[4];
#pragma unroll
        for (int j = 0; j < 4; ++j) v[j] = *(const f32x4*)(src + 4 * (lane + 64 * j));
        norm_mod_store(v, a.in[I_NMIX], modv + (size_t)mr * 6144 + 1024, modv + (size_t)mr * 6144, H + (size_t)row * DM, lane, h);
    }
}

__device__ __forceinline__ void ph_postproj(const Args& a, int l, LAS unsigned char* lds, int tid, int lane, int wave) {
    LAS bf16* vtl = (LAS bf16*)lds;
    LAS bf16* ktl = (LAS bf16*)(lds + 107520);
    LAS bf16* v1T = (LAS bf16*)(lds + 8192); LAS bf16* v2P = (LAS bf16*)(lds + 41472); LAS bf16* VT = (LAS bf16*)(lds + 74240);
    unsigned char* ws = a.ws;
    const bf16* P = (const bf16*)(ws + WS_P);
    bf16* Qr = (bf16*)(ws + WS_QR); bf16* Kr = (bf16*)(ws + WS_KR); bf16* Vt = (bf16*)(ws + WS_VT); bf16* AP = (bf16*)(ws + WS_AP);
    bf16* Rb = (bf16*)(ws + WS_R); bf16* Kb = (bf16*)(ws + WS_K); bf16* V0 = (bf16*)(ws + WS_V0); bf16* Vb = l == 0 ? V0 : (bf16*)(ws + WS_V1);
    const int c0 = lane * 8;
    const u32x4 zero4 = (u32x4){0u, 0u, 0u, 0u};
    u32x4 wp[4], wc[4], wn[4], rq, rk, rv;
#define PP_LOAD_FIRST(tile_) do { const int rowb_ = (tile_) * 32 + wave * 4; const int tb_ = rowb_ >= NTL ? ((rowb_ - NTL) & 255) : (rowb_ & 4095); const bf16* pr0 = P + (size_t)rowb_ * INCP; \
      _Pragma("unroll") for (int j = 0; j < 4; ++j) { const int cg = 768 + j * 512 + c0; const bool act = (j < 3) || (lane < 48); \
          wc[j] = act ? *(const u32x4*)(pr0 + cg) : zero4; wp[j] = (act && tb_ > 0) ? *(const u32x4*)(pr0 - INCP + cg) : zero4; wn[j] = act ? *(const u32x4*)(pr0 + INCP + cg) : zero4; } \
      rq = *(const u32x4*)(pr0 + c0); rk = *(const u32x4*)(pr0 + 512 + (lane & 15) * 8); rv = *(const u32x4*)(pr0 + 640 + (lane & 15) * 8); } while (0)
    if (blockIdx.x < NT / 32) PP_LOAD_FIRST(blockIdx.x);
    if (l > 0) {
        const float* v1 = a.in[I_V1] + (size_t)(l - 1) * 512 * 32; const float* v2 = a.in[I_V2] + (size_t)(l - 1) * 32 * 512;
        for (int idx = tid; idx < 16384; idx += 512) { const int c = idx >> 5, j = idx & 31; v1T[j * 520 + c] = (bf16)f2bf(v1[idx]); }
        for (int idx = tid; idx < 16384; idx += 512) { const int j = idx >> 9, c = idx & 511;
            v2P[c * 32 + ((((j >> 4) * 2 + ((j >> 2) & 1)) * 8) + 4 * ((j >> 3) & 1) + (j & 3))] = (bf16)f2bf(v2[idx]); }
        __syncthreads();
    }
    float* KN = (float*)(ws + WS_KN);
    float kkp[8];
#pragma unroll
    for (int i = 0; i < 8; ++i) kkp[i] = a.in[I_KK][l * 512 + c0 + i];
    float mp[4][8], mn[4][8], vz[8];
    { const float* mup = a.in[I_MUP] + l * 1920; const float* mun = a.in[I_MUN] + l * 1920;
#pragma unroll
      for (int j = 0; j < 4; ++j) { const int cg = j * 512 + c0; const bool act = (j < 3) || (lane < 48);
#pragma unroll
          for (int i = 0; i < 8; ++i) { mp[j][i] = act ? mup[cg + i] : 0.f; mn[j][i] = act ? mun[cg + i] : 0.f; } }
#pragma unroll
      for (int i = 0; i < 8; ++i) vz[i] = l > 0 ? a.in[I_V0][(size_t)(l - 1) * 512 + c0 + i] : 0.f; }
    const int fbase = 8 * (lane & 1), axis = (lane >> 2) & 1, second = (lane >> 1) & 1;
    LAS float* rct = (LAS float*)(lds + 116224); LAS float* rst = (LAS float*)(lds + 120320);
    for (int idx = tid; idx < 1024; idx += 512) { const float ang = (float)(idx >> 4) * exp2f(-(float)(idx & 15) * (13.287712379549449f / 16.0f)); rct[idx] = __cosf(ang); rst[idx] = __sinf(ang); }
    __syncthreads();
    const float QSCALE = 0.125f * 1.4426950408889634f;
    for (int tile = blockIdx.x; tile < NT / 32; tile += gridDim.x) {
    const int rowb = tile * 32 + wave * 4;
    const bool isctx = rowb >= NTL; int tb, len;
    if (!isctx) { tb = rowb & 4095; len = SEQ; } else { tb = (rowb - NTL) & 255; len = CTXL; }
#pragma unroll 1
    for (int rr = 0; rr < 4; ++rr) {
        const int tl = wave * 4 + rr, row = rowb + rr;
        const int t = tb + rr;
        u32x4 nn[4], nq = zero4, nk = zero4, nv = zero4;
        { const bf16* pr2 = P + (size_t)(row + 2) * INCP; const bool ok2 = rr < 3 && (t + 2 < len);
#pragma unroll
          for (int j = 0; j < 4; ++j) { const int cg = 768 + j * 512 + c0; const bool act = (j < 3) || (lane < 48); nn[j] = (act && ok2) ? *(const u32x4*)(pr2 + cg) : zero4; }
          if (rr < 3) { const bf16* pr1 = P + (size_t)(row + 1) * INCP;
              nq = *(const u32x4*)(pr1 + c0); nk = *(const u32x4*)(pr1 + 512 + (lane & 15) * 8); nv = *(const u32x4*)(pr1 + 640 + (lane & 15) * 8); } }
        u32x4 rc[4], rp[4], rn[4];
#pragma unroll
        for (int j = 0; j < 4; ++j) { rc[j] = wc[j]; rp[j] = wp[j]; rn[j] = wn[j]; }
        __builtin_amdgcn_sched_barrier(0);
        float cs[8], sn[8];
        { const int pi = (axis ? (t & 63) : (t >> 6)) * 16 + fbase;
          const f32x4 c0v = *(const LAS f32x4*)(rct + pi), c1v = *(const LAS f32x4*)(rct + pi + 4), s0v = *(const LAS f32x4*)(rst + pi), s1v = *(const LAS f32x4*)(rst + pi + 4);
          cs[0] = c0v.x; cs[1] = c0v.y; cs[2] = c0v.z; cs[3] = c0v.w; cs[4] = c1v.x; cs[5] = c1v.y; cs[6] = c1v.z; cs[7] = c1v.w;
          sn[0] = s0v.x; sn[1] = s0v.y; sn[2] = s0v.z; sn[3] = s0v.w; sn[4] = s1v.x; sn[5] = s1v.y; sn[6] = s1v.z; sn[7] = s1v.w; }
        { float q[8], pq[8]; unpack8(rq, q);
#pragma unroll
          for (int i = 0; i < 8; ++i) pq[i] = xor2_(q[i]);
          if (!isctx) {
#pragma unroll
              for (int i = 0; i < 8; ++i) q[i] = second ? (q[i] * cs[i] + pq[i] * sn[i]) : (q[i] * cs[i] - pq[i] * sn[i]); }
#pragma unroll
          for (int i = 0; i < 8; ++i) q[i] *= QSCALE;
          *(u32x4*)(Qr + (size_t)row * 512 + c0) = pack8(q); }
        { float k[8], pk[8];
          unpack8(rk, k);
#pragma unroll
          for (int i = 0; i < 8; ++i) pk[i] = xor2_(k[i]);
          if (!isctx) {
#pragma unroll
              for (int i = 0; i < 8; ++i) k[i] = second ? (k[i] * cs[i] + pk[i] * sn[i]) : (k[i] * cs[i] - pk[i] * sn[i]); }
          if (lane < 16) {
              *(LAS u32x4*)(ktl + tl * 136 + c0) = pack8(k);
              LAS bf16* vp = vtl + c0 * 32 + tl;
              vp[0 * 32] = (bf16)(rv.x & 0xffffu); vp[1 * 32] = (bf16)(rv.x >> 16); vp[2 * 32] = (bf16)(rv.y & 0xffffu); vp[3 * 32] = (bf16)(rv.y >> 16);
              vp[4 * 32] = (bf16)(rv.z & 0xffffu); vp[5 * 32] = (bf16)(rv.z >> 16); vp[6 * 32] = (bf16)(rv.w & 0xffffu); vp[7 * 32] = (bf16)(rv.w >> 16);
          } }
        float vv[8];
#pragma unroll
        for (int j = 0; j < 4; ++j) {
            float u[8], cur[8], pv[8], nx[8];
            unpack8(rc[j], cur); unpack8(rp[j], pv); unpack8(rn[j], nx);
#pragma unroll
            for (int i = 0; i < 8; ++i) u[i] = cur[i] + mp[j][i] * (pv[i] - cur[i]) + mn[j][i] * (nx[i] - cur[i]);
            if (j == 0) *(u32x4*)(Rb + (size_t)row * 512 + c0) = pack8(u);
            else if (j == 1) { const u32x4 kw = pack8(u); *(u32x4*)(Kb + (size_t)row * 512 + c0) = kw;
                float kq[8]; unpack8(kw, kq); float ss = 0.f;
#pragma unroll
                for (int i = 0; i < 8; ++i) { const float t = kq[i] * kkp[i]; ss += t * t; }
                ss = sum8_(ss);
                if ((lane & 7) == 0) KN[(size_t)row * 8 + (lane >> 3)] = __builtin_amdgcn_rsqf(fmaxf(ss, 1e-24f)); }
            else if (j == 2) {
#pragma unroll
                for (int i = 0; i < 8; ++i) vv[i] = u[i];
            } else if (lane < 48) {
                if (lane < 16) {
#pragma unroll
                    for (int i = 0; i < 8; ++i) { const float e2 = __expf(2.0f * u[i]); u[i] = 1.0f - 2.0f * __builtin_amdgcn_rcpf(e2 + 1.0f); }
                } else if (lane >= 32) {
#pragma unroll
                    for (int i = 0; i < 8; ++i) u[i] = sigmoidf_(u[i]);
                }
                *(u32x4*)(AP + (size_t)row * APC + c0) = pack8(u);
            }
        }
        if (l > 0) *(LAS u32x4*)(VT + tl * 520 + c0) = pack8(vv);
        else *(u32x4*)(Vb + (size_t)row * 512 + c0) = pack8(vv);
#pragma unroll
        for (int j = 0; j < 4; ++j) { wp[j] = wc[j]; wc[j] = wn[j]; wn[j] = nn[j]; }
        rq = nq; rk = nk; rv = nv;
    }
        if (tile + (int)gridDim.x < NT / 32) PP_LOAD_FIRST(tile + (int)gridDim.x);
        if (l > 0) {
            const int l31 = lane & 31, hh = lane >> 5;
            u32x2 fwv[2][4];
#pragma unroll
            for (int ci = 0; ci < 2; ++ci)
#pragma unroll
                for (int g = 0; g < 4; ++g) fwv[ci][g] = *(const u32x2*)(V0 + (size_t)(tile * 32 + l31) * 512 + 32 * (2 * wave + ci) + 8 * g + 4 * hh);
            __syncthreads();
            f32x16 t1;
#pragma unroll
            for (int i = 0; i < 16; ++i) t1[i] = 0.f;
#pragma unroll 8
            for (int ks = 0; ks < 32; ++ks) t1 = __builtin_amdgcn_mfma_f32_32x32x16_bf16(*(const LAS bf16x8*)(v1T + l31 * 520 + 16 * ks + 8 * hh), *(const LAS bf16x8*)(VT + l31 * 520 + 16 * ks + 8 * hh), t1, 0, 0, 0);
            bf16x8 tb[2];
#pragma unroll
            for (int sI = 0; sI < 2; ++sI) { u32x4 w; w.x = pk2(t1[8 * sI + 0], t1[8 * sI + 1]); w.y = pk2(t1[8 * sI + 2], t1[8 * sI + 3]); w.z = pk2(t1[8 * sI + 4], t1[8 * sI + 5]); w.w = pk2(t1[8 * sI + 6], t1[8 * sI + 7]); tb[sI] = __builtin_bit_cast(bf16x8, w); }
            const int row0 = tile * 32;
            __syncthreads();
#pragma unroll
            for (int ci = 0; ci < 2; ++ci) {
                const int ct = 2 * wave + ci;
                f32x16 z;
#pragma unroll
                for (int i = 0; i < 16; ++i) z[i] = 0.f;
#pragma unroll
                for (int sI = 0; sI < 2; ++sI) z = __builtin_amdgcn_mfma_f32_32x32x16_bf16(*(const LAS bf16x8*)(v2P + (32 * ct + l31) * 32 + (sI * 2 + hh) * 8), tb[sI], z, 0, 0, 0);
#pragma unroll
                for (int g = 0; g < 4; ++g) { const int c = 32 * ct + 8 * g + 4 * hh;
                    const f32x4 zb = *(const f32x4*)(a.in[I_V0] + (size_t)(l - 1) * 512 + c);
                    LAS u32x2* vp = (LAS u32x2*)(VT + l31 * 520 + c); const u32x2 vw = *vp, fw = fwv[ci][g];
                    const float v0_ = bflo(vw.x), v1_ = bfhi(vw.x), v2_ = bflo(vw.y), v3_ = bfhi(vw.y), f0 = bflo(fw.x), f1 = bfhi(fw.x), f2 = bflo(fw.y), f3 = bfhi(fw.y);
                    u32x2 ow; ow.x = pk2(v0_ + (f0 - v0_) * sigmoidf_(z[4 * g] + zb.x), v1_ + (f1 - v1_) * sigmoidf_(z[4 * g + 1] + zb.y));
                    ow.y = pk2(v2_ + (f2 - v2_) * sigmoidf_(z[4 * g + 2] + zb.z), v3_ + (f3 - v3_) * sigmoidf_(z[4 * g + 3] + zb.w)); *vp = ow; }
            }
            __syncthreads();
#pragma unroll
            for (int rr = 0; rr < 4; ++rr) { const int tl = wave * 4 + rr; *(u32x4*)(Vb + (size_t)(row0 + tl) * 512 + c0) = *(const LAS u32x4*)(VT + tl * 520 + c0); }
        }
        __syncthreads();
        { const int row0 = tile * 32; const bool isctx = row0 >= NTL; int b, pt;
          if (!isctx) { b = row0 >> 12; pt = (CTXL + (row0 & 4095)) >> 5; } else { const int r2 = row0 - NTL; b = r2 >> 8; pt = (r2 & 255) >> 5; }
          const int hk = tid >> 8, f = (tid >> 6) & 3, ln = tid & 63, l31 = ln & 31, lh = ln >> 5;
          const size_t toff = ((size_t)((b * 2 + hk) * 136 + pt)) * 2048 + (size_t)(f * 64 + ln) * 8;
          *(u32x4*)(Kr + toff) = *(const LAS u32x4*)(ktl + l31 * 136 + hk * 64 + 16 * f + 8 * lh);
          const LAS bf16* vp = vtl + (hk * 64 + (f >> 1) * 32 + l31) * 32 + 16 * (f & 1) + 4 * lh;
          const u32x2 lo = *(const LAS u32x2*)vp, hi2 = *(const LAS u32x2*)(vp + 8);
          *(u32x4*)(Vt + toff) = (u32x4){lo.x, lo.y, hi2.x, hi2.y}; }
        __syncthreads();
    }
#undef PP_LOAD_FIRST
}

__device__ __forceinline__ bf16x8 ld_bf16x8(const bf16* p) { return *(const bf16x8*)p; }
struct AttnFrag { bf16x8 kf[4]; };
__device__ __forceinline__ void attn_load(AttnFrag& F, const bf16* ktile, int lane) {
#pragma unroll
    for (int s = 0; s < 4; ++s) F.kf[s] = ld_bf16x8(ktile + (s * 64 + lane) * 8);
}
__device__ __forceinline__ void attn_compute(f32x16 (&o)[2][2], float (&m)[2], float (&ls)[2], const bf16x8 (&qf)[2][4], const AttnFrag& F, const bf16* vtile  ,
                                             bool masked, int kj0, int qi0, int lane, int r32, int hi) {
    bf16x8 vf[2][2];
#pragma unroll
    for (int dt = 0; dt < 2; ++dt)
#pragma unroll
        for (int s2 = 0; s2 < 2; ++s2) vf[dt][s2] = ld_bf16x8(vtile + ((dt * 2 + s2) * 64 + lane) * 8);
#pragma unroll
    for (int qt = 0; qt < 2; ++qt) {
        f32x16 s;
        { const float nm = -m[qt];
#pragma unroll
          for (int i = 0; i < 16; ++i) s[i] = nm; }
#pragma unroll
        for (int ks = 0; ks < 4; ++ks) s = __builtin_amdgcn_mfma_f32_32x32x16_bf16(F.kf[ks], qf[qt][ks], s, 0, 0, 0);
        if (masked && ((kj0 + 31) - (qi0 + qt * 32) > 128 || kj0 - (qi0 + qt * 32 + 31) < -128)) {
            const int qi = qi0 + qt * 32 + r32;
#pragma unroll
            for (int i = 0; i < 16; ++i) { const int kj = kj0 + (i & 3) + 8 * (i >> 2) + 4 * hi; const int d = kj - qi; s[i] = (d <= 128 && d >= -128) ? s[i] : -1e30f; } }
        float tm = s[0];
#pragma unroll
        for (int i = 1; i < 16; ++i) tm = fmaxf(tm, s[i]);
        { float ra_, rb_; swap32(tm, tm, ra_, rb_); tm = fmaxf(ra_, rb_); }
        if (!__all(tm <= 8.0f)) {
            const float d = fmaxf(tm, 0.f), alpha = __builtin_amdgcn_exp2f(-d);
            m[qt] += d; ls[qt] *= alpha;
#pragma unroll
            for (int dt = 0; dt < 2; ++dt)
#pragma unroll
                for (int i = 0; i < 16; ++i) o[qt][dt][i] *= alpha;
#pragma unroll
            for (int i = 0; i < 16; ++i) s[i] -= d;
        }
        float ps = 0.f; float p[16];
#pragma unroll
        for (int i = 0; i < 16; ++i) { p[i] = __builtin_amdgcn_exp2f(s[i]); ps += p[i]; }
        ls[qt] += ps;
        bf16x8 pf[2];
#pragma unroll
        for (int s2 = 0; s2 < 2; ++s2) { u32x4 w; w.x = pk2(p[8 * s2 + 0], p[8 * s2 + 1]); w.y = pk2(p[8 * s2 + 2], p[8 * s2 + 3]); w.z = pk2(p[8 * s2 + 4], p[8 * s2 + 5]); w.w = pk2(p[8 * s2 + 6], p[8 * s2 + 7]); pf[s2] = __builtin_bit_cast(bf16x8, w); }
#pragma unroll
        for (int dt = 0; dt < 2; ++dt)
#pragma unroll
            for (int s2 = 0; s2 < 2; ++s2) o[qt][dt] = __builtin_amdgcn_mfma_f32_32x32x16_bf16(vf[dt][s2], pf[s2], o[qt][dt], 0, 0, 0);
    }
}

__device__ __forceinline__ void ph_attention(const Args& a, int l, int lane, int wave) {
    unsigned char* ws = a.ws;
    const bf16* Qr = (const bf16*)(ws + WS_QR); const bf16* Kr = (const bf16*)(ws + WS_KR); const bf16* Vt = (const bf16*)(ws + WS_VT); bf16* H = (bf16*)(ws + WS_H);
    const int nunits = 512 + (l == 0 ? 32 : 0);
    const int r32 = lane & 31, hi = lane >> 5, g = wave >> 1, qh = wave & 1;
    for (int un = blockIdx.x; un < nunits; un += gridDim.x) {
        const bool cq = un >= 512; int b, hkv, n;
        if (!cq) { b = un >> 6; hkv = (un >> 5) & 1; n = un & 31; } else { const int u2 = un - 512; b = u2 >> 2; hkv = (u2 >> 1) & 1; n = u2 & 1; }
        const int hq = hkv * 4 + g;
        const int qrow0 = (cq ? NTL + b * CTXL : b * SEQ) + n * 128 + qh * 64;
        bf16x8 qf[2][4];
#pragma unroll
        for (int qt = 0; qt < 2; ++qt)
#pragma unroll
            for (int s = 0; s < 4; ++s) qf[qt][s] = ld_bf16x8(Qr + (size_t)(qrow0 + qt * 32 + r32) * 512 + hq * 64 + 16 * s + 8 * hi);
        f32x16 o[2][2];
#pragma unroll
        for (int qt = 0; qt < 2; ++qt)
#pragma unroll
            for (int dt = 0; dt < 2; ++dt)
#pragma unroll
                for (int i = 0; i < 16; ++i) o[qt][dt][i] = 0.f;
        float m[2], ls[2];
        const float sk = a.in[I_SINK][l * 8 + hq] * 1.4426950408889634f;
        m[0] = sk; m[1] = sk; ls[0] = hi == 0 ? 1.0f : 0.0f; ls[1] = ls[0];
        int jmin = 2 * qh, jmax = 2 * qh + 10;
        if (!cq) { const int lo = 4 - 4 * n, hi2 = (SEQ + 128 - 128 * n) / 32; jmin = jmin > lo ? jmin : lo; jmax = jmax < hi2 ? jmax : hi2; } else { jmax = jmin; }
        const int nw = jmax - jmin, T = nw + 8;
        const size_t hbase = (size_t)((b * 2 + hkv) * 136) * 2048;
        const int wt0 = 4 + 4 * n + jmin;
        AttnFrag F0, F1;
#define ATT_TI(t) ((t) < nw ? wt0 + (t) : (t) - nw)
#define ATT_LOAD(F, t) attn_load(F, Kr + hbase + (size_t)ATT_TI(t) * 2048, lane)
#define ATT_VB(t) (Vt + hbase + (size_t)ATT_TI(t) * 2048)
        ATT_LOAD(F0, 0);
        for (int t = 0; t < T; t += 2) {
            ATT_LOAD(F1, t + 1);
            attn_compute(o, m, ls, qf, F0, ATT_VB(t), t < nw, -128 + 32 * (jmin + t), qh * 64, lane, r32, hi);
            if (t + 2 < T) ATT_LOAD(F0, t + 2);
            attn_compute(o, m, ls, qf, F1, ATT_VB(t + 1), t + 1 < nw, -128 + 32 * (jmin + t + 1), qh * 64, lane, r32, hi);
        }
#undef ATT_TI
#undef ATT_VB
#undef ATT_LOAD
#pragma unroll
        for (int qt = 0; qt < 2; ++qt) {
            float lt; { float ra_, rb_; swap32(ls[qt], ls[qt], ra_, rb_); lt = ra_ + rb_; } const float inv = 1.0f / lt;
            bf16* orow = H + (size_t)(qrow0 + qt * 32 + r32) * DM + hq * 64;
#pragma unroll
            for (int dt = 0; dt < 2; ++dt)
#pragma unroll
                for (int g4 = 0; g4 < 4; ++g4) { u32x2 w; w.x = pk2(o[qt][dt][4 * g4 + 0] * inv, o[qt][dt][4 * g4 + 1] * inv); w.y = pk2(o[qt][dt][4 * g4 + 2] * inv, o[qt][dt][4 * g4 + 3] * inv);
                    *(u32x2*)(orow + dt * 32 + 8 * g4 + 4 * hi) = w; }
        }
    }
}

constexpr int SG = 4;
constexpr int SVEC = 384;
constexpr int SCAN_WLDS = SG * SVEC * 4;
struct ScanRaw { unsigned short kx[SG], rx[SG], ax[SG], wx[SG], vx[SG]; float rn[SG]; };

__device__ __forceinline__ void scan_load(const Args& a, int l, int b, int h, int dir, int s0, ScanRaw& R, int lane) {
    const bf16* Rb = (const bf16*)(a.ws + WS_R); const bf16* Kb = (const bf16*)(a.ws + WS_K); const bf16* Vb = (const bf16*)(a.ws + (l == 0 ? WS_V0 : WS_V1));
    const bf16* LW = (const bf16*)(a.ws + WS_P); const float* KN = (const float*)(a.ws + WS_KN);
    const int hc = h * 64 + lane;
#pragma unroll
    for (int gi = 0; gi < SG; ++gi) {
        const int s = s0 + gi, pos = dir == 0 ? s : (s < CTXL ? CTXL - 1 - s : POSN + CTXL - 1 - s), row = row_of(b, pos);
        const unsigned o5 = (unsigned)(row * 512 + hc), ol = (unsigned)(row * LWC + dir * 512 + hc);
        R.kx[gi] = Kb[o5]; R.rx[gi] = Rb[o5]; R.vx[gi] = Vb[o5];
        R.wx[gi] = LW[ol]; R.ax[gi] = LW[ol + 1024u]; R.rn[gi] = KN[row * 8 + h];
    }
}
__device__ __forceinline__ void scan_write(const ScanRaw& R, float kkw, float kaw, float w0b, float a0b, LAS float* wl, int lane, float& gam, bool last_of_16) {
#pragma unroll
    for (int gi = 0; gi < SG; ++gi) {
        const float kxf = bf2f(R.kx[gi]);
        const float wv = __expf(-0.60653066f * sigmoidf_(bf2f(R.wx[gi]) + w0b)), av = sigmoidf_(bf2f(R.ax[gi]) + a0b);
        const float kk = kxf * kkw * R.rn[gi];
        const float kd = kxf * (1.0f + (av - 1.0f) * kaw), bb = kk * av;
        const float kks = kk * gam;
        gam *= wv;
        const float ig = __builtin_amdgcn_rcpf(gam);
        LAS float* p = wl + gi * SVEC + lane;
        const float rf = bf2f(R.rx[gi]);
        p[0] = gam; p[64] = __builtin_bit_cast(float, pk2(kd * ig, bb * ig)); p[128] = kks; p[256] = rf * gam; p[320] = bf2f(R.vx[gi]);
        LAS bf16* fr = (LAS bf16*)(wl + gi * SVEC + 192);
        const int fo = ((((lane >> 5) * 2 + ((lane >> 4) & 1)) * 2 + ((lane >> 2) & 1)) * 8) + 4 * ((lane >> 3) & 1) + (lane & 3);
        fr[fo] = f2bf1((last_of_16 && gi == SG - 1) ? rf : rf * gam); fr[64 + fo] = f2bf1(kks);
    }
    if (last_of_16) gam = 1.0f;
}
__device__ __forceinline__ void fmac_(float& acc, float x, float y) { asm("v_fmac_f32 %0, %1, %2" : "+v"(acc) : "v"(x), "v"(y)); }
__device__ __forceinline__ float fma_(float x, float y, float z) { float d; asm("v_fma_f32 %0, %1, %2, %3" : "=v"(d) : "v"(x), "v"(y), "v"(z)); return d; }
__device__ __forceinline__ float mul_(float x, float y) { float d; asm("v_mul_f32 %0, %1, %2" : "=v"(d) : "v"(x), "v"(y)); return d; }
__device__ __forceinline__ void dot4_(float& acc, float s0, float s1, float s2, float s3, f32x4 k) {
    asm("v_fmac_f32 %0, %1, %5\n\tv_fmac_f32 %0, %2, %6\n\tv_fmac_f32 %0, %3, %7\n\tv_fmac_f32 %0, %4, %8"
        : "+v"(acc) : "v"(s0), "v"(s1), "v"(s2), "v"(s3), "v"(k.x), "v"(k.y), "v"(k.z), "v"(k.w));
}
__device__ __forceinline__ void dot4x4_(float& a0, float& a1, float& a2, float& a3, const float* s0, const float* s1, const float* s2, const float* s3, f32x4 k) {
    asm("v_fmac_f32 %0, %4, %20\n\tv_fmac_f32 %1, %8, %20\n\tv_fmac_f32 %2, %12, %20\n\tv_fmac_f32 %3, %16, %20\n\t"
        "v_fmac_f32 %0, %5, %21\n\tv_fmac_f32 %1, %9, %21\n\tv_fmac_f32 %2, %13, %21\n\tv_fmac_f32 %3, %17, %21\n\t"
        "v_fmac_f32 %0, %6, %22\n\tv_fmac_f32 %1, %10, %22\n\tv_fmac_f32 %2, %14, %22\n\tv_fmac_f32 %3, %18, %22\n\t"
        "v_fmac_f32 %0, %7, %23\n\tv_fmac_f32 %1, %11, %23\n\tv_fmac_f32 %2, %15, %23\n\tv_fmac_f32 %3, %19, %23"
        : "+v"(a0), "+v"(a1), "+v"(a2), "+v"(a3)
        : "v"(s0[0]), "v"(s0[1]), "v"(s0[2]), "v"(s0[3]), "v"(s1[0]), "v"(s1[1]), "v"(s1[2]), "v"(s1[3]),
          "v"(s2[0]), "v"(s2[1]), "v"(s2[2]), "v"(s2[3]), "v"(s3[0]), "v"(s3[1]), "v"(s3[2]), "v"(s3[3]), "v"(k.x), "v"(k.y), "v"(k.z), "v"(k.w));
}
__device__ __forceinline__ void upd4_p(float& s0, float& s1, float& s2, float& s3, float d, f32x4 w, f32x4 b) {
    float t0, t1, t2, t3;
    asm("v_mul_f32 %4, %8, %13\n\tv_mul_f32 %5, %8, %14\n\tv_mul_f32 %6, %8, %15\n\tv_mul_f32 %7, %8, %16\n\t"
        "v_fma_f32 %0, %0, %9, %4\n\tv_fma_f32 %1, %1, %10, %5\n\tv_fma_f32 %2, %2, %11, %6\n\tv_fma_f32 %3, %3, %12, %7"
        : "+v"(s0), "+v"(s1), "+v"(s2), "+v"(s3), "=&v"(t0), "=&v"(t1), "=&v"(t2), "=&v"(t3)
        : "v"(d), "v"(w.x), "v"(w.y), "v"(w.z), "v"(w.w), "v"(b.x), "v"(b.y), "v"(b.z), "v"(b.w));
}
__device__ __forceinline__ void upd4_l(float& s0, float& s1, float& s2, float& s3, float d, float v, f32x4 w, f32x4 k, f32x4 b) {
    float t0, t1, t2, t3;
    asm("v_mul_f32 %4, %8, %14\n\tv_mul_f32 %5, %8, %15\n\tv_mul_f32 %6, %8, %16\n\tv_mul_f32 %7, %8, %17\n\t"
        "v_fmac_f32 %4, %9, %18\n\tv_fmac_f32 %5, %9, %19\n\tv_fmac_f32 %6, %9, %20\n\tv_fmac_f32 %7, %9, %21\n\t"
        "v_fma_f32 %0, %0, %10, %4\n\tv_fma_f32 %1, %1, %11, %5\n\tv_fma_f32 %2, %2, %12, %6\n\tv_fma_f32 %3, %3, %13, %7"
        : "+v"(s0), "+v"(s1), "+v"(s2), "+v"(s3), "=&v"(t0), "=&v"(t1), "=&v"(t2), "=&v"(t3)
        : "v"(d), "v"(v), "v"(w.x), "v"(w.y), "v"(w.z), "v"(w.w), "v"(b.x), "v"(b.y), "v"(b.z), "v"(b.w), "v"(k.x), "v"(k.y), "v"(k.z), "v"(k.w));
}
__device__ __forceinline__ float qsum(float x) {
    float r;
    asm("s_nop 1\n\tv_add_f32_dpp %0, %1, %1 quad_perm:[1,0,3,2] row_mask:0xf bank_mask:0xf" : "=v"(r) : "v"(x));
    asm("s_nop 1\n\tv_add_f32_dpp %0, %1, %1 quad_perm:[2,3,0,1] row_mask:0xf bank_mask:0xf" : "=v"(x) : "v"(r));
    return x;
}

__device__ __forceinline__ bf16x8 mk_frag(unsigned w0) { const u32x4 w = {w0, 0u, 0u, 0u}; return __builtin_bit_cast(bf16x8, w); }
__device__ __forceinline__ void ph_scan1(const Args& a, int l, LAS unsigned char* lds, int lane, int wave) {
    LAS float* wl = (LAS float*)(lds + wave * SCAN_WLDS);
    float* PC = (float*)(a.ws + WS_PC); float* LC = (float*)(a.ws + WS_LC);
    const int gw = blockIdx.x * 8 + wave, NGW = gridDim.x * 8;
    const int l31 = lane & 31, hh = lane >> 5;
    for (int item = gw; item < 2048; item += NGW) {
        const int c = item & 15, dir = (item >> 4) & 1, h = (item >> 5) & 7, b = item >> 8;
        if (c == NCH - 1) continue;
        const int hc = h * 64 + lane;
        const float kkw = a.in[I_KK][l * 512 + hc], kaw = a.in[I_KA][l * 512 + hc];
        const float w0b = a.in[I_W0][(l * 2 + dir) * 512 + hc], a0b = a.in[I_A0][(l * 2 + dir) * 512 + hc];
        f32x16 CP[2][2], CL[2][2];
        { int ln = lane; asm volatile("" : "+v"(ln));
          const int dg = (ln & 31) - 4 * (ln >> 5);
#pragma unroll
          for (int tr = 0; tr < 2; ++tr)
#pragma unroll
            for (int tc = 0; tc < 2; ++tc)
#pragma unroll
                for (int r = 0; r < 16; ++r) { CP[tr][tc][r] = (tr == tc && dg == (r & 3) + 8 * (r >> 2)) ? 1.0f : 0.0f; CL[tr][tc][r] = 0.f; } }
        ScanRaw R; float gam = 1.0f;
        scan_load(a, l, b, h, dir, c * CHL, R, lane);
        for (int s0 = c * CHL; s0 < (c + 1) * CHL; s0 += SG) {
            const bool renorm = (((s0 - c * CHL) >> 2) & 3) == 3;
            __builtin_amdgcn_sched_barrier(0);
            scan_write(R, kkw, kaw, w0b, a0b, wl, lane, gam, renorm);
            if (s0 + SG < (c + 1) * CHL) scan_load(a, l, b, h, dir, s0 + SG, R, lane);
            __builtin_amdgcn_sched_barrier(0);
#pragma unroll 1
            for (int gi = 0; gi < SG; ++gi) {
                const LAS float* base = wl + gi * SVEC;
                const LAS f32x4* pv = (const LAS f32x4*)(base + 4 * hh);
                f32x4 KK[2][4];
#pragma unroll
                for (int tr = 0; tr < 2; ++tr)
#pragma unroll
                    for (int g = 0; g < 4; ++g) KK[tr][g] = pv[32 + 8 * tr + 2 * g];
                float aop[2], vrr[2];
#pragma unroll
                for (int t = 0; t < 2; ++t) { aop[t] = base[64 + 32 * t + l31]; vrr[t] = base[320 + 32 * t + l31]; }
                __builtin_amdgcn_sched_barrier(0);
                const bf16x8 af[2] = {mk_frag(hh ? 0u : __builtin_bit_cast(unsigned, aop[0])), mk_frag(hh ? 0u : __builtin_bit_cast(unsigned, aop[1]))};
                float ra, rb;
                float dp[2];
#pragma unroll
                for (int tc = 0; tc < 2; ++tc) { float p0 = 0.f, p1 = 0.f;
#pragma unroll
                    for (int g = 0; g < 4; ++g)
#pragma unroll
                        for (int i = 0; i < 4; ++i) { p0 = __builtin_fmaf(CP[0][tc][4 * g + i], KK[0][g][i], p0); p1 = __builtin_fmaf(CP[1][tc][4 * g + i], KK[1][g][i], p1); }
                    dp[tc] = p0 + p1; }
                float dp0, dp1;
                swap32(dp[0], dp[1], ra, rb); { const float sd = ra + rb; swap32(sd, sd, dp0, dp1); }
                const bf16x8 bp0 = mk_frag(hh ? 0u : pk2(0.f, -dp0)), bp1 = mk_frag(hh ? 0u : pk2(0.f, -dp1));
                __builtin_amdgcn_sched_barrier(0);
                CP[0][0] = __builtin_amdgcn_mfma_f32_32x32x16_bf16(af[0], bp0, CP[0][0], 0, 0, 0);
                CP[1][0] = __builtin_amdgcn_mfma_f32_32x32x16_bf16(af[1], bp0, CP[1][0], 0, 0, 0);
                CP[0][1] = __builtin_amdgcn_mfma_f32_32x32x16_bf16(af[0], bp1, CP[0][1], 0, 0, 0);
                CP[1][1] = __builtin_amdgcn_mfma_f32_32x32x16_bf16(af[1], bp1, CP[1][1], 0, 0, 0);
                __builtin_amdgcn_sched_barrier(0);
                float dl[2];
#pragma unroll
                for (int tc = 0; tc < 2; ++tc) { float q0 = 0.f, q1 = 0.f;
#pragma unroll
                    for (int g = 0; g < 4; ++g)
#pragma unroll
                        for (int i = 0; i < 4; ++i) { q0 = __builtin_fmaf(CL[0][tc][4 * g + i], KK[0][g][i], q0); q1 = __builtin_fmaf(CL[1][tc][4 * g + i], KK[1][g][i], q1); }
                    dl[tc] = q0 + q1; }
                float dl0, dl1;
                swap32(dl[0], dl[1], ra, rb); { const float sd = ra + rb; swap32(sd, sd, dl0, dl1); }
                const bf16x8 bl0 = mk_frag(hh ? 0u : pk2(vrr[0], -dl0)), bl1 = mk_frag(hh ? 0u : pk2(vrr[1], -dl1));
                __builtin_amdgcn_sched_barrier(0);
                CL[0][0] = __builtin_amdgcn_mfma_f32_32x32x16_bf16(af[0], bl0, CL[0][0], 0, 0, 0);
                CL[1][0] = __builtin_amdgcn_mfma_f32_32x32x16_bf16(af[1], bl0, CL[1][0], 0, 0, 0);
                CL[0][1] = __builtin_amdgcn_mfma_f32_32x32x16_bf16(af[0], bl1, CL[0][1], 0, 0, 0);
                CL[1][1] = __builtin_amdgcn_mfma_f32_32x32x16_bf16(af[1], bl1, CL[1][1], 0, 0, 0);
                __builtin_amdgcn_sched_barrier(0);
                if (renorm && gi == SG - 1) {
#pragma unroll
                    for (int tr = 0; tr < 2; ++tr)
#pragma unroll
                        for (int g = 0; g < 4; ++g) { const f32x4 G = pv[8 * tr + 2 * g];
#pragma unroll
                            for (int tc = 0; tc < 2; ++tc)
#pragma unroll
                                for (int i = 0; i < 4; ++i) { CP[tr][tc][4 * g + i] *= G[i]; CL[tr][tc][4 * g + i] *= G[i]; } }
                }
            }
        }
        int item_o = item; asm volatile("" : "+s"(item_o));
#pragma unroll
        for (int tc = 0; tc < 2; ++tc) { float* po = PC + ((size_t)item_o * 64 + 32 * tc + l31) * 64 + 4 * hh; float* lo = LC + ((size_t)item_o * 64 + 32 * tc + l31) * 64 + 4 * hh;
#pragma unroll
            for (int tr = 0; tr < 2; ++tr)
#pragma unroll
                for (int g = 0; g < 4; ++g) { *(f32x4*)(po + 32 * tr + 8 * g) = (f32x4){CP[tr][tc][4 * g], CP[tr][tc][4 * g + 1], CP[tr][tc][4 * g + 2], CP[tr][tc][4 * g + 3]};
                    *(f32x4*)(lo + 32 * tr + 8 * g) = (f32x4){CL[tr][tc][4 * g], CL[tr][tc][4 * g + 1], CL[tr][tc][4 * g + 2], CL[tr][tc][4 * g + 3]}; } }
    }
}

__device__ __forceinline__ void split_bf16x8(const float (&x)[8], bf16x8& hi, bf16x8& lo) {
    u32x4 h, l;
    h.x = pk2(x[0], x[1]); h.y = pk2(x[2], x[3]); h.z = pk2(x[4], x[5]); h.w = pk2(x[6], x[7]);
    l.x = pk2(x[0] - bflo(h.x), x[1] - bfhi(h.x)); l.y = pk2(x[2] - bflo(h.y), x[3] - bfhi(h.y)); l.z = pk2(x[4] - bflo(h.z), x[5] - bfhi(h.z)); l.w = pk2(x[6] - bflo(h.w), x[7] - bfhi(h.w));
    hi = __builtin_bit_cast(bf16x8, h); lo = __builtin_bit_cast(bf16x8, l);
}
template <int VAR> __device__ __forceinline__ void ph_scan2(const Args& a, LAS unsigned char* lds, int tid, int lane, int wave) {
    const float* PC = (const float*)(a.ws + WS_PC); float* LC = (float*)(a.ws + WS_LC);
    const int l31 = lane & 31, hh = lane >> 5;
    if (wave != 0) {
        for (int u = blockIdx.x; u < 256; u += gridDim.x) {
            const int sid = u >> 1, t = (wave - 1) * 64 + lane; float sink = 0.f;
#pragma unroll
            for (int k = 0; k < 6; ++k) { const int id = t + 448 * k;
                if (id < 14 * 192) { const int c = 1 + id / 192, r = id % 192;
                    const float* pl = r < 128 ? PC + (size_t)(sid * 16 + c) * 4096 + r * 32 : LC + ((size_t)(sid * 16 + c) * 64 + 32 * (u & 1)) * 64 + (r - 128) * 32;
                    sink += *pl; } }
            asm volatile("" :: "v"(sink));
        }
        return;
    }
    for (int u = blockIdx.x; u < 256; u += gridDim.x) {
        const int sid = u >> 1, i = 32 * (u & 1) + l31;
        f32x16 acc[2];
#pragma unroll
        for (int ct = 0; ct < 2; ++ct)
#pragma unroll
            for (int g = 0; g < 4; ++g) { const f32x4 x = *(const f32x4*)(LC + ((size_t)(sid * 16) * 64 + i) * 64 + 32 * ct + 8 * g + 4 * hh); acc[ct][4 * g] = x.x; acc[ct][4 * g + 1] = x.y; acc[ct][4 * g + 2] = x.z; acc[ct][4 * g + 3] = x.w; }
        float pr[8][8]; f32x4 lr[2][4];
#define SC2_LOADP(co_, pc_) do { _Pragma("unroll") for (int k_ = 0; k_ < 4; ++k_) { const float* pb_ = (pc_) + (16 * k_ + 4 * hh) * 64 + 32 * (co_) + l31; \
            _Pragma("unroll") for (int jj = 0; jj < 8; ++jj) pr[(co_) * 4 + k_][jj] = pb_[((jj & 3) + 8 * (jj >> 2)) * 64]; } } while (0)
#define SC2_LOADL(cc_) do { const float* lp_ = LC + ((size_t)(sid * 16 + (cc_)) * 64 + i) * 64 + 4 * hh; _Pragma("unroll") for (int ct = 0; ct < 2; ++ct) _Pragma("unroll") for (int g = 0; g < 4; ++g) lr[ct][g] = *(const f32x4*)(lp_ + 32 * ct + 8 * g); } while (0)
        { const float* pc = PC + (size_t)(sid * 16 + 1) * 4096; SC2_LOADP(0, pc); SC2_LOADP(1, pc); SC2_LOADL(1); }
#pragma unroll 1
        for (int c = 1; c < NCH - 1; ++c) {
            const bool more = c + 1 < NCH - 1;
            const float* pcn = PC + (size_t)(sid * 16 + c + 1) * 4096;
            bf16x8 bh[4], bl[4];
#pragma unroll
            for (int ck = 0; ck < 2; ++ck)
#pragma unroll
                for (int sI = 0; sI < 2; ++sI) { float x[8];
#pragma unroll
                    for (int jj = 0; jj < 8; ++jj) x[jj] = acc[ck][8 * sI + jj];
                    split_bf16x8(x, bh[ck * 2 + sI], bl[ck * 2 + sI]); }
#pragma unroll
            for (int ct = 0; ct < 2; ++ct)
#pragma unroll
                for (int g = 0; g < 4; ++g) { acc[ct][4 * g] = lr[ct][g].x; acc[ct][4 * g + 1] = lr[ct][g].y; acc[ct][4 * g + 2] = lr[ct][g].z; acc[ct][4 * g + 3] = lr[ct][g].w; }
            __builtin_amdgcn_sched_barrier(0);
            if (more) SC2_LOADL(c + 1);
#pragma unroll
            for (int co = 0; co < 2; ++co) {
                bf16x8 ah[4], al[4];
#pragma unroll
                for (int k = 0; k < 4; ++k) split_bf16x8(pr[co * 4 + k], ah[k], al[k]);
                __builtin_amdgcn_sched_barrier(0);
                if (more) { if (co == 0) SC2_LOADP(0, pcn); else SC2_LOADP(1, pcn); }
                __builtin_amdgcn_sched_barrier(0);
#pragma unroll
                for (int k = 0; k < 4; ++k) {
                    acc[co] = __builtin_amdgcn_mfma_f32_32x32x16_bf16(ah[k], bh[k], acc[co], 0, 0, 0);
                    acc[co] = __builtin_amdgcn_mfma_f32_32x32x16_bf16(ah[k], bl[k], acc[co], 0, 0, 0);
                    acc[co] = __builtin_amdgcn_mfma_f32_32x32x16_bf16(al[k], bh[k], acc[co], 0, 0, 0); }
                __builtin_amdgcn_sched_barrier(0);
            }
            float* lcp = LC + ((size_t)(sid * 16 + c) * 64 + i) * 64 + 4 * hh;
#pragma unroll
            for (int ct = 0; ct < 2; ++ct)
#pragma unroll
                for (int g = 0; g < 4; ++g) if (VAR == 0 || acc[ct][4 * g] == 12345.678f) *(f32x4*)(lcp + 32 * ct + 8 * g) = (f32x4){acc[ct][4 * g], acc[ct][4 * g + 1], acc[ct][4 * g + 2], acc[ct][4 * g + 3]};
        }
#undef SC2_LOADP
#undef SC2_LOADL
    }
}

#ifndef PVAR
#define PVAR 0
#endif
template <int VAR> __device__ __forceinline__ void ph_scan3(const Args& a, int l, LAS unsigned char* lds, int lane, int wave) {
    LAS float* wl = (LAS float*)(lds + wave * (2 * SCAN_WLDS));
    LAS float* zer = (LAS float*)(lds + 8 * 2 * SCAN_WLDS + wave * 128);
    const float* LC = (const float*)(a.ws + WS_LC); bf16* Y = (bf16*)(a.ws + WS_Y);
    const int gw = blockIdx.x * 8 + wave, NGW = gridDim.x * 8;
    const int l31 = lane & 31, hh = lane >> 5;
    if (lane < 32) zer[lane] = 0.f;
    for (int item = gw; item < 2048; item += NGW) {
        if ((VAR & 16) && wave >= 4) continue;
        const int c = item & 15, dir = (item >> 4) & 1, h = (item >> 5) & 7, b = item >> 8;
        const int hc = h * 64 + lane;
        const float kkw = a.in[I_KK][l * 512 + hc], kaw = a.in[I_KA][l * 512 + hc];
        const float w0b = a.in[I_W0][(l * 2 + dir) * 512 + hc], a0b = a.in[I_A0][(l * 2 + dir) * 512 + hc];
        f32x16 C[2][2];
        if (c == 0) {
#pragma unroll
            for (int tr = 0; tr < 2; ++tr)
#pragma unroll
                for (int tc = 0; tc < 2; ++tc)
#pragma unroll
                    for (int i = 0; i < 16; ++i) C[tr][tc][i] = 0.f;
        } else {
#pragma unroll
            for (int tc = 0; tc < 2; ++tc) { const float* si = LC + ((size_t)(item - 1) * 64 + 32 * tc + l31) * 64 + 4 * hh;
#pragma unroll
                for (int tr = 0; tr < 2; ++tr)
#pragma unroll
                    for (int g = 0; g < 4; ++g) { const f32x4 x = *(const f32x4*)(si + 32 * tr + 8 * g); C[tr][tc][4 * g] = x.x; C[tr][tc][4 * g + 1] = x.y; C[tr][tc][4 * g + 2] = x.z; C[tr][tc][4 * g + 3] = x.w; } } }
        ScanRaw R; float gam = 1.0f;
        scan_load(a, l, b, h, dir, c * CHL, R, lane);
        int prow = 0;
        for (int s0 = c * CHL, grp = 0; s0 < (c + 1) * CHL; s0 += SG, ++grp) {
            const bool renorm = (grp & 3) == 3;
            LAS float* wg = wl + (grp & 1) * (SG * SVEC);
            __builtin_amdgcn_sched_barrier(0);
            scan_write(R, kkw, kaw, w0b, a0b, wg, lane, gam, renorm);
            if (s0 + SG < (c + 1) * CHL) scan_load(a, l, b, h, dir, s0 + SG, R, lane);
            __builtin_amdgcn_sched_barrier(0);
#pragma unroll 1
            for (int gi = 0; gi < SG; ++gi) {
                const LAS float* base = wg + gi * SVEC;
                const LAS float* pbase = gi > 0 ? base - SVEC : wl + ((grp & 1) ^ 1) * (SG * SVEC) + (SG - 1) * SVEC;
                const bool first = (grp == 0 && gi == 0);
                const LAS bf16* asrc = (l31 == 0) ? (first ? (const LAS bf16*)zer : (const LAS bf16*)(pbase + 192)) : (l31 == 1 ? (const LAS bf16*)(base + 192) + 64 : (const LAS bf16*)zer);
                const int astep = (l31 < 2 && !(l31 == 0 && first)) ? 16 : 0;
                bf16x8 afr[4];
#pragma unroll
                for (int f = 0; f < 4; ++f) afr[f] = *(const LAS bf16x8*)(asrc + (f * astep) + (l31 < 2 && !(l31 == 0 && first) ? hh * 8 : 0));
                float aop[2], vrr[2];
#pragma unroll
                for (int t = 0; t < 2; ++t) { aop[t] = base[64 + 32 * t + l31]; vrr[t] = base[320 + 32 * t + l31]; }
                __builtin_amdgcn_sched_barrier(0);
                f32x16 out[2];
#pragma unroll
                for (int tc = 0; tc < 2; ++tc) {
#pragma unroll
                    for (int i = 0; i < 16; ++i) out[tc][i] = 0.f;
#pragma unroll
                    for (int tr = 0; tr < 2; ++tr)
#pragma unroll
                        for (int sI = 0; sI < 2; ++sI) { u32x4 w; w.x = pk2(C[tr][tc][8 * sI + 0], C[tr][tc][8 * sI + 1]); w.y = pk2(C[tr][tc][8 * sI + 2], C[tr][tc][8 * sI + 3]);
                            w.z = pk2(C[tr][tc][8 * sI + 4], C[tr][tc][8 * sI + 5]); w.w = pk2(C[tr][tc][8 * sI + 6], C[tr][tc][8 * sI + 7]);
                            out[tc] = __builtin_amdgcn_mfma_f32_32x32x16_bf16(afr[tr * 2 + sI], __builtin_bit_cast(bf16x8, w), out[tc], 0, 0, 0); }
                }
                if (!first && lane < 32 && (VAR == 0 || out[0][0] == 12345.678f)) {
                    bf16* yp = Y + ((size_t)dir * NT + prow) * 512 + h * 64 + l31;
                    yp[0] = f2bf1(out[0][0]); yp[32] = f2bf1(out[1][0]); }
                const bf16x8 bop0 = mk_frag(hh ? 0u : pk2(vrr[0], -out[0][1])), bop1 = mk_frag(hh ? 0u : pk2(vrr[1], -out[1][1]));
                const bf16x8 af[2] = {mk_frag(hh ? 0u : __builtin_bit_cast(unsigned, aop[0])), mk_frag(hh ? 0u : __builtin_bit_cast(unsigned, aop[1]))};
                C[0][0] = __builtin_amdgcn_mfma_f32_32x32x16_bf16(af[0], bop0, C[0][0], 0, 0, 0);
                C[1][0] = __builtin_amdgcn_mfma_f32_32x32x16_bf16(af[1], bop0, C[1][0], 0, 0, 0);
                C[0][1] = __builtin_amdgcn_mfma_f32_32x32x16_bf16(af[0], bop1, C[0][1], 0, 0, 0);
                C[1][1] = __builtin_amdgcn_mfma_f32_32x32x16_bf16(af[1], bop1, C[1][1], 0, 0, 0);
                if (renorm && gi == SG - 1) {
                    const LAS f32x4* pv = (const LAS f32x4*)(base + 4 * hh);
#pragma unroll
                    for (int tr = 0; tr < 2; ++tr)
#pragma unroll
                        for (int g = 0; g < 4; ++g) { const f32x4 G = pv[8 * tr + 2 * g];
#pragma unroll
                            for (int tc = 0; tc < 2; ++tc)
#pragma unroll
                                for (int i = 0; i < 4; ++i) C[tr][tc][4 * g + i] *= G[i]; }
                }
                const int sx = s0 + gi, pos = dir == 0 ? sx : (sx < CTXL ? CTXL - 1 - sx : POSN + CTXL - 1 - sx);
                prow = row_of(b, pos);
            }
        }
        {
            const LAS float* pbase = wl + (((CHL / SG - 1) & 1)) * (SG * SVEC) + (SG - 1) * SVEC;
            const LAS bf16* asrc = (l31 == 0) ? (const LAS bf16*)(pbase + 192) : (const LAS bf16*)zer;
            bf16x8 afr[4];
#pragma unroll
            for (int f = 0; f < 4; ++f) afr[f] = *(const LAS bf16x8*)(asrc + (l31 == 0 ? f * 16 + hh * 8 : 0));
            f32x16 out[2];
#pragma unroll
            for (int tc = 0; tc < 2; ++tc) {
#pragma unroll
                for (int i = 0; i < 16; ++i) out[tc][i] = 0.f;
#pragma unroll
                for (int tr = 0; tr < 2; ++tr)
#pragma unroll
                    for (int sI = 0; sI < 2; ++sI) { u32x4 w; w.x = pk2(C[tr][tc][8 * sI + 0], C[tr][tc][8 * sI + 1]); w.y = pk2(C[tr][tc][8 * sI + 2], C[tr][tc][8 * sI + 3]);
                        w.z = pk2(C[tr][tc][8 * sI + 4], C[tr][tc][8 * sI + 5]); w.w = pk2(C[tr][tc][8 * sI + 6], C[tr][tc][8 * sI + 7]);
                        out[tc] = __builtin_amdgcn_mfma_f32_32x32x16_bf16(afr[tr * 2 + sI], __builtin_bit_cast(bf16x8, w), out[tc], 0, 0, 0); }
            }
            if (lane < 32 && (VAR == 0 || out[0][0] == 12345.678f)) { bf16* yp = Y + ((size_t)dir * NT + prow) * 512 + h * 64 + l31; yp[0] = f2bf1(out[0][0]); yp[32] = f2bf1(out[1][0]); }
        }
    }
}

constexpr int BT = 16, FRS = 72;
constexpr int B_FRK = 0, B_FRR = 2304, B_FRD = 4608, B_FRB = 6912;
constexpr int B_KMD = 9216, B_KMB = 11264;
constexpr int B_GT = 13312;
constexpr int B_GAM = 17408;
constexpr int B_WLDS = 17664;

template <int T0> __device__ __forceinline__ void blk_stage(const ScanRaw& R, float kkw, float kaw, float w0b, float a0b, LAS unsigned char* wb, int lane, int fo, float& gam, float (&V)[BT], unsigned (&kc)[4]) {
    unsigned lowk[SG], lowb[SG];
#pragma unroll
    for (int gi = 0; gi < SG; ++gi) {
        constexpr int dummy = 0; (void)dummy;
        const int t = T0 + gi;
        const float kxf = bf2f(R.kx[gi]);
        const float wv = __expf(-0.60653066f * sigmoidf_(bf2f(R.wx[gi]) + w0b)), av = sigmoidf_(bf2f(R.ax[gi]) + a0b);
        const float kk = kxf * kkw * R.rn[gi];
        const float kd = kxf * (1.0f + (av - 1.0f) * kaw), bb = kk * av;
        const float kks = kk * gam;
        gam *= wv;
        const float ig = __builtin_amdgcn_rcpf(gam);
        const unsigned pkb = pk2(kd * ig, bb * ig), prk = pk2(bf2f(R.rx[gi]) * gam, kks);
        ((LAS bf16*)(wb + B_FRD))[t * FRS + fo] = (bf16)(pkb & 0xffffu); ((LAS bf16*)(wb + B_FRB))[t * FRS + fo] = (bf16)(pkb >> 16);
        ((LAS bf16*)(wb + B_FRR))[t * FRS + fo] = (bf16)(prk & 0xffffu); ((LAS bf16*)(wb + B_FRK))[t * FRS + fo] = (bf16)(prk >> 16);
        lowk[gi] = pkb & 0xffffu; lowb[gi] = pkb >> 16;
        V[t] = bf2f(R.vx[gi]);
        if (t == BT - 1) { ((LAS float*)(wb + B_GAM))[lane] = gam; gam = 1.0f; }
    }
    const unsigned k0 = lowk[0] | (lowk[1] << 16), k1 = lowk[2] | (lowk[3] << 16), b0 = lowb[0] | (lowb[1] << 16), b1 = lowb[2] | (lowb[3] << 16);
    if ((T0 & 4) == 0) { kc[0] = k0; kc[1] = k1; kc[2] = b0; kc[3] = b1; }
    else { *(LAS u32x4*)(wb + B_KMD + ((T0 >> 3) * 64 + lane) * 16) = (u32x4){kc[0], kc[1], k0, k1}; *(LAS u32x4*)(wb + B_KMB + ((T0 >> 3) * 64 + lane) * 16) = (u32x4){kc[2], kc[3], b0, b1}; }
}
__device__ __forceinline__ void blk_stepA(const f32x16 (&C)[2][2], LAS unsigned char* wb, int l31, int hh, f32x16 (&out)[2]) {
    const LAS bf16* arow = (const LAS bf16*)(wb + (l31 < 16 ? B_FRR : B_FRK)) + (l31 & 15) * FRS + hh * 8;
    bf16x8 afr[4];
#pragma unroll
    for (int f = 0; f < 4; ++f) afr[f] = *(const LAS bf16x8*)(arow + f * 16);
#pragma unroll
    for (int tc = 0; tc < 2; ++tc) {
#pragma unroll
        for (int i = 0; i < 16; ++i) out[tc][i] = 0.f;
#pragma unroll
        for (int tr = 0; tr < 2; ++tr)
#pragma unroll
            for (int sI = 0; sI < 2; ++sI) { u32x4 w; w.x = pk2(C[tr][tc][8 * sI + 0], C[tr][tc][8 * sI + 1]); w.y = pk2(C[tr][tc][8 * sI + 2], C[tr][tc][8 * sI + 3]);
                w.z = pk2(C[tr][tc][8 * sI + 4], C[tr][tc][8 * sI + 5]); w.w = pk2(C[tr][tc][8 * sI + 6], C[tr][tc][8 * sI + 7]);
                out[tc] = __builtin_amdgcn_mfma_f32_32x32x16_bf16(afr[tr * 2 + sI], __builtin_bit_cast(bf16x8, w), out[tc], 0, 0, 0); }
    }
}
__device__ __forceinline__ void blk_stepB(LAS unsigned char* wb, int l31, int hh) {
    const LAS bf16* arow = (const LAS bf16*)(wb + (l31 < 16 ? B_FRD : B_FRB)) + (l31 & 15) * FRS + hh * 8;
    const LAS bf16* brow = (const LAS bf16*)(wb + (l31 < 16 ? B_FRK : B_FRR)) + (l31 & 15) * FRS + hh * 8;
    f32x16 g;
#pragma unroll
    for (int i = 0; i < 16; ++i) g[i] = 0.f;
#pragma unroll
    for (int f = 0; f < 4; ++f) g = __builtin_amdgcn_mfma_f32_32x32x16_bf16(*(const LAS bf16x8*)(arow + f * 16), *(const LAS bf16x8*)(brow + f * 16), g, 0, 0, 0);
    LAS float* gt = (LAS float*)(wb + B_GT) + l31 * 32 + 4 * hh;
#pragma unroll
    for (int q = 0; q < 4; ++q) *(LAS f32x4*)(gt + 8 * q) = (f32x4){g[4 * q], g[4 * q + 1], g[4 * q + 2], g[4 * q + 3]};
}
__device__ __forceinline__ void blk_gather(const f32x16 (&out)[2], int rbase  , float (&X)[BT]) {
#pragma unroll
    for (int q = 0; q < 2; ++q)
#pragma unroll
        for (int i = 0; i < 4; ++i) { float ra, rb; swap32(out[0][rbase + 4 * q + i], out[1][rbase + 4 * q + i], ra, rb); X[8 * q + i] = ra; X[8 * q + 4 + i] = rb; }
}
__device__ __forceinline__ void blk_bfrag(const float (&X)[BT], float sgn, bf16x8& b0, bf16x8& b1) {
    u32x4 lo, hi, r0, r1;
    lo.x = pk2(sgn * X[0], sgn * X[1]); lo.y = pk2(sgn * X[2], sgn * X[3]); lo.z = pk2(sgn * X[4], sgn * X[5]); lo.w = pk2(sgn * X[6], sgn * X[7]);
    hi.x = pk2(sgn * X[8], sgn * X[9]); hi.y = pk2(sgn * X[10], sgn * X[11]); hi.z = pk2(sgn * X[12], sgn * X[13]); hi.w = pk2(sgn * X[14], sgn * X[15]);
#pragma unroll
    for (int d = 0; d < 4; ++d) { const unsigned ul = lo[d], uh = hi[d];
        float ra, rb; swap32(__builtin_bit_cast(float, ul), __builtin_bit_cast(float, uh), ra, rb); r0[d] = __builtin_bit_cast(unsigned, ra); r1[d] = __builtin_bit_cast(unsigned, rb); }
    b0 = __builtin_bit_cast(bf16x8, r0); b1 = __builtin_bit_cast(bf16x8, r1);
}

__device__ __forceinline__ void ph_scan3b(const Args& a, int l, LAS unsigned char* lds, int lane, int wave) {
    LAS unsigned char* wb = lds + wave * B_WLDS;
    const float* LC = (const float*)(a.ws + WS_LC); bf16* Y = (bf16*)(a.ws + WS_Y);
    const int gw = blockIdx.x * 8 + wave, NGW = gridDim.x * 8;
    const int l31 = lane & 31, hh = lane >> 5;
    const int fo = ((((lane >> 5) * 2 + ((lane >> 4) & 1)) * 2 + ((lane >> 2) & 1)) * 8) + 4 * ((lane >> 3) & 1) + (lane & 3);
    for (int item = gw; item < 2048; item += NGW) {
        const int c = item & 15, dir = (item >> 4) & 1, h = (item >> 5) & 7, b = item >> 8;
        const int hc = h * 64 + lane;
        const float kkw = a.in[I_KK][l * 512 + hc], kaw = a.in[I_KA][l * 512 + hc];
        const float w0b = a.in[I_W0][(l * 2 + dir) * 512 + hc], a0b = a.in[I_A0][(l * 2 + dir) * 512 + hc];
        f32x16 C[2][2];
        if (c == 0) {
#pragma unroll
            for (int tr = 0; tr < 2; ++tr)
#pragma unroll
                for (int tc = 0; tc < 2; ++tc)
#pragma unroll
                    for (int i = 0; i < 16; ++i) C[tr][tc][i] = 0.f;
        } else {
#pragma unroll
            for (int tc = 0; tc < 2; ++tc) { const float* si = LC + ((size_t)(item - 1) * 64 + 32 * tc + l31) * 64 + 4 * hh;
#pragma unroll
                for (int tr = 0; tr < 2; ++tr)
#pragma unroll
                    for (int g = 0; g < 4; ++g) { const f32x4 x = *(const f32x4*)(si + 32 * tr + 8 * g); C[tr][tc][4 * g] = x.x; C[tr][tc][4 * g + 1] = x.y; C[tr][tc][4 * g + 2] = x.z; C[tr][tc][4 * g + 3] = x.w; } } }
        ScanRaw R0, R1; float gam = 1.0f;
        scan_load(a, l, b, h, dir, c * CHL, R0, lane);
        scan_load(a, l, b, h, dir, c * CHL + SG, R1, lane);
#pragma unroll 1
        for (int blk = 0; blk < CHL / BT; ++blk) {
            const int s0 = c * CHL + blk * BT; const bool more = blk + 1 < CHL / BT;
            float V[BT]; unsigned kc[4];
            __builtin_amdgcn_sched_barrier(0);
            blk_stage<0>(R0, kkw, kaw, w0b, a0b, wb, lane, fo, gam, V, kc);  scan_load(a, l, b, h, dir, s0 + 2 * SG, R0, lane);
            __builtin_amdgcn_sched_barrier(0);
            blk_stage<4>(R1, kkw, kaw, w0b, a0b, wb, lane, fo, gam, V, kc);  scan_load(a, l, b, h, dir, s0 + 3 * SG, R1, lane);
            __builtin_amdgcn_sched_barrier(0);
            blk_stage<8>(R0, kkw, kaw, w0b, a0b, wb, lane, fo, gam, V, kc);  if (more) scan_load(a, l, b, h, dir, s0 + 4 * SG, R0, lane);
            __builtin_amdgcn_sched_barrier(0);
            blk_stage<12>(R1, kkw, kaw, w0b, a0b, wb, lane, fo, gam, V, kc); if (more) scan_load(a, l, b, h, dir, s0 + 5 * SG, R1, lane);
            __builtin_amdgcn_sched_barrier(0);
            f32x16 out[2];
            blk_stepB(wb, l31, hh);
            blk_stepA(C, wb, l31, hh, out);
            const LAS float* GT = (const LAS float*)(wb + B_GT);
            bf16x8 bv0, bv1, bd0, bd1, a2, a3;
            blk_bfrag(V, 1.0f, bv0, bv1);
            { const LAS float* gp = GT + (l31 ^ 16) * 32 + 8 * hh;
              const int thr = (l31 < 16 ? l31 + 1 : l31 - 16) - 8 * hh, thr3 = (l31 < 16 ? l31 + 1 : 0) - 8 * hh;
              const f32x4 x0 = *(const LAS f32x4*)gp, x1 = *(const LAS f32x4*)(gp + 4), y0 = *(const LAS f32x4*)(gp + 16), y1 = *(const LAS f32x4*)(gp + 20);
              u32x4 w2, w3;
              w2.x = pk2(0 < thr ? x0.x : 0.f, 1 < thr ? x0.y : 0.f); w2.y = pk2(2 < thr ? x0.z : 0.f, 3 < thr ? x0.w : 0.f);
              w2.z = pk2(4 < thr ? x1.x : 0.f, 5 < thr ? x1.y : 0.f); w2.w = pk2(6 < thr ? x1.z : 0.f, 7 < thr ? x1.w : 0.f);
              w3.x = pk2(0 < thr3 ? y0.x : 0.f, 1 < thr3 ? y0.y : 0.f); w3.y = pk2(2 < thr3 ? y0.z : 0.f, 3 < thr3 ? y0.w : 0.f);
              w3.z = pk2(4 < thr3 ? y1.x : 0.f, 5 < thr3 ? y1.y : 0.f); w3.w = pk2(6 < thr3 ? y1.z : 0.f, 7 < thr3 ? y1.w : 0.f);
              a2 = __builtin_bit_cast(bf16x8, w2); a3 = __builtin_bit_cast(bf16x8, w3); }
            out[0] = __builtin_amdgcn_mfma_f32_32x32x16_bf16(a2, bv0, out[0], 0, 0, 0);
            out[1] = __builtin_amdgcn_mfma_f32_32x32x16_bf16(a2, bv1, out[1], 0, 0, 0);
            float D[BT];
            blk_gather(out, 8, D);
#pragma unroll
            for (int t = 1; t < BT; ++t) {
                float acc = D[t];
                f32x4 g2[4];
#pragma unroll
                for (int q = 0; q < 4; ++q) if (4 * q < t) g2[q] = *(const LAS f32x4*)(GT + t * 32 + 16 + 4 * q);
#pragma unroll
                for (int s = 0; s < t; ++s) acc = __builtin_fmaf(-D[s], g2[s >> 2][s & 3], acc);
                D[t] = acc;
            }
            blk_bfrag(D, -1.0f, bd0, bd1);
            out[0] = __builtin_amdgcn_mfma_f32_32x32x16_bf16(a3, bd0, out[0], 0, 0, 0);
            out[1] = __builtin_amdgcn_mfma_f32_32x32x16_bf16(a3, bd1, out[1], 0, 0, 0);
#pragma unroll
            for (int rr = 0; rr < 8; ++rr) {
                const int tb = (rr & 3) + 8 * (rr >> 2);
                const int sa = s0 + tb, sb = sa + 4;
                const int posa = dir == 0 ? sa : (sa < CTXL ? CTXL - 1 - sa : POSN + CTXL - 1 - sa), posb = dir == 0 ? sb : (sb < CTXL ? CTXL - 1 - sb : POSN + CTXL - 1 - sb);
                const int row = hh ? row_of(b, posb) : row_of(b, posa);
                bf16* yp = Y + ((size_t)dir * NT + row) * 512 + h * 64 + l31;
                yp[0] = f2bf1(out[0][rr]); yp[32] = f2bf1(out[1][rr]);
            }
#pragma unroll
            for (int tr = 0; tr < 2; ++tr) {
                const bf16x8 ad = *(const LAS bf16x8*)(wb + B_KMD + (hh * 64 + 32 * tr + l31) * 16), ab = *(const LAS bf16x8*)(wb + B_KMB + (hh * 64 + 32 * tr + l31) * 16);
                C[tr][0] = __builtin_amdgcn_mfma_f32_32x32x16_bf16(ad, bv0, C[tr][0], 0, 0, 0); C[tr][0] = __builtin_amdgcn_mfma_f32_32x32x16_bf16(ab, bd0, C[tr][0], 0, 0, 0);
                C[tr][1] = __builtin_amdgcn_mfma_f32_32x32x16_bf16(ad, bv1, C[tr][1], 0, 0, 0); C[tr][1] = __builtin_amdgcn_mfma_f32_32x32x16_bf16(ab, bd1, C[tr][1], 0, 0, 0);
            }
            { const LAS f32x4* pg = (const LAS f32x4*)((const LAS float*)(wb + B_GAM) + 4 * hh);
#pragma unroll
              for (int tr = 0; tr < 2; ++tr)
#pragma unroll
                for (int g = 0; g < 4; ++g) { const f32x4 G = pg[8 * tr + 2 * g];
#pragma unroll
                    for (int tc = 0; tc < 2; ++tc)
#pragma unroll
                        for (int i = 0; i < 4; ++i) C[tr][tc][4 * g + i] *= G[i]; } }
        }
    }
}

struct ScanRaw1 { unsigned ka[SG], wv[SG]; float rn[SG]; };
__device__ __forceinline__ void scan_load1(const Args& a, int l, int b, int h, int dir, int s0, ScanRaw1& R, int lane) {
    const bf16* Kb = (const bf16*)(a.ws + WS_K); const bf16* Vb = (const bf16*)(a.ws + (l == 0 ? WS_V0 : WS_V1));
    const bf16* LW = (const bf16*)(a.ws + WS_P); const float* KN = (const float*)(a.ws + WS_KN);
    const int hc = h * 64 + lane;
#pragma unroll
    for (int gi = 0; gi < SG; ++gi) {
        const int s = s0 + gi, pos = dir == 0 ? s : (s < CTXL ? CTXL - 1 - s : POSN + CTXL - 1 - s), row = row_of(b, pos);
        const unsigned o5 = (unsigned)(row * 512 + hc), ol = (unsigned)(row * LWC + dir * 512 + hc);
        R.ka[gi] = (unsigned)Kb[o5] | ((unsigned)LW[ol + 1024u] << 16); R.wv[gi] = (unsigned)LW[ol] | ((unsigned)Vb[o5] << 16); R.rn[gi] = KN[row * 8 + h];
    }
}
template <int T0> __device__ __forceinline__ void blk_stage1(const ScanRaw1& R, float kkw, float kaw, float w0b, float a0b, LAS unsigned char* wb, int lane, int fo, float& gam, unsigned (&kc)[6]) {
    unsigned lowk[SG], lowb[SG];
#pragma unroll
    for (int gi = 0; gi < SG; ++gi) {
        const int t = T0 + gi;
        const float kxf = bflo(R.ka[gi]);
        const float wv = __expf(-0.60653066f * sigmoidf_(bflo(R.wv[gi]) + w0b)), av = sigmoidf_(bfhi(R.ka[gi]) + a0b);
        const float kk = kxf * kkw * R.rn[gi];
        const float kd = kxf * (1.0f + (av - 1.0f) * kaw), bb = kk * av;
        const float kks = kk * gam;
        gam *= wv;
        const float ig = __builtin_amdgcn_rcpf(gam);
        const unsigned pkb = pk2(kd * ig, bb * ig);
        ((LAS bf16*)(wb + B_FRD))[t * FRS + fo] = (bf16)(pkb & 0xffffu); ((LAS bf16*)(wb + B_FRB))[t * FRS + fo] = (bf16)(pkb >> 16);
        ((LAS bf16*)(wb + B_FRK))[t * FRS + fo] = f2bf1(kks);
        lowk[gi] = pkb & 0xffffu; lowb[gi] = pkb >> 16;
        if (t == BT - 1) { ((LAS float*)(wb + B_GAM))[lane] = gam; gam = 1.0f; }
    }
    const unsigned k0 = lowk[0] | (lowk[1] << 16), k1 = lowk[2] | (lowk[3] << 16), b0 = lowb[0] | (lowb[1] << 16), b1 = lowb[2] | (lowb[3] << 16);
    const unsigned v0 = (R.wv[0] >> 16) | (R.wv[1] & 0xffff0000u), v1 = (R.wv[2] >> 16) | (R.wv[3] & 0xffff0000u);
    if ((T0 & 4) == 0) { kc[0] = k0; kc[1] = k1; kc[2] = b0; kc[3] = b1; kc[4] = v0; kc[5] = v1; }
    else { *(LAS u32x4*)(wb + B_KMD + ((T0 >> 3) * 64 + lane) * 16) = (u32x4){kc[0], kc[1], k0, k1}; *(LAS u32x4*)(wb + B_KMB + ((T0 >> 3) * 64 + lane) * 16) = (u32x4){kc[2], kc[3], b0, b1};
           *(LAS u32x4*)(wb + B_FRR + ((T0 >> 3) * 64 + lane) * 16) = (u32x4){kc[4], kc[5], v0, v1}; }
}
__device__ __forceinline__ void blk_d0(const f32x16 (&C)[2][2], LAS unsigned char* wb, int l31, int hh, float (&X)[BT]) {
    f32x16 out[2];
    blk_stepA(C, wb, l31, hh, out);
    blk_gather(out, 8, X);
}
__device__ __forceinline__ void blk_bfrag_lds(const LAS unsigned char* rowp, bf16x8& b0, bf16x8& b1) {
    const u32x4 lo = *(const LAS u32x4*)rowp, hi = *(const LAS u32x4*)(rowp + 1024); u32x4 r0, r1;
#pragma unroll
    for (int d = 0; d < 4; ++d) { const unsigned ul = lo[d], uh = hi[d]; float ra, rb; swap32(__builtin_bit_cast(float, ul), __builtin_bit_cast(float, uh), ra, rb); r0[d] = __builtin_bit_cast(unsigned, ra); r1[d] = __builtin_bit_cast(unsigned, rb); }
    b0 = __builtin_bit_cast(bf16x8, r0); b1 = __builtin_bit_cast(bf16x8, r1);
}
__device__ __forceinline__ void ph_scan1b(const Args& a, int l, LAS unsigned char* lds, int lane, int wave) {
    LAS unsigned char* wb = lds + wave * B_WLDS;
    float* PC = (float*)(a.ws + WS_PC); float* LC = (float*)(a.ws + WS_LC);
    const int gw = blockIdx.x * 8 + wave, NGW = gridDim.x * 8;
    const int l31 = lane & 31, hh = lane >> 5;
    const int fo = ((((lane >> 5) * 2 + ((lane >> 4) & 1)) * 2 + ((lane >> 2) & 1)) * 8) + 4 * ((lane >> 3) & 1) + (lane & 3);
    for (int item = gw; item < 2048; item += NGW) {
        const int c = item & 15, dir = (item >> 4) & 1, h = (item >> 5) & 7, b = item >> 8;
        if (c == NCH - 1) continue;
        const int hc = h * 64 + lane;
        const float kkw = a.in[I_KK][l * 512 + hc], kaw = a.in[I_KA][l * 512 + hc];
        const float w0b = a.in[I_W0][(l * 2 + dir) * 512 + hc], a0b = a.in[I_A0][(l * 2 + dir) * 512 + hc];
        f32x16 CP[2][2], CL[2][2];
        { int ln = lane; asm volatile("" : "+v"(ln));
          const int dg = (ln & 31) - 4 * (ln >> 5);
#pragma unroll
          for (int tr = 0; tr < 2; ++tr)
#pragma unroll
            for (int tc = 0; tc < 2; ++tc)
#pragma unroll
                for (int r = 0; r < 16; ++r) { CP[tr][tc][r] = (tr == tc && dg == (r & 3) + 8 * (r >> 2)) ? 1.0f : 0.0f; CL[tr][tc][r] = 0.f; } }
        ScanRaw1 R0, R1; float gam = 1.0f;
        scan_load1(a, l, b, h, dir, c * CHL, R0, lane);
        scan_load1(a, l, b, h, dir, c * CHL + SG, R1, lane);
#pragma unroll 1
        for (int blk = 0; blk < CHL / BT; ++blk) {
            const int s0 = c * CHL + blk * BT; const bool more = blk + 1 < CHL / BT;
            unsigned kc[6];
            __builtin_amdgcn_sched_barrier(0);
            blk_stage1<0>(R0, kkw, kaw, w0b, a0b, wb, lane, fo, gam, kc);  scan_load1(a, l, b, h, dir, s0 + 2 * SG, R0, lane);
            __builtin_amdgcn_sched_barrier(0);
            blk_stage1<4>(R1, kkw, kaw, w0b, a0b, wb, lane, fo, gam, kc);  scan_load1(a, l, b, h, dir, s0 + 3 * SG, R1, lane);
            __builtin_amdgcn_sched_barrier(0);
            blk_stage1<8>(R0, kkw, kaw, w0b, a0b, wb, lane, fo, gam, kc);
            __builtin_amdgcn_sched_barrier(0);
            blk_stage1<12>(R1, kkw, kaw, w0b, a0b, wb, lane, fo, gam, kc);
            __builtin_amdgcn_sched_barrier(0);
            blk_stepB(wb, l31, hh);
            const LAS unsigned char* vrow = wb + B_FRR + lane * 16;
            const LAS float* GT = (const LAS float*)(wb + B_GT);
            bf16x8 bl0, bl1, bp0, bp1;
            {
                float DL[BT];
                { f32x16 out[2];
                  blk_stepA(CL, wb, l31, hh, out);
                  bf16x8 bv0, bv1, a2;
                  blk_bfrag_lds(vrow, bv0, bv1);
                  { const LAS float* gp = GT + (l31 & 15) * 32 + 8 * hh;
                    const int thr = (l31 >= 16 ? l31 - 16 : 0) - 8 * hh;
                    const f32x4 x0 = *(const LAS f32x4*)gp, x1 = *(const LAS f32x4*)(gp + 4);
                    u32x4 w2;
                    w2.x = pk2(0 < thr ? x0.x : 0.f, 1 < thr ? x0.y : 0.f); w2.y = pk2(2 < thr ? x0.z : 0.f, 3 < thr ? x0.w : 0.f);
                    w2.z = pk2(4 < thr ? x1.x : 0.f, 5 < thr ? x1.y : 0.f); w2.w = pk2(6 < thr ? x1.z : 0.f, 7 < thr ? x1.w : 0.f);
                    a2 = __builtin_bit_cast(bf16x8, w2); }
                  out[0] = __builtin_amdgcn_mfma_f32_32x32x16_bf16(a2, bv0, out[0], 0, 0, 0);
                  out[1] = __builtin_amdgcn_mfma_f32_32x32x16_bf16(a2, bv1, out[1], 0, 0, 0);
                  blk_gather(out, 8, DL); }
#pragma unroll
                for (int t = 1; t < BT; ++t) {
                    float accl = DL[t];
#pragma unroll
                    for (int q = 0; q < 4; ++q) if (4 * q < t) { const f32x4 g2 = *(const LAS f32x4*)(GT + t * 32 + 16 + 4 * q);
#pragma unroll
                        for (int i = 0; i < 4; ++i) if (4 * q + i < t) accl = __builtin_fmaf(-DL[4 * q + i], g2[i], accl); }
                    DL[t] = accl;
                }
                blk_bfrag(DL, -1.0f, bl0, bl1);
            }
            __builtin_amdgcn_sched_barrier(0);
            {   float DP[BT];
                blk_d0(CP, wb, l31, hh, DP);
#pragma unroll
                for (int t = 1; t < BT; ++t) {
                    float accp = DP[t];
#pragma unroll
                    for (int q = 0; q < 4; ++q) if (4 * q < t) { const f32x4 g2 = *(const LAS f32x4*)(GT + t * 32 + 16 + 4 * q);
#pragma unroll
                        for (int i = 0; i < 4; ++i) if (4 * q + i < t) accp = __builtin_fmaf(-DP[4 * q + i], g2[i], accp); }
                    DP[t] = accp;
                }
                blk_bfrag(DP, -1.0f, bp0, bp1);
            }
            __builtin_amdgcn_sched_barrier(0);
            if (more) { scan_load1(a, l, b, h, dir, s0 + 4 * SG, R0, lane); scan_load1(a, l, b, h, dir, s0 + 5 * SG, R1, lane); }
            __builtin_amdgcn_sched_barrier(0);
            bf16x8 bv0, bv1;
            blk_bfrag_lds(vrow, bv0, bv1);
#pragma unroll
            for (int tr = 0; tr < 2; ++tr) {
                const bf16x8 ad = *(const LAS bf16x8*)(wb + B_KMD + (hh * 64 + 32 * tr + l31) * 16), ab = *(const LAS bf16x8*)(wb + B_KMB + (hh * 64 + 32 * tr + l31) * 16);
                CL[tr][0] = __builtin_amdgcn_mfma_f32_32x32x16_bf16(ad, bv0, CL[tr][0], 0, 0, 0); CL[tr][0] = __builtin_amdgcn_mfma_f32_32x32x16_bf16(ab, bl0, CL[tr][0], 0, 0, 0);
                CL[tr][1] = __builtin_amdgcn_mfma_f32_32x32x16_bf16(ad, bv1, CL[tr][1], 0, 0, 0); CL[tr][1] = __builtin_amdgcn_mfma_f32_32x32x16_bf16(ab, bl1, CL[tr][1], 0, 0, 0);
                CP[tr][0] = __builtin_amdgcn_mfma_f32_32x32x16_bf16(ab, bp0, CP[tr][0], 0, 0, 0); CP[tr][1] = __builtin_amdgcn_mfma_f32_32x32x16_bf16(ab, bp1, CP[tr][1], 0, 0, 0);
            }
            { const LAS f32x4* pg = (const LAS f32x4*)((const LAS float*)(wb + B_GAM) + 4 * hh);
#pragma unroll
              for (int tr = 0; tr < 2; ++tr)
#pragma unroll
                for (int g = 0; g < 4; ++g) { const f32x4 G = pg[8 * tr + 2 * g];
#pragma unroll
                    for (int tc = 0; tc < 2; ++tc)
#pragma unroll
                        for (int i = 0; i < 4; ++i) { CL[tr][tc][4 * g + i] *= G[i]; CP[tr][tc][4 * g + i] *= G[i]; } } }
        }
        int item_o = item; asm volatile("" : "+s"(item_o));
#pragma unroll
        for (int tc = 0; tc < 2; ++tc) { float* po = PC + ((size_t)item_o * 64 + 32 * tc + l31) * 64 + 4 * hh; float* lo = LC + ((size_t)item_o * 64 + 32 * tc + l31) * 64 + 4 * hh;
#pragma unroll
            for (int tr = 0; tr < 2; ++tr)
#pragma unroll
                for (int g = 0; g < 4; ++g) { *(f32x4*)(po + 32 * tr + 8 * g) = (f32x4){CP[tr][tc][4 * g], CP[tr][tc][4 * g + 1], CP[tr][tc][4 * g + 2], CP[tr][tc][4 * g + 3]};
                    *(f32x4*)(lo + 32 * tr + 8 * g) = (f32x4){CL[tr][tc][4 * g], CL[tr][tc][4 * g + 1], CL[tr][tc][4 * g + 2], CL[tr][tc][4 * g + 3]}; } }
    }
}

__device__ __forceinline__ void ph_readout(const Args& a, int l, int lane, int wave) {
    const int gw = blockIdx.x * 8 + wave, NGW = gridDim.x * 8;
    unsigned char* ws = a.ws;
    const bf16* Y = (const bf16*)(ws + WS_Y); const bf16* Rb = (const bf16*)(ws + WS_R); const bf16* Kb = (const bf16*)(ws + WS_K); const bf16* Vb = (const bf16*)(ws + (l == 0 ? WS_V0 : WS_V1));
    const bf16* LW = (const bf16*)(ws + WS_P); bf16* H = (bf16*)(ws + WS_H);
    const int c0 = lane * 8;
    float ka[8], rk[8], lw[8], lb[8], ab0[8], ab1[8];
    { const float* p0 = a.in[I_KA] + l * 512 + c0; const float* p1 = a.in[I_RK] + l * 512 + c0; const float* p2 = a.in[I_LNW] + l * 512 + c0; const float* p3 = a.in[I_LNB] + l * 512 + c0;
      const float* p4 = a.in[I_A0] + l * 1024 + c0;
#pragma unroll
      for (int i = 0; i < 8; ++i) { ka[i] = p0[i]; rk[i] = p1[i]; lw[i] = p2[i]; lb[i] = p3[i]; ab0[i] = p4[i]; ab1[i] = p4[512 + i]; } }
    const int nrows = (l == 1) ? NTL : NT;
    for (int row = gw; row < nrows; row += NGW) {
        float y0[8], y1[8], r[8], k[8], v[8], a0[8], a1[8], g[8];
        unpack8(*(const u32x4*)(Y + (size_t)row * 512 + c0), y0); unpack8(*(const u32x4*)(Y + ((size_t)NT + row) * 512 + c0), y1);
        unpack8(*(const u32x4*)(Rb + (size_t)row * 512 + c0), r); unpack8(*(const u32x4*)(Kb + (size_t)row * 512 + c0), k); unpack8(*(const u32x4*)(Vb + (size_t)row * 512 + c0), v);
        unpack8(*(const u32x4*)(LW + (size_t)row * LWC + 1024 + c0), a0); unpack8(*(const u32x4*)(LW + (size_t)row * LWC + 1536 + c0), a1); unpack8(*(const u32x4*)(LW + (size_t)row * LWC + 2048 + c0), g);
        float s = 0.f, bs = 0.f;
#pragma unroll
        for (int i = 0; i < 8; ++i) { a0[i] = sigmoidf_(a0[i] + ab0[i]); a1[i] = sigmoidf_(a1[i] + ab1[i]); }
#pragma unroll
        for (int i = 0; i < 8; ++i) { y0[i] += y1[i]; s += y0[i];
            const float kd0 = k[i] * (1.0f + (a0[i] - 1.0f) * ka[i]), kd1 = k[i] * (1.0f + (a1[i] - 1.0f) * ka[i]); bs += r[i] * (kd0 + kd1) * rk[i]; }
        s = sum8_(s);
        bs = sum8_(bs);
        const float mu = s * (1.0f / 64.0f); float q = 0.f;
#pragma unroll
        for (int i = 0; i < 8; ++i) { const float d = y0[i] - mu; q += d * d; }
        q = sum8_(q);
        const float rstd = rsqrtf(q * (1.0f / 64.0f) + 64e-5f);
        float o[8];
#pragma unroll
        for (int i = 0; i < 8; ++i) o[i] = ((y0[i] - mu) * rstd * lw[i] + lb[i] + bs * v[i]) * g[i];
        *(u32x4*)(H + (size_t)row * DM + 512 + c0) = pack8(o);
    }
}

template <int VAR> __device__ __forceinline__ void ph_norm2_router(const Args& a, int l, LAS unsigned char* lds, int tid, int lane, int wave) {
    const int gw = blockIdx.x * 8 + wave, NGW = gridDim.x * 8;
    unsigned char* ws = a.ws;
    const float* XC = (const float*)(ws + WS_XC);
    const int nrows = (l == 1) ? NTL : NT;
    f32x4 nv0[4], nv1[4];
#define RT_LOAD(pr_) do { const int row_ = 2 * (pr_); const float* src_ = row_ < NTL ? a.out + (size_t)row_ * DM : XC + (size_t)(row_ - NTL) * DM; \
        _Pragma("unroll") for (int j = 0; j < 4; ++j) { nv0[j] = *(const f32x4*)(src_ + 4 * (lane + 64 * j)); nv1[j] = *(const f32x4*)(src_ + DM + 4 * (lane + 64 * j)); } } while (0)
    if (2 * gw < nrows) RT_LOAD(gw);
    LAS float* rwl = (LAS float*)lds;
    for (int i = tid; i < 16384; i += 512) rwl[(i & 15) * 1024 + (i >> 4)] = a.in[I_RW][i];
    LAS int* wcnt = (LAS int*)(lds + 65536);
    LAS int* woff = wcnt + 128;
    if (tid < 128) wcnt[tid] = 0;
    __syncthreads();
    const float* modv = (const float*)(ws + WS_MODV) + (size_t)l * 9 * 6144; bf16* H = (bf16*)(ws + WS_H);
    unsigned* cnt = (unsigned*)(ws + WS_CTL) + CW_CNT + 64 * l; int* route = (int*)(ws + WS_ROUTE);
    const int lq = lane >> 4, eb = 8 * (lq & 1), rsel = lq >> 1;
    float rb[8];
#pragma unroll
    for (int e = 0; e < 8; ++e) rb[e] = a.in[I_RB][eb + e];
    for (int pr = gw; 2 * pr < nrows; pr += NGW) {
        const int row = 2 * pr;
        const int mr = row < NTL ? (row >> 12) : 8;
        f32x4 v0[4], v1[4], h0[4], h1[4];
#pragma unroll
        for (int j = 0; j < 4; ++j) { v0[j] = nv0[j]; v1[j] = nv1[j]; }
        if (2 * (pr + NGW) < nrows) RT_LOAD(pr + NGW);
        {
            float ss0 = 0.f, ss1 = 0.f;
#pragma unroll
            for (int j = 0; j < 4; ++j) { ss0 += (v0[j].x * v0[j].x + v0[j].y * v0[j].y) + (v0[j].z * v0[j].z + v0[j].w * v0[j].w); ss1 += (v1[j].x * v1[j].x + v1[j].y * v1[j].y) + (v1[j].z * v1[j].z + v1[j].w * v1[j].w); }
            float ra, rbb; swap32(ss0, ss1, ra, rbb); float sq = ra + rbb;
            { float t0, t1; swap16(sq, sq, t0, t1); sq = t0 + t1; }
            sq = dpp_add_(sq, 0); sq = dpp_add_(sq, 1); sq = dpp_add_(sq, 2); sq = dpp_add_(sq, 3);
            const float tot0 = __builtin_bit_cast(float, __builtin_amdgcn_readlane(__builtin_bit_cast(int, sq), 0)), tot1 = __builtin_bit_cast(float, __builtin_amdgcn_readlane(__builtin_bit_cast(int, sq), 32));
            const float rms0 = rsqrtf(tot0 * (1.0f / DM) + 1e-6f), rms1 = rsqrtf(tot1 * (1.0f / DM) + 1e-6f);
            const float* g = a.in[I_NFFN] + l * DM; const float* sc = modv + (size_t)mr * 6144 + 4096; const float* sh = modv + (size_t)mr * 6144 + 3072;
            bf16* o0 = H + (size_t)row * DM;
#pragma unroll
            for (int j = 0; j < 4; ++j) { const int c = 4 * (lane + 64 * j);
                const f32x4 gg = *(const f32x4*)(g + c), s1 = *(const f32x4*)(sc + c), s0 = *(const f32x4*)(sh + c);
                const f32x4 x0 = (v0[j] * rms0 * gg) * (s1 + 1.0f) + s0, x1 = (v1[j] * rms1 * gg) * (s1 + 1.0f) + s0; h0[j] = x0; h1[j] = x1;
                u32x2 w0, w1; w0.x = pk2(x0.x, x0.y); w0.y = pk2(x0.z, x0.w); w1.x = pk2(x1.x, x1.y); w1.y = pk2(x1.z, x1.w);
                if (VAR == 0 || x0.x == 12345.678f) { *(u32x2*)(o0 + c) = w0; *(u32x2*)(o0 + DM + c) = w1; } }
        }
        float lg0[16], lg1[16];
#pragma unroll
        for (int e = 0; e < 16; ++e) { lg0[e] = 0.f; lg1[e] = 0.f; }
#pragma unroll
        for (int e = 0; e < 16; ++e) {
#pragma unroll
            for (int j = 0; j < 4; ++j) { const f32x4 w = *(const LAS f32x4*)(rwl + e * 1024 + 4 * (lane + 64 * j));
                lg0[e] += (h0[j].x * w.x + h0[j].y * w.y) + (h0[j].z * w.z + h0[j].w * w.w); lg1[e] += (h1[j].x * w.x + h1[j].y * w.y) + (h1[j].z * w.z + h1[j].w * w.w); }
            if ((e & 3) == 3) __builtin_amdgcn_sched_barrier(0); }
        float x[16], z[8];
#pragma unroll
        for (int e = 0; e < 16; ++e) { float ra, rbb; swap32(lg0[e], lg1[e], ra, rbb); x[e] = ra + rbb; }
#pragma unroll
        for (int k = 0; k < 8; ++k) { float ra, rbb; swap16(x[k], x[k + 8], ra, rbb); z[k] = ra + rbb; }
#pragma unroll
        for (int k = 0; k < 8; ++k) { z[k] = dpp_add_(z[k], 0); z[k] = dpp_add_(z[k], 1); z[k] = dpp_add_(z[k], 2); z[k] = dpp_add_(z[k], 3); }
        float sc[8], bs[8];
#pragma unroll
        for (int e = 0; e < 8; ++e) { sc[e] = sigmoidf_(z[e]); bs[e] = sc[e] + rb[e]; }
        float gsv[2];
#pragma unroll
        for (int g = 0; g < 2; ++g) { const float x0 = bs[4 * g], x1 = bs[4 * g + 1], x2 = bs[4 * g + 2], x3 = bs[4 * g + 3];
            const float h1 = fmaxf(x0, x1), l1 = fminf(x0, x1), h2 = fmaxf(x2, x3), l2 = fminf(x2, x3);
            gsv[g] = fmaxf(h1, h2) + fmaxf(fminf(h1, h2), fmaxf(l1, l2)); }
        const int lb = gsv[1] > gsv[0] ? 1 : 0; const float lbv = lb ? gsv[1] : gsv[0];
        float ev, od; swap16(lbv, lbv, ev, od);
        const bool mine = (lq & 1) ? (od > ev) : !(od > ev);
        const float g0 = lb ? bs[4] : bs[0], g1 = lb ? bs[5] : bs[1], g2 = lb ? bs[6] : bs[2], g3 = lb ? bs[7] : bs[3];
        const float s0 = lb ? sc[4] : sc[0], s1 = lb ? sc[5] : sc[1], s2 = lb ? sc[6] : sc[2], s3 = lb ? sc[7] : sc[3];
        int i0 = 0; float m0 = g0, t0 = s0;
        if (g1 > m0) { m0 = g1; i0 = 1; t0 = s1; } if (g2 > m0) { m0 = g2; i0 = 2; t0 = s2; } if (g3 > m0) { m0 = g3; i0 = 3; t0 = s3; }
        int i1 = -1; float m1 = 0.f, t1 = 0.f;
        if (i0 != 0) { m1 = g0; i1 = 0; t1 = s0; }
        if (i0 != 1 && (i1 < 0 || g1 > m1)) { m1 = g1; i1 = 1; t1 = s1; }
        if (i0 != 2 && (i1 < 0 || g2 > m1)) { m1 = g2; i1 = 2; t1 = s2; }
        if (i0 != 3 && (i1 < 0 || g3 > m1)) { m1 = g3; i1 = 3; t1 = s3; }
        const bool writer = mine && (lane & 15) == 0 && (VAR == 0 || t0 == 12345.678f);
        const int e0 = eb + lb * 4 + i0, e1 = eb + lb * 4 + i1; const float inv = 1.0f / (t0 + t1);
#pragma unroll
        for (int r = 0; r < 2; ++r)
            if (writer && rsel == r) {
                const int sl0 = wcnt[wave * 16 + e0]; wcnt[wave * 16 + e0] = sl0 + 1;
                const int sl1 = wcnt[wave * 16 + e1]; wcnt[wave * 16 + e1] = sl1 + 1;
                int* rp = route + (size_t)(row + r) * 8;
                rp[0] = e0; rp[1] = e1; rp[2] = sl0; rp[3] = sl1; rp[6] = __float_as_int(t0 * inv); rp[7] = __float_as_int(t1 * inv);
            }
    }
    __syncthreads();
    if (VAR == 0 && tid < 16) {
        int tot = 0;
#pragma unroll
        for (int w = 0; w < 8; ++w) tot += wcnt[w * 16 + tid];
        int run = (int)atomicAdd(cnt + tid, (unsigned)tot);
#pragma unroll
        for (int w = 0; w < 8; ++w) { woff[w * 16 + tid] = run; run += wcnt[w * 16 + tid]; }
    }
    asm volatile("s_waitcnt vmcnt(0)" ::: "memory");
    __syncthreads();
    { const int row = 2 * (gw + (lane >> 1) * NGW) + (lane & 1);
      if (VAR == 0 && row < nrows) { int* rp = route + (size_t)row * 8; const int e0 = rp[0], e1 = rp[1]; rp[2] += woff[wave * 16 + e0]; rp[3] += woff[wave * 16 + e1]; } }
    __syncthreads();
#undef RT_LOAD
}

__device__ __forceinline__ void ph_plan_gather(const Args& a, int l, LAS unsigned char* lds, int tid, int lane, int wave) {
    const int gw = blockIdx.x * 8 + wave, NGW = gridDim.x * 8;
    unsigned char* ws = a.ws;
    const unsigned* cnt = (const unsigned*)(ws + WS_CTL) + CW_CNT + 64 * l; int* plan = (int*)(ws + WS_CTL) + CW_PLAN + 512 * l;
    LAS int* ps = (LAS int*)lds;
    if (tid == 0) {
        int acc = 0;
        for (int e = 0; e < 16; ++e) { const int c = (int)cnt[e], pd = (c + 255) & ~255; ps[e] = acc;
            if (blockIdx.x == 0) { for (int t = acc >> 8; t < (acc + pd) >> 8; ++t) plan[16 + t] = e; plan[320 + e] = acc; }
            acc += pd; }
        if (blockIdx.x == 0) plan[0] = acc >> 8;
    }
    __syncthreads();
    int* route = (int*)(ws + WS_ROUTE); const bf16* H = (const bf16*)(ws + WS_H); bf16* Xs = (bf16*)(ws + WS_XS);
    const int ntok = (l == 1) ? NTL : NT;
    for (int it = gw; it < 2 * ntok; it += NGW) {
        const int tok = it >> 1, k = it & 1; int* rp = route + (size_t)tok * 8;
        const int e = rp[k], sl = rp[2 + k], dest = ps[e] + sl;
        if (lane == 0) rp[4 + k] = dest;
        const u32x4* s = (const u32x4*)(H + (size_t)tok * DM); u32x4* d = (u32x4*)(Xs + (size_t)dest * DM);
        __builtin_nontemporal_store(s[lane], d + lane); __builtin_nontemporal_store(s[lane + 64], d + lane + 64);
    }
    __syncthreads();
}

template <int VAR> __device__ __forceinline__ void ph_combine(const Args& a, int l, int lane, int wave) {
    const int gw = blockIdx.x * 8 + wave, NGW = gridDim.x * 8;
    unsigned char* ws = a.ws;
    const float* modv = (const float*)(ws + WS_MODV); const int* route = (const int*)(ws + WS_ROUTE); const bf16* Y2 = (const bf16*)(ws + WS_XS);
    float* XC = (float*)(ws + WS_XC); bf16* H = (bf16*)(ws + WS_H);
    const int nrows = (l == 1) ? NTL : NT;
    for (int row = gw; row < nrows; row += NGW) {
        float* xr = row < NTL ? a.out + (size_t)row * DM : XC + (size_t)(row - NTL) * DM;
        const int mr = row < NTL ? (row >> 12) : 8;
        const int* rp = route + (size_t)row * 8; const int d0 = rp[4], d1 = rp[5]; const float g0 = __int_as_float(rp[6]), g1 = __int_as_float(rp[7]);
        const float* gf = modv + ((size_t)l * 9 + mr) * 6144 + 5120;
        f32x4 v[4];
#pragma unroll
        for (int j = 0; j < 4; ++j) { const int c = 4 * (lane + 64 * j);
            const f32x4 x = *(const f32x4*)(xr + c), gg = *(const f32x4*)(gf + c);
            const u32x2 w0 = __builtin_nontemporal_load((const u32x2*)(Y2 + (size_t)d0 * DM + c)), w1 = __builtin_nontemporal_load((const u32x2*)(Y2 + (size_t)d1 * DM + c));
            const f32x4 ya = (f32x4){bflo(w0.x), bfhi(w0.x), bflo(w0.y), bfhi(w0.y)}, yb = (f32x4){bflo(w1.x), bfhi(w1.x), bflo(w1.y), bfhi(w1.y)};
            v[j] = x + gg * (ya * g0 + yb * g1); }
        if (l == 0) {
#pragma unroll
            for (int j = 0; j < 4; ++j) if (VAR == 0 || v[j].x == 12345.678f) __builtin_nontemporal_store(v[j], (f32x4*)(xr + 4 * (lane + 64 * j)));
            f32x4 h[4];
            norm_mod_store(v, a.in[I_NMIX] + DM, modv + ((size_t)9 + mr) * 6144 + 1024, modv + ((size_t)9 + mr) * 6144, H + (size_t)row * DM, lane, h, VAR == 0);
        } else {
            float ss = 0.f;
#pragma unroll
            for (int j = 0; j < 4; ++j) ss += (v[j].x * v[j].x + v[j].y * v[j].y) + (v[j].z * v[j].z + v[j].w * v[j].w);
            const float rms = rsqrtf(wave_sum(ss) * (1.0f / DM) + 1e-6f);
#pragma unroll
            for (int j = 0; j < 4; ++j) { const int c = 4 * (lane + 64 * j); const f32x4 ov = v[j] * rms * *(const f32x4*)(a.in[I_FNG] + c); if (VAR == 0 || ov.x == 12345.678f) __builtin_nontemporal_store(ov, (f32x4*)(xr + c)); }
        }
    }
}

#define IN(k) (lo <= (k) && (k) < hi)
#define SEAM(k) do { if ((k) + 1 < hi) xcd_barrier(bar); } while (0)
template <int MASK, int l> __device__ __forceinline__ void layer_phases(const Args& args, LAS unsigned char* lds, const XcdBarrier& bar, int lo, int hi, int tid, int lane, int wave) {
    constexpr int pb = 2 + 13 * l;
    const int G = gridDim.x, cid = blockIdx.x;
    unsigned char* ws = args.ws;

        if (HAS(2) && IN(pb + 0)) {
            pg8::Gemm g{(const bf16*)(ws + WS_H), (const bf16*)(ws + WS_WIN) + (size_t)l * INCP * DM, DM, DM, DM};
            pg8::DenseOrder S; S.init(NT / 256, INCP / 256, G, cid, DM, DM, 0);
            pg8::EpiStore E{(bf16*)(ws + WS_P), INCP};
            for (int rep_ = 0; rep_ < REPS(2); ++rep_) pg8::gemm_phase<pg8::EpiStore, pg8::DenseOrder, true, true>(lds, g, S, E);
            SEAM(pb + 0);
        }
        if (HAS(3) && IN(pb + 1)) { ph_postproj(args, l, lds, tid, lane, wave); if (REPS(3) > 1) ph_postproj(args, l, lds, tid, lane, wave); if (REPS(3) > 2) ph_postproj(args, l, lds, tid, lane, wave); SEAM(pb + 1); }
        if (HAS(4) && IN(pb + 2)) {
            pg8::Gemm g{(const bf16*)(ws + WS_AP), (const bf16*)(ws + WS_WL) + (size_t)l * LWC * 128, APC, 128, 128};
            pg8::DenseOrder S; S.init(NT / 256, LWC / 256, G, cid, APC, 128, 1);
            pg8::EpiStore E{(bf16*)(ws + WS_P), LWC};
            for (int rep_ = 0; rep_ < REPS(4); ++rep_) pg8::gemm_phase<pg8::EpiStore, pg8::DenseOrder, true, true>(lds, g, S, E);
            SEAM(pb + 2);
        }
        if (HAS(5) && IN(pb + 3)) {
#if REPK == 15 || REPK == 16
            if (HAS(15)) for (int rep_ = 0; rep_ < REPS(15); ++rep_) ph_attention(args, l, lane, wave);
            if (HAS(16)) for (int rep_ = 0; rep_ < REPS(16); ++rep_) ph_scan1b(args, l, lds, lane, wave);
#else
            if (wave < 4) { ph_scan1b(args, l, lds, lane, wave); __builtin_amdgcn_sched_barrier(0); ph_attention(args, l, lane, wave); }
            else { ph_attention(args, l, lane, wave); __builtin_amdgcn_sched_barrier(0); ph_scan1b(args, l, lds, lane, wave); }
#endif
            SEAM(pb + 3); }
        if (HAS(6) && IN(pb + 4)) { ph_scan2<0>(args, lds, tid, lane, wave); for (int rep_ = 1; rep_ < REPS(6); ++rep_) ph_scan2<1>(args, lds, tid, lane, wave); SEAM(pb + 4); }
        if (HAS(7) && IN(pb + 5)) { ph_scan3b(args, l, lds, lane, wave); for (int rep_ = 1; rep_ < REPS(7); ++rep_) ph_scan3b(args, l, lds, lane, wave); SEAM(pb + 5); }
        if (HAS(8) && IN(pb + 6)) { for (int rep_ = 0; rep_ < REPS(8); ++rep_) ph_readout(args, l, lane, wave); SEAM(pb + 6); }
        if (HAS(9) && IN(pb + 7)) {
            pg8::Gemm g{(const bf16*)(ws + WS_H), (const bf16*)(ws + WS_WOUT) + (size_t)l * DM * DM, DM, DM, DM};
            pg8::DenseOrder S; S.init((l == 1 ? NTL : NT) / 256, DM / 256, G, cid, DM, DM, 0);
            pg8::EpiResid E{l == 0 ? args.in[I_X] : args.out, l == 0 ? args.in[I_CTX] : (const float*)(ws + WS_XC), args.out, (float*)(ws + WS_XC), (const float*)(ws + WS_MODV) + (size_t)l * 9 * 6144, 0};
            pg8::gemm_phase<pg8::EpiResid, pg8::DenseOrder, true, true>(lds, g, S, E);
            if (REPS(9) > 1) { pg8::EpiResid E2 = E; E2.dummy = 1; pg8::gemm_phase<pg8::EpiResid, pg8::DenseOrder, true, true>(lds, g, S, E2); if (REPS(9) > 2) pg8::gemm_phase<pg8::EpiResid, pg8::DenseOrder, true, true>(lds, g, S, E2); }
            SEAM(pb + 7);
        }
        if (HAS(10) && IN(pb + 8)) { ph_norm2_router<0>(args, l, lds, tid, lane, wave); for (int rep_ = 1; rep_ < REPS(17); ++rep_) ph_norm2_router<1>(args, l, lds, tid, lane, wave); for (int rep_ = 0; rep_ < REPS(10); ++rep_) convert_experts(args, l, lds, lane, wave); SEAM(pb + 8); }
        if (HAS(11) && IN(pb + 9)) { for (int rep_ = 0; rep_ < REPS(11); ++rep_) ph_plan_gather(args, l, lds, tid, lane, wave); SEAM(pb + 9); }
        if (HAS(12) && IN(pb + 10)) {
            pg8::Gemm g{(const bf16*)(ws + WS_XS), (const bf16*)(ws + WS_WE), DM, DM, DM};
            pg8::MoeOrder S; S.init((const int*)(ws + WS_CTL) + CW_PLAN + 512 * l, 8, G, cid, DM, DM, 2048);
            pg8::EpiGateUp E{(bf16*)(ws + WS_HM)};
            for (int rep_ = 0; rep_ < REPS(12); ++rep_) pg8::gemm_phase<pg8::EpiGateUp, pg8::MoeOrder, false, true>(lds, g, S, E);
            SEAM(pb + 10);
        }
        if (HAS(13) && IN(pb + 11)) {
            pg8::Gemm g{(const bf16*)(ws + WS_HM), (const bf16*)(ws + WS_WE) + (size_t)16 * 2048 * 1024, DM, DM, DM};
            pg8::MoeOrder S; S.init((const int*)(ws + WS_CTL) + CW_PLAN + 512 * l, 4, G, cid, DM, DM, 1024);
            pg8::EpiStore E{(bf16*)(ws + WS_XS), DM};
            for (int rep_ = 0; rep_ < REPS(13); ++rep_) pg8::gemm_phase<pg8::EpiStore, pg8::MoeOrder, true, true>(lds, g, S, E);
            SEAM(pb + 11);
        }
        if (HAS(14) && IN(pb + 12)) { if (REPS(14) > 1) ph_combine<1>(args, l, lane, wave); if (REPS(14) > 2) ph_combine<1>(args, l, lane, wave); ph_combine<0>(args, l, lane, wave); SEAM(pb + 12); }
    }
#undef IN
#undef SEAM

template <int MASK> __global__ void __launch_bounds__(512, 2) __attribute__((target("no-packed-fp32-ops"))) mega_fwd(Args args) {
    extern __shared__ __attribute__((aligned(16))) unsigned char lds_raw[];
    LAS unsigned char* lds = (LAS unsigned char*)lds_raw;
    const int tid = threadIdx.x, lane = tid & 63, wave = __builtin_amdgcn_readfirstlane(tid >> 6);
    const int lo = args.ph_lo, hi = args.ph_hi;
    volatile LAS unsigned* MISC = (volatile LAS unsigned*)(lds + MISC_OFF);
    if (tid < 64) MISC[tid] = 0u;
    __syncthreads();
    unsigned* ctl = (unsigned*)(args.ws + WS_CTL);
    XcdBarrier bar; bar.bar = ctl + CW_BAR; bar.x = 0; bar.st = MISC + 8;
    if (hi - lo > 1) bar = xcd_barrier_post(ctl + CW_BAR, MISC + 8);
#define IN(k) (lo <= (k) && (k) < hi)
#define SEAM(k) do { if ((k) + 1 < hi) xcd_barrier(bar); } while (0)
    const int G = gridDim.x, cid = blockIdx.x;
    unsigned char* ws = args.ws;

    if (HAS(0) && IN(0)) { for (int rep_ = 0; rep_ < REPS(0); ++rep_) { ph_prologue(args, lds, tid, lane, wave); __syncthreads(); } SEAM(0); }
    if (HAS(1) && IN(1)) { for (int rep_ = 0; rep_ < REPS(1); ++rep_) ph_norm1_l0(args, lane, wave); SEAM(1); }
    layer_phases<MASK, 0>(args, lds, bar, lo, hi, tid, lane, wave);
    layer_phases<MASK, 1>(args, lds, bar, lo, hi, tid, lane, wave);
#undef IN
#undef SEAM
}

template <int MASK> static void launch_one(const Args& a, int grid, hipStream_t stream) { hipLaunchKernelGGL(mega_fwd<MASK>, dim3(grid), dim3(512), LDS_BYTES, stream, a); }
template <int MASK> static bool setup_one(int* per_cu) {
    if (hipFuncSetAttribute((const void*)mega_fwd<MASK>, hipFuncAttributeMaxDynamicSharedMemorySize, LDS_BYTES) != hipSuccess) return false;
    int pc = 0; if (hipOccupancyMaxActiveBlocksPerMultiprocessor(&pc, (const void*)mega_fwd<MASK>, 512, LDS_BYTES) != hipSuccess) pc = 0;
    (void)hipGetLastError(); if (pc < *per_cu) *per_cu = pc; return true;
}
static int kind_of_phase(int p) { return p < 2 ? p : 2 + (p - 2) % 13; }

extern "C" void kernel_launch(void* const* d_in, const int* in_sizes, int n_in, void* d_out, int out_size, void* d_ws, size_t ws_size, hipStream_t stream) {
    static int grid = 0;
    if (grid == 0) {
        if (n_in != 32 || out_size != NTL * DM || ws_size < WS_END) { fprintf(stderr, "kernel_launch: unexpected sizes (n_in %d, out %d, ws %zu, need %zu)\n", n_in, out_size, ws_size, (size_t)WS_END); grid = -1; return; }
        int dev = 0, cus = 0, per_cu = 99;
        if (hipGetDevice(&dev) != hipSuccess || hipDeviceGetAttribute(&cus, hipDeviceAttributeMultiprocessorCount, dev) != hipSuccess) { grid = -1; return; }
        bool ok = true;
#if MK_MULTI
        ok = ok && setup_one<1 << 0>(&per_cu) && setup_one<1 << 1>(&per_cu) && setup_one<1 << 2>(&per_cu) && setup_one<1 << 3>(&per_cu) && setup_one<1 << 4>(&per_cu)
                && setup_one<(1 << 5) | (1 << 15)>(&per_cu) && setup_one<(1 << 5) | (1 << 16)>(&per_cu) && setup_one<1 << 6>(&per_cu) && setup_one<1 << 7>(&per_cu) && setup_one<1 << 8>(&per_cu) && setup_one<1 << 9>(&per_cu)
                && setup_one<1 << 10>(&per_cu) && setup_one<1 << 11>(&per_cu) && setup_one<1 << 12>(&per_cu) && setup_one<1 << 13>(&per_cu) && setup_one<1 << 14>(&per_cu);
#else
        ok = ok && setup_one<0x1ffff>(&per_cu);
#endif
        if (!ok) { fprintf(stderr, "kernel_launch: hipFuncSetAttribute failed\n"); grid = -1; return; }
        if (per_cu < 1) fprintf(stderr, "kernel_launch: occupancy query reports %d\n", per_cu);
        grid = cus;
    }
    if (grid < 0) return;
    (void)hipMemsetAsync((char*)d_ws + WS_CTL, 0, CTL_BYTES, stream);
    Args a{};
    for (int i = 0; i < 32; ++i) a.in[i] = (const float*)d_in[i];
    a.out = (float*)d_out; a.ws = (unsigned char*)d_ws;
#if MK_MULTI
    for (int p = 0; p < NPHASE; ++p) {
        a.ph_lo = p; a.ph_hi = p + 1;
        switch (kind_of_phase(p)) {
            case 0: launch_one<1 << 0>(a, grid, stream); break;   case 1: launch_one<1 << 1>(a, grid, stream); break;
            case 2: launch_one<1 << 2>(a, grid, stream); break;   case 3: launch_one<1 << 3>(a, grid, stream); break;
            case 4: launch_one<1 << 4>(a, grid, stream); break;   case 5: launch_one<(1 << 5) | (1 << 15)>(a, grid, stream); launch_one<(1 << 5) | (1 << 16)>(a, grid, stream); break;
            case 6: launch_one<1 << 6>(a, grid, stream); break;   case 7: launch_one<1 << 7>(a, grid, stream); break;
            case 8: launch_one<1 << 8>(a, grid, stream); break;   case 9: launch_one<1 << 9>(a, grid, stream); break;
            case 10: launch_one<1 << 10>(a, grid, stream); break; case 11: launch_one<1 << 11>(a, grid, stream); break;
            case 12: launch_one<1 << 12>(a, grid, stream); break; case 13: launch_one<1 << 13>(a, grid, stream); break;
            default: launch_one<1 << 14>(a, grid, stream); break;
        }
    }
#else
    a.ph_lo = 0; a.ph_hi = NPHASE;
    launch_one<0x1ffff>(a, grid, stream);
#endif
}
```

```cpp
#include <hip/hip_runtime.h>
#include <cstdio>
#include <cstdint>

#ifndef MK_MULTI
#define MK_MULTI 0
#endif

#ifndef PHMASK
#define PHMASK 0x1ffff
#endif
#define HAS(k) ((((PHMASK) & MASK) >> (k)) & 1)
#ifndef REPK
#define REPK -1
#endif
#ifndef REPN
#define REPN 1
#endif
#define REPS(k) ((REPK) == (k) ? (REPN) : 1)
#define LAS __attribute__((address_space(3)))
#define GAS __attribute__((address_space(1)))
typedef unsigned short bf16;
typedef short bf16x8 __attribute__((ext_vector_type(8)));
typedef float f32x4 __attribute__((ext_vector_type(4)));
typedef float f32x16 __attribute__((ext_vector_type(16)));
typedef unsigned u32x4 __attribute__((ext_vector_type(4)));
typedef unsigned u32x2 __attribute__((ext_vector_type(2)));

constexpr int NB = 8, SEQ = 4096, CTXL = 256, DM = 1024;
constexpr int NTL = NB * SEQ, NTC = NB * CTXL, NT = NTL + NTC;
constexpr int INC = 2688, INCP = 2816;
constexpr int POSN = CTXL + SEQ;
constexpr int NCH = 16, CHL = 272;
constexpr int LWC = 2560;
constexpr int APC = 384;
constexpr int MOE_ROWS = 73728;
constexpr int NPHASE = 28;

constexpr size_t MiB = 1u << 20;
constexpr size_t WS_CTL = 0, CTL_BYTES = 1 * MiB;
constexpr size_t WS_MODV = 1 * MiB;
constexpr size_t WS_WIN = 2 * MiB;
constexpr size_t WS_WOUT = 14 * MiB;
constexpr size_t WS_WL = 18 * MiB;
constexpr size_t WS_XC = 21 * MiB;
constexpr size_t WS_ROUTE = 29 * MiB;
constexpr size_t WS_H = 31 * MiB;
constexpr size_t WS_V0 = 99 * MiB;
constexpr size_t WS_T = 133 * MiB;
constexpr size_t WS_P = WS_T;
constexpr size_t WS_R = WS_T + 187 * MiB;
constexpr size_t WS_K = WS_R + 34 * MiB;
constexpr size_t WS_V1 = WS_K + 34 * MiB;
constexpr size_t WS_QR = WS_V1 + 34 * MiB;
constexpr size_t WS_KR = WS_QR + 34 * MiB;
constexpr size_t WS_VT = WS_KR + 9 * MiB;
constexpr size_t WS_AP = WS_VT + 9 * MiB;
constexpr size_t WS_Y = WS_QR;
constexpr size_t WS_PC = WS_AP + 26 * MiB;
constexpr size_t WS_LC = WS_PC + 32 * MiB;
constexpr size_t WS_KN = WS_LC + 32 * MiB;
constexpr size_t WS_MIX_END = WS_KN + 2 * MiB;
constexpr size_t WS_WE = WS_T;
constexpr size_t WS_XS = WS_T + 96 * MiB;
constexpr size_t WS_HM = WS_XS + 144 * MiB;
constexpr size_t WS_MOE_END = WS_HM + 144 * MiB;
constexpr size_t WS_END = WS_MIX_END > WS_MOE_END ? WS_MIX_END : WS_MOE_END;
static_assert((size_t)NT * INCP * 2 <= 187 * MiB && (size_t)NT * 512 * 2 <= 34 * MiB && (size_t)NT * 128 * 2 <= 9 * MiB && (size_t)NB * 2 * 64 * POSN * 2 <= 9 * MiB, "ws map");
static_assert((size_t)NT * APC * 2 <= 26 * MiB && (size_t)2 * NT * 512 * 2 <= 78 * MiB && (size_t)MOE_ROWS * 1024 * 2 <= 144 * MiB && (size_t)NT * 32 <= 2 * MiB, "ws map");
static_assert(WS_END <= (size_t)590 * MiB, "ws budget");

constexpr int CW_BAR = 4096;
constexpr int CW_CNT = 8192;
constexpr int CW_PLAN = 8448;

constexpr int RING_BYTES = 131072;
constexpr int MISC_OFF = 147456 - 256;
constexpr int LDS_BYTES = 147456;

__device__ __forceinline__ unsigned f2bf(float f) { unsigned u = __builtin_bit_cast(unsigned, f); return (u + 0x7fffu + ((u >> 16) & 1u)) >> 16; }
typedef float f32x2_t __attribute__((ext_vector_type(2)));
typedef __bf16 bf16x2_t __attribute__((ext_vector_type(2)));
__device__ __forceinline__ unsigned pk2(float lo, float hi) { const f32x2_t v = {lo, hi}; const bf16x2_t b = __builtin_convertvector(v, bf16x2_t); return __builtin_bit_cast(unsigned, b); }
__device__ __forceinline__ unsigned short f2bf1(float f) { return (unsigned short)(pk2(f, 0.f) & 0xffffu); }
__device__ __forceinline__ float bf2f(unsigned short h) { return __builtin_bit_cast(float, (unsigned)h << 16); }
__device__ __forceinline__ float bflo(unsigned w) { return __builtin_bit_cast(float, w << 16); }
__device__ __forceinline__ float bfhi(unsigned w) { return __builtin_bit_cast(float, w & 0xffff0000u); }
__device__ __forceinline__ void unpack8(u32x4 w, float* f) { f[0] = bflo(w.x); f[1] = bfhi(w.x); f[2] = bflo(w.y); f[3] = bfhi(w.y); f[4] = bflo(w.z); f[5] = bfhi(w.z); f[6] = bflo(w.w); f[7] = bfhi(w.w); }
__device__ __forceinline__ u32x4 pack8(const float* f) { u32x4 w; w.x = pk2(f[0], f[1]); w.y = pk2(f[2], f[3]); w.z = pk2(f[4], f[5]); w.w = pk2(f[6], f[7]); return w; }
__device__ __forceinline__ void swap32(float a, float b, float& ra, float& rb) {
    auto r = __builtin_amdgcn_permlane32_swap(__builtin_bit_cast(unsigned, a), __builtin_bit_cast(unsigned, b), false, false);
    const unsigned u0 = r[0], u1 = r[1];
    ra = __builtin_bit_cast(float, u0); rb = __builtin_bit_cast(float, u1);
}
__device__ __forceinline__ float dpp_add_(float x, int ctrl_sel) {
    const int xi = __builtin_bit_cast(int, x); int y;
    if (ctrl_sel == 0) y = __builtin_amdgcn_update_dpp(0, xi, 0xB1, 0xf, 0xf, false);
    else if (ctrl_sel == 1) y = __builtin_amdgcn_update_dpp(0, xi, 0x4E, 0xf, 0xf, false);
    else if (ctrl_sel == 2) y = __builtin_amdgcn_update_dpp(0, xi, 0x141, 0xf, 0xf, false);
    else y = __builtin_amdgcn_update_dpp(0, xi, 0x140, 0xf, 0xf, false);
    return x + __builtin_bit_cast(float, y);
}
__device__ __forceinline__ void swap16(float a, float b, float& ra, float& rb) {
    auto r = __builtin_amdgcn_permlane16_swap(__builtin_bit_cast(unsigned, a), __builtin_bit_cast(unsigned, b), false, false);
    const unsigned u0 = r[0], u1 = r[1];
    ra = __builtin_bit_cast(float, u0); rb = __builtin_bit_cast(float, u1);
}
__device__ __forceinline__ float xor2_(float x) { return __builtin_bit_cast(float, __builtin_amdgcn_update_dpp(0, __builtin_bit_cast(int, x), 0x4E, 0xf, 0xf, false)); }
__device__ __forceinline__ float sum8_(float x) { x = dpp_add_(x, 0); x = dpp_add_(x, 1); return dpp_add_(x, 2); }
__device__ __forceinline__ float wave_sum(float v) {
    v = dpp_add_(v, 0); v = dpp_add_(v, 1); v = dpp_add_(v, 2); v = dpp_add_(v, 3);
    float t0, t1; swap16(v, v, t0, t1); v = t0 + t1; swap32(v, v, t0, t1); return t0 + t1;
}
__device__ __forceinline__ float sigmoidf_(float x) { return __builtin_amdgcn_rcpf(1.0f + __expf(-x)); }
__device__ __forceinline__ float sigmoid_nb(float x, float nb) { return __builtin_amdgcn_rcpf(1.0f + __builtin_amdgcn_exp2f(__builtin_fmaf(x, -1.4426950408889634f, nb))); }
__device__ __forceinline__ int row_of(int b, int pos) { return pos < CTXL ? NTL + b * CTXL + pos : b * SEQ + (pos - CTXL); }

namespace pg8 {
#define PG8_LAS __attribute__((address_space(3)))
typedef unsigned short bf16_t;
constexpr int BM = 256, BK = 64, HALF = 128, HTB = HALF * BK * 2, STAGE_BYTES = 8 * HTB, NXCD = 8, WGM = 8;
__host__ __device__ __forceinline__ int lds_byte(int r, int c) { const int st = (r >> 4) * 2 + (c >> 5), rr = r & 15, cc = c & 31, ob = rr * 64 + cc * 2; return st * 1024 + (ob ^ (((ob >> 9) & 1) << 5)); }
__host__ __device__ __forceinline__ void stage_rc(int b, int& R, int& C) { const int st = b / 1024, sb = b % 1024, swz = sb ^ (((sb >> 9) & 1) << 5); R = (st >> 1) * 16 + swz / 64; C = (st & 1) * 32 + (swz % 64) / 2; }
__host__ __device__ __forceinline__ int perm32(int rho) { const int n = rho >> 4, i = rho & 15; return 8 * (i >> 2) + 4 * n + (i & 3); }

struct Unit { int pm, pn; unsigned aoff, boff; int aux; };
struct Gemm { const bf16_t* A; const bf16_t* Bt; int lda, ldb, K; };

__device__ __forceinline__ unsigned cvt_pk_bf16(float lo, float hi) { unsigned r; asm volatile("v_cvt_pk_bf16_f32 %0, %1, %2" : "=v"(r) : "v"(lo), "v"(hi)); return r; }

template <class Epi, class Sched, bool ALIGN_EPI = false, bool SP2 = false>
__device__ __forceinline__ void gemm_phase(PG8_LAS unsigned char* lds, const Gemm g, const Sched& S, const Epi& E) {
    const int tid = threadIdx.x, wid = __builtin_amdgcn_readfirstlane(tid >> 6), lane = tid & 63, wr = wid >> 2, wc = wid & 3, fr = lane & 15, fq = lane >> 4;
    const int K = g.K, nt = K / BK;
    unsigned voffA[2], voffB[2];
#pragma unroll
    for (int i = 0; i < 2; ++i) { int R, C; stage_rc(tid * 16 + i * 8192, R, C); const int Rb = Epi::PERM ? ((R & ~31) + perm32(R & 31)) : R;
        voffA[i] = (unsigned)(R * g.lda + C) * 2u; voffB[i] = (unsigned)(Rb * g.ldb + C) * 2u; }
    const size_t kstep = (size_t)(BK * 2);
    const size_t hstepA = (size_t)HALF * g.lda * 2, hstepB = (size_t)HALF * g.ldb * 2;
    const unsigned ldsw = (unsigned)wid * 1024u;
    const int aoff = lds_byte(wr * 64 + fr, fq * 8), boff = lds_byte(wc * 32 + fr, fq * 8);
#define PG8_SA(b, h) (((b) * 2 + (h)) * HTB)
#define PG8_SB(b, h) ((4 + (b) * 2 + (h)) * HTB)
#define PG8_STAGE(bufoff, gbase, voff) do { _Pragma("unroll") for (int _i = 0; _i < 2; ++_i) \
        __builtin_amdgcn_global_load_lds((const unsigned*)((const char*)(gbase) + (voff)[_i]), (PG8_LAS unsigned*)(lds + (bufoff) + ldsw + _i * 8192), 16, 0, 0); } while (0)
#define PG8_LDA(dst, b, h) do { _Pragma("unroll") for (int m = 0; m < 4; ++m) _Pragma("unroll") for (int k = 0; k < 2; ++k) dst[m][k] = *(const PG8_LAS bf16x8*)(lds + PG8_SA(b, h) + aoff + m * 2048 + k * 1024); } while (0)
#define PG8_LDB(dst, b, h) do { _Pragma("unroll") for (int n = 0; n < 2; ++n) _Pragma("unroll") for (int k = 0; k < 2; ++k) dst[n][k] = *(const PG8_LAS bf16x8*)(lds + PG8_SB(b, h) + boff + n * 2048 + k * 1024); } while (0)
#define PG8_MMA(ai, bj, At, Bt) do { __builtin_amdgcn_s_setprio(1); _Pragma("unroll") for (int m = 0; m < 4; ++m) _Pragma("unroll") for (int n = 0; n < 2; ++n) _Pragma("unroll") for (int k = 0; k < 2; ++k) \
        acc[ai][bj][m][n] = __builtin_amdgcn_mfma_f32_16x16x32_bf16(Bt[n][k], At[m][k], acc[ai][bj][m][n], 0, 0, 0); __builtin_amdgcn_s_setprio(0); } while (0)
#define PG8_WAIT_V(n) asm volatile("s_waitcnt vmcnt(" #n ")" ::: "memory")
#define PG8_WAIT_L(n) asm volatile("s_waitcnt lgkmcnt(" #n ")" ::: "memory")
#define PG8_BAR __builtin_amdgcn_s_barrier()
#define PG8_SCHED __builtin_amdgcn_sched_barrier(0)
    Unit cur, nxt; int ui = 0;
    if (!S.next(0, cur)) return;
    f32x4 acc[2][2][4][2];
#pragma unroll
    for (int a = 0; a < 2; ++a)
#pragma unroll
        for (int b = 0; b < 2; ++b)
#pragma unroll
            for (int m = 0; m < 4; ++m)
#pragma unroll
                for (int n = 0; n < 2; ++n) acc[a][b][m][n] = (f32x4){0.f, 0.f, 0.f, 0.f};
    bf16x8 At[4][2], B0[2][2], B1[2][2];
    const char* cA = (const char*)g.A + (size_t)cur.aoff; const char* cB = (const char*)g.Bt + (size_t)cur.boff;
    if constexpr (SP2) {
        PG8_STAGE(PG8_SB(0, 0), cB, voffB); PG8_STAGE(PG8_SB(0, 1), cB + hstepB, voffB); PG8_STAGE(PG8_SA(0, 0), cA, voffA); PG8_STAGE(PG8_SA(0, 1), cA + hstepA, voffA);
        if (wr == 1) PG8_BAR;
        PG8_WAIT_V(2); PG8_BAR;
        PG8_STAGE(PG8_SB(1, 0), cB + kstep, voffB); PG8_STAGE(PG8_SA(1, 0), cA + kstep, voffA); PG8_STAGE(PG8_SB(1, 1), cB + hstepB + kstep, voffB);
        PG8_WAIT_V(6); PG8_BAR;
    } else {
        PG8_STAGE(PG8_SB(0, 0), cB, voffB); PG8_STAGE(PG8_SA(0, 0), cA, voffA); PG8_STAGE(PG8_SB(0, 1), cB + hstepB, voffB); PG8_STAGE(PG8_SA(0, 1), cA + hstepA, voffA);
        if (wr == 1) PG8_BAR;
        PG8_WAIT_V(4); PG8_BAR;
        PG8_STAGE(PG8_SB(1, 0), cB + kstep, voffB); PG8_STAGE(PG8_SA(1, 0), cA + kstep, voffA); PG8_STAGE(PG8_SB(1, 1), cB + hstepB + kstep, voffB);
        PG8_WAIT_V(6); PG8_BAR;
    }
    for (;;) {
        const bool has_next = S.next(ui + 1, nxt);
        const char* nA = has_next ? (const char*)g.A + (size_t)nxt.aoff : cA; const char* nB = has_next ? (const char*)g.Bt + (size_t)nxt.boff : cB;
#pragma unroll 1
        for (int t = 0; t < nt; t += 2) {
            const bool last = (t == nt - 2);
            const char* a1 = cA + (size_t)(t + 1) * kstep;
            const char* a2 = last ? nA : cA + (size_t)(t + 2) * kstep; const char* b2 = last ? nB : cB + (size_t)(t + 2) * kstep;
            const char* a3 = a2 + kstep; const char* b3 = b2 + kstep;
            if constexpr (SP2) {
            PG8_LDB(B0, 0, 0); PG8_LDB(B1, 0, 1); PG8_SCHED; PG8_LDA(At, 0, 0); PG8_STAGE(PG8_SA(1, 1), a1 + hstepA, voffA);
            PG8_WAIT_V(8); PG8_WAIT_L(0); PG8_BAR; PG8_MMA(0, 0, At, B0); PG8_MMA(0, 1, At, B1); PG8_BAR; PG8_SCHED;
            PG8_LDA(At, 0, 1); PG8_STAGE(PG8_SB(0, 0), b2, voffB); PG8_STAGE(PG8_SB(0, 1), b2 + hstepB, voffB); PG8_STAGE(PG8_SA(0, 0), a2, voffA);
            PG8_WAIT_V(8); PG8_WAIT_L(0); PG8_BAR; PG8_MMA(1, 0, At, B0); PG8_MMA(1, 1, At, B1); PG8_BAR; PG8_SCHED;
            PG8_LDB(B0, 1, 0); PG8_LDB(B1, 1, 1); PG8_SCHED; PG8_LDA(At, 1, 0); PG8_STAGE(PG8_SA(0, 1), a2 + hstepA, voffA);
            PG8_WAIT_V(8); PG8_WAIT_L(0); PG8_BAR; PG8_MMA(0, 0, At, B0); PG8_MMA(0, 1, At, B1); PG8_BAR; PG8_SCHED;
            PG8_LDA(At, 1, 1); PG8_STAGE(PG8_SB(1, 0), b3, voffB); PG8_STAGE(PG8_SB(1, 1), b3 + hstepB, voffB); PG8_STAGE(PG8_SA(1, 0), a3, voffA);
            PG8_WAIT_V(8); PG8_WAIT_L(0); PG8_BAR; PG8_MMA(1, 0, At, B0); PG8_MMA(1, 1, At, B1); PG8_BAR; PG8_SCHED;
            } else {
            PG8_LDB(B0, 0, 0); PG8_SCHED; PG8_LDA(At, 0, 0); PG8_STAGE(PG8_SA(1, 1), a1 + hstepA, voffA);
            PG8_WAIT_L(8); PG8_BAR; PG8_WAIT_L(0); PG8_MMA(0, 0, At, B0); PG8_BAR; PG8_SCHED;
            PG8_LDB(B1, 0, 1); PG8_STAGE(PG8_SB(0, 0), b2, voffB);
            PG8_BAR; PG8_WAIT_L(0); PG8_MMA(0, 1, At, B1); PG8_BAR;
            PG8_LDA(At, 0, 1); PG8_STAGE(PG8_SA(0, 0), a2, voffA);
            PG8_BAR; PG8_WAIT_L(0); PG8_MMA(1, 0, At, B0); PG8_BAR; PG8_SCHED;
            PG8_STAGE(PG8_SB(0, 1), b2 + hstepB, voffB);
            PG8_WAIT_V(6); PG8_BAR; PG8_MMA(1, 1, At, B1); PG8_BAR;
            PG8_LDB(B0, 1, 0); PG8_SCHED; PG8_LDA(At, 1, 0); PG8_STAGE(PG8_SA(0, 1), a2 + hstepA, voffA);
            PG8_WAIT_L(8); PG8_BAR; PG8_WAIT_L(0); PG8_MMA(0, 0, At, B0); PG8_BAR; PG8_SCHED;
            PG8_LDB(B1, 1, 1); PG8_STAGE(PG8_SB(1, 0), b3, voffB);
            PG8_BAR; PG8_WAIT_L(0); PG8_MMA(0, 1, At, B1); PG8_BAR;
            PG8_LDA(At, 1, 1); PG8_STAGE(PG8_SA(1, 0), a3, voffA);
            PG8_BAR; PG8_WAIT_L(0); PG8_MMA(1, 0, At, B0); PG8_BAR; PG8_SCHED;
            PG8_STAGE(PG8_SB(1, 1), b3 + hstepB, voffB);
            PG8_WAIT_V(6); PG8_BAR; PG8_MMA(1, 1, At, B1); PG8_BAR;
            }
        }
        if constexpr (ALIGN_EPI) { if (wr == 0) PG8_BAR; }
        E(acc, cur, wr, wc, fr, fq);
        if (!has_next) break;
#pragma unroll
        for (int a = 0; a < 2; ++a)
#pragma unroll
            for (int b = 0; b < 2; ++b)
#pragma unroll
                for (int m = 0; m < 4; ++m)
#pragma unroll
                    for (int n = 0; n < 2; ++n) acc[a][b][m][n] = (f32x4){0.f, 0.f, 0.f, 0.f};
        cur = nxt; cA = nA; cB = nB; ++ui;
        if constexpr (ALIGN_EPI) { if (wr == 1) PG8_BAR; }
    }
    PG8_WAIT_V(0);
    if constexpr (!ALIGN_EPI) { if (wr == 0) PG8_BAR; }
    PG8_BAR;
#undef PG8_SA
#undef PG8_SB
#undef PG8_STAGE
#undef PG8_LDA
#undef PG8_LDB
#undef PG8_MMA
#undef PG8_WAIT_V
#undef PG8_WAIT_L
#undef PG8_BAR
#undef PG8_SCHED
}

struct DenseOrder {
    int nM, nN, nwg, G, c; unsigned atile, btile; int lora;
    __device__ __forceinline__ void init(int nM_, int nN_, int G_, int c_, int lda, int ldb, int lora_) { nM = nM_; nN = nN_; nwg = nM * nN; G = G_; c = c_; atile = (unsigned)(BM * lda * 2); btile = (unsigned)(BM * ldb * 2); lora = lora_; }
    __device__ __forceinline__ bool next(int i, Unit& u) const {
        const long L = (long)i * G + c; if (L >= nwg) return false;
        int wgid = (int)L; { const int q = nwg / NXCD, r = nwg % NXCD, xcd = wgid % NXCD, off = wgid / NXCD; wgid = (xcd < r ? xcd * (q + 1) : r * (q + 1) + (xcd - r) * q) + off; }
        const int nig = WGM * nN, gid = wgid / nig, fm = gid * WGM, gsz = (nM - fm) < WGM ? (nM - fm) : WGM;
        u.pm = fm + ((wgid % nig) % gsz); u.pn = (wgid % nig) / gsz;
        u.aoff = (unsigned)u.pm * atile + (lora ? (u.pn < 4 ? 0u : (u.pn < 8 ? 256u : 512u)) : 0u); u.boff = (unsigned)u.pn * btile; u.aux = 0; return true;
    }
};
struct MoeOrder {
    const int* plan; int ntiles, npn, G, c; unsigned atile, brow; int nper;
    __device__ __forceinline__ void init(const int* plan_, int npn_, int G_, int c_, int lda, int ldb, int nper_) { plan = plan_; ntiles = plan_[0]; npn = npn_; G = G_; c = c_; atile = (unsigned)(BM * lda * 2); brow = (unsigned)(ldb * 2); nper = nper_; }
    __device__ __forceinline__ bool next(int i, Unit& u) const {
        const int L = i * G + c, x = L & 7, off = L >> 3;
        const int ntx = (ntiles - x + 7) >> 3;
        if (off >= ntx * npn) return false;
        u.pm = (off / npn) * 8 + x; u.pn = off % npn; const int e = plan[16 + u.pm]; u.aux = e;
        u.aoff = (unsigned)u.pm * atile; u.boff = (unsigned)(e * nper + u.pn * BM) * brow; return true;
    }
};

struct EpiStore {
    static constexpr bool PERM = true;
    bf16_t* O; int ldc;
    __device__ __forceinline__ void operator()(const f32x4 (&acc)[2][2][4][2], const Unit& u, int wr, int wc, int fr, int fq) const {
        const int row0 = u.pm * BM + wr * 64 + fr, col0 = u.pn * BM + wc * 32 + 8 * fq;
#pragma unroll
        for (int ai = 0; ai < 2; ++ai)
#pragma unroll
            for (int m = 0; m < 4; ++m) { bf16_t* rowp = O + (size_t)(row0 + ai * HALF + m * 16) * ldc + col0;
#pragma unroll
                for (int bj = 0; bj < 2; ++bj) { const f32x4 v0 = acc[ai][bj][m][0], v1 = acc[ai][bj][m][1];
                    u32x4 w; w.x = cvt_pk_bf16(v0[0], v0[1]); w.y = cvt_pk_bf16(v0[2], v0[3]); w.z = cvt_pk_bf16(v1[0], v1[1]); w.w = cvt_pk_bf16(v1[2], v1[3]);
                    __builtin_nontemporal_store(w, (u32x4*)(rowp + bj * HALF)); } }
    }
};
struct EpiGateUp {
    static constexpr bool PERM = true;
    bf16_t* O;
    __device__ __forceinline__ void operator()(const f32x4 (&acc)[2][2][4][2], const Unit& u, int wr, int wc, int fr, int fq) const {
        const int row0 = u.pm * BM + wr * 64 + fr, col0 = u.pn * HALF + wc * 32 + 8 * fq;
#pragma unroll
        for (int ai = 0; ai < 2; ++ai)
#pragma unroll
            for (int m = 0; m < 4; ++m) { bf16_t* rowp = O + (size_t)(row0 + ai * HALF + m * 16) * 1024 + col0;
                f32x4 h0, h1;
#pragma unroll
                for (int i = 0; i < 4; ++i) { const float g0 = acc[ai][0][m][0][i], g1 = acc[ai][0][m][1][i];
                    h0[i] = g0 * sigmoidf_(g0) * acc[ai][1][m][0][i]; h1[i] = g1 * sigmoidf_(g1) * acc[ai][1][m][1][i]; }
                u32x4 w; w.x = cvt_pk_bf16(h0[0], h0[1]); w.y = cvt_pk_bf16(h0[2], h0[3]); w.z = cvt_pk_bf16(h1[0], h1[1]); w.w = cvt_pk_bf16(h1[2], h1[3]);
                __builtin_nontemporal_store(w, (u32x4*)rowp); }
    }
};
struct EpiResid {
    static constexpr bool PERM = false;
    const float* baseL; const float* baseC; float* outL; float* outC; const float* modv; int dummy;
    __device__ __forceinline__ void operator()(const f32x4 (&acc)[2][2][4][2], const Unit& u, int wr, int wc, int fr, int fq) const {
        const bool lat = u.pm < NTL / BM;
        const int rowt = (lat ? u.pm : u.pm - NTL / BM) * BM + wr * 64 + fr, col0 = u.pn * BM + wc * 32 + 4 * fq;
        const float* base = lat ? baseL : baseC; float* out = lat ? outL : outC;
        const int mr = lat ? (u.pm >> 4) : 8;
        const float* gp = modv + (size_t)mr * 6144 + 2048 + col0;
        f32x4 gv[2][2];
#pragma unroll
        for (int bj = 0; bj < 2; ++bj)
#pragma unroll
            for (int n = 0; n < 2; ++n) gv[bj][n] = *(const f32x4*)(gp + bj * HALF + n * 16);
#pragma unroll
        for (int ai = 0; ai < 2; ++ai)
#pragma unroll
            for (int m = 0; m < 4; ++m) { const size_t off = (size_t)(rowt + ai * HALF + m * 16) * DM + col0;
#pragma unroll
                for (int bj = 0; bj < 2; ++bj)
#pragma unroll
                    for (int n = 0; n < 2; ++n) { const f32x4 bs = *(const f32x4*)(base + off + bj * HALF + n * 16);
                        const f32x4 ov = bs + gv[bj][n] * acc[ai][bj][m][n]; if (!dummy || ov[0] == 12345.678f) *(f32x4*)(out + off + bj * HALF + n * 16) = ov; } }
    }
};
}

#define XB_TMO      128
#define XB_XCNT(j)  (256  + 64 * (j))
#define XB_XSUB(j)  (1280 + 64 * (j))
#define XB_XGEN(j)  (2304 + 64 * (j))
#define XB_TOP      3328
#define XB_TOPGEN   3392
#define XCD_BAR_WORDS 3456
#define XB_SPIN_CAP (1u << 20)
__device__ __forceinline__ unsigned xb_ld(unsigned* p)              { return __hip_atomic_load(p, __ATOMIC_RELAXED, __HIP_MEMORY_SCOPE_AGENT); }
__device__ __forceinline__ unsigned xb_add(unsigned* p, unsigned v) { return __hip_atomic_fetch_add(p, v, __ATOMIC_RELAXED, __HIP_MEMORY_SCOPE_AGENT); }
__device__ __forceinline__ unsigned xb_xcc_id() { return (unsigned)__builtin_amdgcn_s_getreg((3 << 11) | 20) & 0xFu; }
#define XB_SPIN(cond, bar) do { unsigned _sp = 0; while (cond) { __builtin_amdgcn_s_sleep(1); \
    if ((++_sp & 255u) == 0u) { if (xb_ld(&(bar)[XB_TMO])) break; if (_sp > XB_SPIN_CAP) { atomicAdd(&(bar)[XB_TMO], 1u); break; } } } } while (0)
struct XcdBarrier { unsigned* bar; unsigned x; volatile LAS unsigned* st; };
__device__ __forceinline__ XcdBarrier xcd_barrier_post(unsigned* bar, volatile LAS unsigned* st) {
    XcdBarrier b; b.bar = bar; b.x = xb_xcc_id(); b.st = st;
    if (threadIdx.x == 0) (void)xb_add(&bar[XB_XCNT(b.x)], 1u);
    return b;
}
__device__ __forceinline__ void xcd_barrier_complete(unsigned* bar, unsigned x, unsigned& nloc, unsigned& nx) {
    const unsigned G = gridDim.x * gridDim.y * gridDim.z;
    unsigned sum, cnt, mine, sp = 0u;
    for (;;) {
        sum = 0u; cnt = 0u; mine = 0u;
#pragma unroll
        for (unsigned j = 0; j < 16; ++j) { const unsigned c = xb_ld(&bar[XB_XCNT(j)]); sum += c; cnt += (c > 0u) ? 1u : 0u; mine = (j == x) ? c : mine; }
        if (sum == G) break;
        __builtin_amdgcn_s_sleep(1);
        if ((++sp & 255u) == 0u) { if (xb_ld(&bar[XB_TMO])) break; if (sp > XB_SPIN_CAP) { atomicAdd(&bar[XB_TMO], 1u); break; } }
    }
    nloc = mine > 0u ? mine : 1u; nx = cnt > 0u ? cnt : 1u;
}
__device__ __forceinline__ void xcd_barrier(const XcdBarrier& b) {
    asm volatile("s_waitcnt vmcnt(0)" ::: "memory");
    __syncthreads();
    if (threadIdx.x == 0) {
        unsigned* bar = b.bar;
        __builtin_amdgcn_s_waitcnt(0);
        unsigned nloc = b.st[0], nx = b.st[1];
        if (nloc == 0u) { xcd_barrier_complete(bar, b.x, nloc, nx); b.st[0] = nloc; b.st[1] = nx; }
        const unsigned old = xb_add(&bar[XB_XSUB(b.x)], 1u);
        const unsigned gen = old / nloc;
        if (old + 1u == (gen + 1u) * nloc) {
            __builtin_amdgcn_fence(__ATOMIC_RELEASE, "agent");
            asm volatile("s_waitcnt vmcnt(0)" ::: "memory");
            const unsigned og = xb_add(&bar[XB_TOP], 1u);
            const unsigned tg = og / nx;
            if (og + 1u == (tg + 1u) * nx) xb_add(&bar[XB_TOPGEN], 1u);
            else XB_SPIN(xb_ld(&bar[XB_TOPGEN]) == tg, bar);
            __builtin_amdgcn_fence(__ATOMIC_ACQUIRE, "agent");
            xb_add(&bar[XB_XGEN(b.x)], 1u);
            asm volatile("s_waitcnt vmcnt(0)" ::: "memory");
        } else {
            XB_SPIN(xb_ld(&bar[XB_XGEN(b.x)]) == gen, bar);
            __builtin_amdgcn_fence(__ATOMIC_ACQUIRE, "agent");
            asm volatile("s_waitcnt vmcnt(0)" ::: "memory");
        }
    }
    __syncthreads();
}

struct Args { const float* in[32]; float* out; unsigned char* ws; int ph_lo, ph_hi; };
enum { I_X = 0, I_C, I_CTX, I_CCTX, I_WMOD, I_BMOD, I_NMIX, I_NFFN, I_WIN, I_WOUT, I_SINK, I_MUP, I_MUN, I_W0, I_W2, I_A0, I_A2, I_V0, I_V1, I_V2, I_G2,
       I_KK, I_KA, I_RK, I_LNW, I_LNB, I_RW, I_RB, I_EG, I_EU, I_ED, I_FNG };

__device__ __forceinline__ void transpose_item(const float* W, int N, int k0, int n0, bf16* dst, int Kp, LAS float* scr, int lane) {
#pragma unroll 8
    for (int i = 0; i < 32; ++i) { const int kk = 2 * i + (lane >> 5); scr[kk * 33 + (lane & 31)] = __builtin_nontemporal_load(W + (size_t)(k0 + kk) * N + n0 + (lane & 31)); }
    asm volatile("s_waitcnt lgkmcnt(0)" ::: "memory");
    const int c = lane & 7;
#pragma unroll
    for (int j = 0; j < 4; ++j) { const int n = (lane >> 3) + 8 * j; const LAS float* s = scr + (8 * c) * 33 + n;
        u32x4 o; o.x = pk2(s[0 * 33], s[1 * 33]); o.y = pk2(s[2 * 33], s[3 * 33]); o.z = pk2(s[4 * 33], s[5 * 33]); o.w = pk2(s[6 * 33], s[7 * 33]);
        __builtin_nontemporal_store(o, (u32x4*)(dst + (size_t)n * Kp + k0 + 8 * c)); }
    asm volatile("s_waitcnt lgkmcnt(0)" ::: "memory");
}

__device__ __forceinline__ void ph_prologue(const Args& a, LAS unsigned char* lds, int tid, int lane, int wave) {
    const int gw = blockIdx.x * 8 + wave, NGW = gridDim.x * 8;
    unsigned char* ws = a.ws;
    LAS float* scr = (LAS float*)(lds + wave * 16384);
    bf16* WinT = (bf16*)(ws + WS_WIN); bf16* WoutT = (bf16*)(ws + WS_WOUT); bf16* WL = (bf16*)(ws + WS_WL);
    constexpr int I_IN = 16 * 84, I_OUT = 16 * 32, I_L = I_IN + I_OUT;
    for (int it = gw; it < 2 * I_L; it += NGW) {
        const int l = it / I_L; int r = it % I_L;
        if (r < I_IN) { const int kb = r / 84, nb = r % 84; transpose_item(a.in[I_WIN] + (size_t)l * DM * INC, INC, kb * 64, nb * 32, WinT + ((size_t)l * INCP + nb * 32) * DM, DM, scr, lane); }
        else { r -= I_IN; const int kb = r / 32, nb = r % 32; transpose_item(a.in[I_WOUT] + (size_t)l * DM * DM, DM, kb * 64, nb * 32, WoutT + ((size_t)l * DM + nb * 32) * DM, DM, scr, lane); }
    }
    for (int i = blockIdx.x * 512 + tid; i < 2 * 128 * DM / 8; i += gridDim.x * 512) { const int l = i / (128 * DM / 8), r = i % (128 * DM / 8);
        *(u32x4*)(WinT + ((size_t)l * INCP + INC) * DM + (size_t)r * 8) = (u32x4){0u, 0u, 0u, 0u}; }
    for (int i = blockIdx.x * 512 + tid; i < 2 * LWC * 128; i += gridDim.x * 512) {
        const int l = i / (LWC * 128), r = i % (LWC * 128), n = r >> 7, k = r & 127; float v = 0.f;
        if (n < 1024) { const int dir = n >> 9, c = n & 511; if ((k >> 6) == dir) v = a.in[I_W2][((size_t)(l * 2 + dir) * 64 + (k & 63)) * 512 + c]; }
        else if (n < 2048) { const int n2 = n - 1024, dir = n2 >> 9, c = n2 & 511; if ((k >> 6) == dir) v = a.in[I_A2][((size_t)(l * 2 + dir) * 64 + (k & 63)) * 512 + c]; }
        else { const int c = n - 2048; v = a.in[I_G2][((size_t)l * 128 + k) * 512 + c]; }
        WL[i] = (bf16)f2bf(v);
    }
    __syncthreads();
    {
        LAS float* sc = (LAS float*)lds; LAS float* red = (LAS float*)(lds + 9 * 1024 * 4);
        float* modv = (float*)(ws + WS_MODV);
        for (int idx = tid; idx < 9 * 1024; idx += 512) { const int r = idx >> 10, k = idx & 1023; const float cv = r < 8 ? a.in[I_C][r * 1024 + k] : a.in[I_CCTX][k]; sc[idx] = cv / (1.0f + __expf(-cv)); }
        __syncthreads();
        for (int it = blockIdx.x; it < 192; it += gridDim.x) {
            const int l = it / 96, n0 = (it % 96) * 64;
            float acc[9];
#pragma unroll
            for (int r = 0; r < 9; ++r) acc[r] = 0.f;
            const float* wp = a.in[I_WMOD] + ((size_t)l * 1024 + wave * 128) * 6144 + n0 + lane;
#pragma unroll 4
            for (int kk = 0; kk < 128; ++kk) { const float wv = wp[(size_t)kk * 6144];
#pragma unroll
                for (int r = 0; r < 9; ++r) acc[r] += sc[r * 1024 + wave * 128 + kk] * wv; }
#pragma unroll
            for (int r = 0; r < 9; ++r) red[(wave * 9 + r) * 64 + lane] = acc[r];
            __syncthreads();
            for (int idx = tid; idx < 576; idx += 512) { const int r = idx >> 6, ln = idx & 63; float s = a.in[I_BMOD][l * 6144 + n0 + ln];
#pragma unroll
                for (int w = 0; w < 8; ++w) s += red[(w * 9 + r) * 64 + ln];
                modv[((size_t)l * 9 + r) * 6144 + n0 + ln] = s; }
            __syncthreads();
        }
    }
}

__device__ __forceinline__ void convert_experts(const Args& a, int l, LAS unsigned char* lds, int lane, int wave) {
    const int gw = blockIdx.x * 8 + wave, NGW = gridDim.x * 8;
    LAS float* scr = (LAS float*)(lds + wave * 16384);
    bf16* WEgu = (bf16*)(a.ws + WS_WE); bf16* WEd = WEgu + (size_t)16 * 2048 * 1024;
    for (int it = gw; it < 3 * 16 * 512; it += NGW) {
        const int mat = it / 8192, r = it % 8192, e = r >> 9, kb = (r >> 5) & 15, nb = r & 31, n0 = nb * 32;
        const float* W = a.in[I_EG + mat] + ((size_t)(l * 16 + e) << 20);
        bf16* dst = mat < 2 ? WEgu + ((size_t)e * 2048 + (n0 >> 7) * 256 + (n0 & 127) + mat * 128) * 1024 : WEd + ((size_t)e * 1024 + n0) * 1024;
        transpose_item(W, 1024, kb * 64, n0, dst, 1024, scr, lane);
    }
}

__device__ __forceinline__ void norm_mod_store(const f32x4 (&v)[4], const float* g, const float* sc, const float* sh, bf16* orow, int lane, f32x4 (&hout)[4], bool dostore = true) {
    float ss = 0.f;
#pragma unroll
    for (int j = 0; j < 4; ++j) ss += (v[j].x * v[j].x + v[j].y * v[j].y) + (v[j].z * v[j].z + v[j].w * v[j].w);
    const float rms = rsqrtf(wave_sum(ss) * (1.0f / DM) + 1e-6f);
#pragma unroll
    for (int j = 0; j < 4; ++j) { const int c = 4 * (lane + 64 * j);
        const f32x4 gg = *(const f32x4*)(g + c), s1 = *(const f32x4*)(sc + c), s0 = *(const f32x4*)(sh + c);
        const f32x4 h = (v[j] * rms * gg) * (s1 + 1.0f) + s0; hout[j] = h;
        u32x2 w; w.x = pk2(h.x, h.y); w.y = pk2(h.z, h.w); if (dostore || h.x == 12345.678f) *(u32x2*)(orow + c) = w; }
}

__device__ __forceinline__ void ph_norm1_l0(const Args& a, int lane, int wave) {
    const int gw = blockIdx.x * 8 + wave, NGW = gridDim.x * 8;
    const float* modv = (const float*)(a.ws + WS_MODV); bf16* H = (bf16*)(a.ws + WS_H);
    for (int row = gw; row < NT; row += NGW) {
        const float* src = row < NTL ? a.in[I_X] + (size_t)row * DM : a.in[I_CTX] + (size_t)(row - NTL) * DM;
        const int mr = row < NTL ? (row >> 12) : 8;
        f32x4 v[4], h[4];
#pragma unroll
        for (int j = 0; j < 4; ++j) v[j] = *(const f32x4*)(src + 4 * (lane + 64 * j));
        norm_mod_store(v, a.in[I_NMIX], modv + (size_t)mr * 6144 + 1024, modv + (size_t)mr * 6144, H + (size_t)row * DM, lane, h);
    }
}

__device__ __forceinline__ void ph_postproj(const Args& a, int l, LAS unsigned char* lds, int tid, int lane, int wave) {
    LAS bf16* vtl = (LAS bf16*)lds;
    LAS bf16* ktl = (LAS bf16*)(lds + 107520);
    LAS bf16* v1T = (LAS bf16*)(lds + 8192); LAS bf16* v2P = (LAS bf16*)(lds + 41472); LAS bf16* VT = (LAS bf16*)(lds + 74240);
    unsigned char* ws = a.ws;
    const bf16* P = (const bf16*)(ws + WS_P);
    bf16* Qr = (bf16*)(ws + WS_QR); bf16* Kr = (bf16*)(ws + WS_KR); bf16* Vt = (bf16*)(ws + WS_VT); bf16* AP = (bf16*)(ws + WS_AP);
    bf16* Rb = (bf16*)(ws + WS_R); bf16* Kb = (bf16*)(ws + WS_K); bf16* V0 = (bf16*)(ws + WS_V0); bf16* Vb = l == 0 ? V0 : (bf16*)(ws + WS_V1);
    const int c0 = lane * 8;
    const u32x4 zero4 = (u32x4){0u, 0u, 0u, 0u};
    u32x4 wp[4], wc[4], wn[4], rq, rk, rv;
#define PP_LOAD_FIRST(tile_) do { const int rowb_ = (tile_) * 32 + wave * 4; const int tb_ = rowb_ >= NTL ? ((rowb_ - NTL) & 255) : (rowb_ & 4095); const bf16* pr0 = P + (size_t)rowb_ * INCP; \
      _Pragma("unroll") for (int j = 0; j < 4; ++j) { const int cg = 768 + j * 512 + c0; const bool act = (j < 3) || (lane < 48); \
          wc[j] = act ? *(const u32x4*)(pr0 + cg) : zero4; wp[j] = (act && tb_ > 0) ? *(const u32x4*)(pr0 - INCP + cg) : zero4; wn[j] = act ? *(const u32x4*)(pr0 + INCP + cg) : zero4; } \
      rq = *(const u32x4*)(pr0 + c0); rk = *(const u32x4*)(pr0 + 512 + (lane & 15) * 8); rv = *(const u32x4*)(pr0 + 640 + (lane & 15) * 8); } while (0)
    if (blockIdx.x < NT / 32) PP_LOAD_FIRST(blockIdx.x);
    if (l > 0) {
        const float* v1 = a.in[I_V1] + (size_t)(l - 1) * 512 * 32; const float* v2 = a.in[I_V2] + (size_t)(l - 1) * 32 * 512;
        for (int idx = tid; idx < 16384; idx += 512) { const int c = idx >> 5, j = idx & 31; v1T[j * 520 + c] = (bf16)f2bf(v1[idx]); }
        for (int idx = tid; idx < 16384; idx += 512) { const int j = idx >> 9, c = idx & 511;
            v2P[c * 32 + ((((j >> 4) * 2 + ((j >> 2) & 1)) * 8) + 4 * ((j >> 3) & 1) + (j & 3))] = (bf16)f2bf(v2[idx]); }
        __syncthreads();
    }
    float* KN = (float*)(ws + WS_KN);
    float kkp[8];
#pragma unroll
    for (int i = 0; i < 8; ++i) kkp[i] = a.in[I_KK][l * 512 + c0 + i];
    float mp[4][8], mn[4][8], vz[8];
    { const float* mup = a.in[I_MUP] + l * 1920; const float* mun = a.in[I_MUN] + l * 1920;
#pragma unroll
      for (int j = 0; j < 4; ++j) { const int cg = j * 512 + c0; const bool act = (j < 3) || (lane < 48);
#pragma unroll
          for (int i = 0; i < 8; ++i) { mp[j][i] = act ? mup[cg + i] : 0.f; mn[j][i] = act ? mun[cg + i] : 0.f; } }
#pragma unroll
      for (int i = 0; i < 8; ++i) vz[i] = l > 0 ? a.in[I_V0][(size_t)(l - 1) * 512 + c0 + i] : 0.f; }
    const int fbase = 8 * (lane & 1), axis = (lane >> 2) & 1, second = (lane >> 1) & 1;
    LAS float* rct = (LAS float*)(lds + 116224); LAS float* rst = (LAS float*)(lds + 120320);
    for (int idx = tid; idx < 1024; idx += 512) { const float ang = (float)(idx >> 4) * exp2f(-(float)(idx & 15) * (13.287712379549449f / 16.0f)); rct[idx] = __cosf(ang); rst[idx] = __sinf(ang); }
    __syncthreads();
    const float QSCALE = 0.125f * 1.4426950408889634f;
    for (int tile = blockIdx.x; tile < NT / 32; tile += gridDim.x) {
    const int rowb = tile * 32 + wave * 4;
    const bool isctx = rowb >= NTL; int tb, len;
    if (!isctx) { tb = rowb & 4095; len = SEQ; } else { tb = (rowb - NTL) & 255; len = CTXL; }
#pragma unroll 1
    for (int rr = 0; rr < 4; ++rr) {
        const int tl = wave * 4 + rr, row = rowb + rr;
        const int t = tb + rr;
        u32x4 nn[4], nq = zero4, nk = zero4, nv = zero4;
        { const bf16* pr2 = P + (size_t)(row + 2) * INCP; const bool ok2 = rr < 3 && (t + 2 < len);
#pragma unroll
          for (int j = 0; j < 4; ++j) { const int cg = 768 + j * 512 + c0; const bool act = (j < 3) || (lane < 48); nn[j] = (act && ok2) ? *(const u32x4*)(pr2 + cg) : zero4; }
          if (rr < 3) { const bf16* pr1 = P + (size_t)(row + 1) * INCP;
              nq = *(const u32x4*)(pr1 + c0); nk = *(const u32x4*)(pr1 + 512 + (lane & 15) * 8); nv = *(const u32x4*)(pr1 + 640 + (lane & 15) * 8); } }
        u32x4 rc[4], rp[4], rn[4];
#pragma unroll
        for (int j = 0; j < 4; ++j) { rc[j] = wc[j]; rp[j] = wp[j]; rn[j] = wn[j]; }
        __builtin_amdgcn_sched_barrier(0);
        float cs[8], sn[8];
        { const int pi = (axis ? (t & 63) : (t >> 6)) * 16 + fbase;
          const f32x4 c0v = *(const LAS f32x4*)(rct + pi), c1v = *(const LAS f32x4*)(rct + pi + 4), s0v = *(const LAS f32x4*)(rst + pi), s1v = *(const LAS f32x4*)(rst + pi + 4);
          cs[0] = c0v.x; cs[1] = c0v.y; cs[2] = c0v.z; cs[3] = c0v.w; cs[4] = c1v.x; cs[5] = c1v.y; cs[6] = c1v.z; cs[7] = c1v.w;
          sn[0] = s0v.x; sn[1] = s0v.y; sn[2] = s0v.z; sn[3] = s0v.w; sn[4] = s1v.x; sn[5] = s1v.y; sn[6] = s1v.z; sn[7] = s1v.w; }
        { float q[8], pq[8]; unpack8(rq, q);
#pragma unroll
          for (int i = 0; i < 8; ++i) pq[i] = xor2_(q[i]);
          if (!isctx) {
#pragma unroll
              for (int i = 0; i < 8; ++i) q[i] = second ? (q[i] * cs[i] + pq[i] * sn[i]) : (q[i] * cs[i] - pq[i] * sn[i]); }
#pragma unroll
          for (int i = 0; i < 8; ++i) q[i] *= QSCALE;
          *(u32x4*)(Qr + (size_t)row * 512 + c0) = pack8(q); }
        { float k[8], pk[8];
          unpack8(rk, k);
#pragma unroll
          for (int i = 0; i < 8; ++i) pk[i] = xor2_(k[i]);
          if (!isctx) {
#pragma unroll
              for (int i = 0; i < 8; ++i) k[i] = second ? (k[i] * cs[i] + pk[i] * sn[i]) : (k[i] * cs[i] - pk[i] * sn[i]); }
          if (lane < 16) {
              *(LAS u32x4*)(ktl + tl * 136 + c0) = pack8(k);
              LAS bf16* vp = vtl + c0 * 32 + tl;
              vp[0 * 32] = (bf16)(rv.x & 0xffffu); vp[1 * 32] = (bf16)(rv.x >> 16); vp[2 * 32] = (bf16)(rv.y & 0xffffu); vp[3 * 32] = (bf16)(rv.y >> 16);
              vp[4 * 32] = (bf16)(rv.z & 0xffffu); vp[5 * 32] = (bf16)(rv.z >> 16); vp[6 * 32] = (bf16)(rv.w & 0xffffu); vp[7 * 32] = (bf16)(rv.w >> 16);
          } }
        float vv[8];
#pragma unroll
        for (int j = 0; j < 4; ++j) {
            float u[8], cur[8], pv[8], nx[8];
            unpack8(rc[j], cur); unpack8(rp[j], pv); unpack8(rn[j], nx);
#pragma unroll
            for (int i = 0; i < 8; ++i) u[i] = cur[i] + mp[j][i] * (pv[i] - cur[i]) + mn[j][i] * (nx[i] - cur[i]);
            if (j == 0) *(u32x4*)(Rb + (size_t)row * 512 + c0) = pack8(u);
            else if (j == 1) { const u32x4 kw = pack8(u); *(u32x4*)(Kb + (size_t)row * 512 + c0) = kw;
                float kq[8]; unpack8(kw, kq); float ss = 0.f;
#pragma unroll
                for (int i = 0; i < 8; ++i) { const float t = kq[i] * kkp[i]; ss += t * t; }
                ss = sum8_(ss);
                if ((lane & 7) == 0) KN[(size_t)row * 8 + (lane >> 3)] = __builtin_amdgcn_rsqf(fmaxf(ss, 1e-24f)); }
            else if (j == 2) {
#pragma unroll
                for (int i = 0; i < 8; ++i) vv[i] = u[i];
            } else if (lane < 48) {
                if (lane < 16) {
#pragma unroll
                    for (int i = 0; i < 8; ++i) { const float e2 = __expf(2.0f * u[i]); u[i] = 1.0f - 2.0f * __builtin_amdgcn_rcpf(e2 + 1.0f); }
                } else if (lane >= 32) {
#pragma unroll
                    for (int i = 0; i < 8; ++i) u[i] = sigmoidf_(u[i]);
                }
                *(u32x4*)(AP + (size_t)row * APC + c0) = pack8(u);
            }
        }
        if (l > 0) *(LAS u32x4*)(VT + tl * 520 + c0) = pack8(vv);
        else *(u32x4*)(Vb + (size_t)row * 512 + c0) = pack8(vv);
#pragma unroll
        for (int j = 0; j < 4; ++j) { wp[j] = wc[j]; wc[j] = wn[j]; wn[j] = nn[j]; }
        rq = nq; rk = nk; rv = nv;
    }
        if (tile + (int)gridDim.x < NT / 32) PP_LOAD_FIRST(tile + (int)gridDim.x);
        if (l > 0) {
            const int l31 = lane & 31, hh = lane >> 5;
            u32x2 fwv[2][4];
#pragma unroll
            for (int ci = 0; ci < 2; ++ci)
#pragma unroll
                for (int g = 0; g < 4; ++g) fwv[ci][g] = *(const u32x2*)(V0 + (size_t)(tile * 32 + l31) * 512 + 32 * (2 * wave + ci) + 8 * g + 4 * hh);
            __syncthreads();
            f32x16 t1;
#pragma unroll
            for (int i = 0; i < 16; ++i) t1[i] = 0.f;
#pragma unroll 8
            for (int ks = 0; ks < 32; ++ks) t1 = __builtin_amdgcn_mfma_f32_32x32x16_bf16(*(const LAS bf16x8*)(v1T + l31 * 520 + 16 * ks + 8 * hh), *(const LAS bf16x8*)(VT + l31 * 520 + 16 * ks + 8 * hh), t1, 0, 0, 0);
            bf16x8 tb[2];
#pragma unroll
            for (int sI = 0; sI < 2; ++sI) { u32x4 w; w.x = pk2(t1[8 * sI + 0], t1[8 * sI + 1]); w.y = pk2(t1[8 * sI + 2], t1[8 * sI + 3]); w.z = pk2(t1[8 * sI + 4], t1[8 * sI + 5]); w.w = pk2(t1[8 * sI + 6], t1[8 * sI + 7]); tb[sI] = __builtin_bit_cast(bf16x8, w); }
            const int row0 = tile * 32;
            __syncthreads();
#pragma unroll
            for (int ci = 0; ci < 2; ++ci) {
                const int ct = 2 * wave + ci;
                f32x16 z;
#pragma unroll
                for (int i = 0; i < 16; ++i) z[i] = 0.f;
#pragma unroll
                for (int sI = 0; sI < 2; ++sI) z = __builtin_amdgcn_mfma_f32_32x32x16_bf16(*(const LAS bf16x8*)(v2P + (32 * ct + l31) * 32 + (sI * 2 + hh) * 8), tb[sI], z, 0, 0, 0);
#pragma unroll
                for (int g = 0; g < 4; ++g) { const int c = 32 * ct + 8 * g + 4 * hh;
                    const f32x4 zb = *(const f32x4*)(a.in[I_V0] + (size_t)(l - 1) * 512 + c);
                    LAS u32x2* vp = (LAS u32x2*)(VT + l31 * 520 + c); const u32x2 vw = *vp, fw = fwv[ci][g];
                    const float v0_ = bflo(vw.x), v1_ = bfhi(vw.x), v2_ = bflo(vw.y), v3_ = bfhi(vw.y), f0 = bflo(fw.x), f1 = bfhi(fw.x), f2 = bflo(fw.y), f3 = bfhi(fw.y);
                    u32x2 ow; ow.x = pk2(v0_ + (f0 - v0_) * sigmoidf_(z[4 * g] + zb.x), v1_ + (f1 - v1_) * sigmoidf_(z[4 * g + 1] + zb.y));
                    ow.y = pk2(v2_ + (f2 - v2_) * sigmoidf_(z[4 * g + 2] + zb.z), v3_ + (f3 - v3_) * sigmoidf_(z[4 * g + 3] + zb.w)); *vp = ow; }
            }
            __syncthreads();
#pragma unroll
            for (int rr = 0; rr < 4; ++rr) { const int tl = wave * 4 + rr; *(u32x4*)(Vb + (size_t)(row0 + tl) * 512 + c0) = *(const LAS u32x4*)(VT + tl * 520 + c0); }
        }
        __syncthreads();
        { const int row0 = tile * 32; const bool isctx = row0 >= NTL; int b, pt;
          if (!isctx) { b = row0 >> 12; pt = (CTXL + (row0 & 4095)) >> 5; } else { const int r2 = row0 - NTL; b = r2 >> 8; pt = (r2 & 255) >> 5; }
          const int hk = tid >> 8, f = (tid >> 6) & 3, ln = tid & 63, l31 = ln & 31, lh = ln >> 5;
          const size_t toff = ((size_t)((b * 2 + hk) * 136 + pt)) * 2048 + (size_t)(f * 64 + ln) * 8;
          *(u32x4*)(Kr + toff) = *(const LAS u32x4*)(ktl + l31 * 136 + hk * 64 + 16 * f + 8 * lh);
          const LAS bf16* vp = vtl + (hk * 64 + (f >> 1) * 32 + l31) * 32 + 16 * (f & 1) + 4 * lh;
          const u32x2 lo = *(const LAS u32x2*)vp, hi2 = *(const LAS u32x2*)(vp + 8);
          *(u32x4*)(Vt + toff) = (u32x4){lo.x, lo.y, hi2.x, hi2.y}; }
        __syncthreads();
    }
#undef PP_LOAD_FIRST
}

__device__ __forceinline__ bf16x8 ld_bf16x8(const bf16* p) { return *(const bf16x8*)p; }
struct AttnFrag { bf16x8 kf[4]; };
__device__ __forceinline__ void attn_load(AttnFrag& F, const bf16* ktile, int lane) {
#pragma unroll
    for (int s = 0; s < 4; ++s) F.kf[s] = ld_bf16x8(ktile + (s * 64 + lane) * 8);
}
__device__ __forceinline__ void attn_compute(f32x16 (&o)[2][2], float (&m)[2], float (&ls)[2], const bf16x8 (&qf)[2][4], const AttnFrag& F, const bf16* vtile  ,
                                             bool masked, int kj0, int qi0, int lane, int r32, int hi) {
    bf16x8 vf[2][2];
#pragma unroll
    for (int dt = 0; dt < 2; ++dt)
#pragma unroll
        for (int s2 = 0; s2 < 2; ++s2) vf[dt][s2] = ld_bf16x8(vtile + ((dt * 2 + s2) * 64 + lane) * 8);
#pragma unroll
    for (int qt = 0; qt < 2; ++qt) {
        f32x16 s;
        { const float nm = -m[qt];
#pragma unroll
          for (int i = 0; i < 16; ++i) s[i] = nm; }
#pragma unroll
        for (int ks = 0; ks < 4; ++ks) s = __builtin_amdgcn_mfma_f32_32x32x16_bf16(F.kf[ks], qf[qt][ks], s, 0, 0, 0);
        if (masked && ((kj0 + 31) - (qi0 + qt * 32) > 128 || kj0 - (qi0 + qt * 32 + 31) < -128)) {
            const int qi = qi0 + qt * 32 + r32;
#pragma unroll
            for (int i = 0; i < 16; ++i) { const int kj = kj0 + (i & 3) + 8 * (i >> 2) + 4 * hi; const int d = kj - qi; s[i] = (d <= 128 && d >= -128) ? s[i] : -1e30f; } }
        float tm = s[0];
#pragma unroll
        for (int i = 1; i < 16; ++i) tm = fmaxf(tm, s[i]);
        { float ra_, rb_; swap32(tm, tm, ra_, rb_); tm = fmaxf(ra_, rb_); }
        if (!__all(tm <= 8.0f)) {
            const float d = fmaxf(tm, 0.f), alpha = __builtin_amdgcn_exp2f(-d);
            m[qt] += d; ls[qt] *= alpha;
#pragma unroll
            for (int dt = 0; dt < 2; ++dt)
#pragma unroll
                for (int i = 0; i < 16; ++i) o[qt][dt][i] *= alpha;
#pragma unroll
            for (int i = 0; i < 16; ++i) s[i] -= d;
        }
        float ps = 0.f; float p[16];
#pragma unroll
        for (int i = 0; i < 16; ++i) { p[i] = __builtin_amdgcn_exp2f(s[i]); ps += p[i]; }
        ls[qt] += ps;
        bf16x8 pf[2];
#pragma unroll
        for (int s2 = 0; s2 < 2; ++s2) { u32x4 w; w.x = pk2(p[8 * s2 + 0], p[8 * s2 + 1]); w.y = pk2(p[8 * s2 + 2], p[8 * s2 + 3]); w.z = pk2(p[8 * s2 + 4], p[8 * s2 + 5]); w.w = pk2(p[8 * s2 + 6], p[8 * s2 + 7]); pf[s2] = __builtin_bit_cast(bf16x8, w); }
#pragma unroll
        for (int dt = 0; dt < 2; ++dt)
#pragma unroll
            for (int s2 = 0; s2 < 2; ++s2) o[qt][dt] = __builtin_amdgcn_mfma_f32_32x32x16_bf16(vf[dt][s2], pf[s2], o[qt][dt], 0, 0, 0);
    }
}

__device__ __forceinline__ void ph_attention(const Args& a, int l, int lane, int wave) {
    unsigned char* ws = a.ws;
    const bf16* Qr = (const bf16*)(ws + WS_QR); const bf16* Kr = (const bf16*)(ws + WS_KR); const bf16* Vt = (const bf16*)(ws + WS_VT); bf16* H = (bf16*)(ws + WS_H);
    const int nunits = 512 + (l == 0 ? 32 : 0);
    const int r32 = lane & 31, hi = lane >> 5, g = wave >> 1, qh = wave & 1;
    for (int un = blockIdx.x; un < nunits; un += gridDim.x) {
        const bool cq = un >= 512; int b, hkv, n;
        if (!cq) { b = un >> 6; hkv = (un >> 5) & 1; n = un & 31; } else { const int u2 = un - 512; b = u2 >> 2; hkv = (u2 >> 1) & 1; n = u2 & 1; }
        const int hq = hkv * 4 + g;
        const int qrow0 = (cq ? NTL + b * CTXL : b * SEQ) + n * 128 + qh * 64;
        bf16x8 qf[2][4];
#pragma unroll
        for (int qt = 0; qt < 2; ++qt)
#pragma unroll
            for (int s = 0; s < 4; ++s) qf[qt][s] = ld_bf16x8(Qr + (size_t)(qrow0 + qt * 32 + r32) * 512 + hq * 64 + 16 * s + 8 * hi);
        f32x16 o[2][2];
#pragma unroll
        for (int qt = 0; qt < 2; ++qt)
#pragma unroll
            for (int dt = 0; dt < 2; ++dt)
#pragma unroll
                for (int i = 0; i < 16; ++i) o[qt][dt][i] = 0.f;
        float m[2], ls[2];
        const float sk = a.in[I_SINK][l * 8 + hq] * 1.4426950408889634f;
        m[0] = sk; m[1] = sk; ls[0] = hi == 0 ? 1.0f : 0.0f; ls[1] = ls[0];
        int jmin = 2 * qh, jmax = 2 * qh + 10;
        if (!cq) { const int lo = 4 - 4 * n, hi2 = (SEQ + 128 - 128 * n) / 32; jmin = jmin > lo ? jmin : lo; jmax = jmax < hi2 ? jmax : hi2; } else { jmax = jmin; }
        const int nw = jmax - jmin, T = nw + 8;
        const size_t hbase = (size_t)((b * 2 + hkv) * 136) * 2048;
        const int wt0 = 4 + 4 * n + jmin;
        AttnFrag F0, F1;
#define ATT_TI(t) ((t) < nw ? wt0 + (t) : (t) - nw)
#define ATT_LOAD(F, t) attn_load(F, Kr + hbase + (size_t)ATT_TI(t) * 2048, lane)
#define ATT_VB(t) (Vt + hbase + (size_t)ATT_TI(t) * 2048)
        ATT_LOAD(F0, 0);
        for (int t = 0; t < T; t += 2) {
            ATT_LOAD(F1, t + 1);
            attn_compute(o, m, ls, qf, F0, ATT_VB(t), t < nw, -128 + 32 * (jmin + t), qh * 64, lane, r32, hi);
            if (t + 2 < T) ATT_LOAD(F0, t + 2);
            attn_compute(o, m, ls, qf, F1, ATT_VB(t + 1), t + 1 < nw, -128 + 32 * (jmin + t + 1), qh * 64, lane, r32, hi);
        }
#undef ATT_TI
#undef ATT_VB
#undef ATT_LOAD
#pragma unroll
        for (int qt = 0; qt < 2; ++qt) {
            float lt; { float ra_, rb_; swap32(ls[qt], ls[qt], ra_, rb_); lt = ra_ + rb_; } const float inv = 1.0f / lt;
            bf16* orow = H + (size_t)(qrow0 + qt * 32 + r32) * DM + hq * 64;
#pragma unroll
            for (int dt = 0; dt < 2; ++dt)
#pragma unroll
                for (int g4 = 0; g4 < 4; ++g4) { u32x2 w; w.x = pk2(o[qt][dt][4 * g4 + 0] * inv, o[qt][dt][4 * g4 + 1] * inv); w.y = pk2(o[qt][dt][4 * g4 + 2] * inv, o[qt][dt][4 * g4 + 3] * inv);
                    *(u32x2*)(orow + dt * 32 + 8 * g4 + 4 * hi) = w; }
        }
    }
}

constexpr int SG = 4;
constexpr int SVEC = 384;
constexpr int SCAN_WLDS = SG * SVEC * 4;
struct ScanRaw { unsigned short kx[SG], rx[SG], ax[SG], wx[SG], vx[SG]; float rn[SG]; };

__device__ __forceinline__ void scan_load(const Args& a, int l, int b, int h, int dir, int s0, ScanRaw& R, int lane) {
    const bf16* Rb = (const bf16*)(a.ws + WS_R); const bf16* Kb = (const bf16*)(a.ws + WS_K); const bf16* Vb = (const bf16*)(a.ws + (l == 0 ? WS_V0 : WS_V1));
    const bf16* LW = (const bf16*)(a.ws + WS_P); const float* KN = (const float*)(a.ws + WS_KN);
    const int hc = h * 64 + lane;
#pragma unroll
    for (int gi = 0; gi < SG; ++gi) {
        const int s = s0 + gi, pos = dir == 0 ? s : (s < CTXL ? CTXL - 1 - s : POSN + CTXL - 1 - s), row = row_of(b, pos);
        const unsigned o5 = (unsigned)(row * 512 + hc), ol = (unsigned)(row * LWC + dir * 512 + hc);
        R.kx[gi] = Kb[o5]; R.rx[gi] = Rb[o5]; R.vx[gi] = Vb[o5];
        R.wx[gi] = LW[ol]; R.ax[gi] = LW[ol + 1024u]; R.rn[gi] = KN[row * 8 + h];
    }
}
__device__ __forceinline__ void scan_write(const ScanRaw& R, float kkw, float kaw, float w0b, float a0b, LAS float* wl, int lane, float& gam, bool last_of_16) {
#pragma unroll
    for (int gi = 0; gi < SG; ++gi) {
        const float kxf = bf2f(R.kx[gi]);
        const float wv = __expf(-0.60653066f * sigmoidf_(bf2f(R.wx[gi]) + w0b)), av = sigmoidf_(bf2f(R.ax[gi]) + a0b);
        const float kk = kxf * kkw * R.rn[gi];
        const float kd = kxf * (1.0f + (av - 1.0f) * kaw), bb = kk * av;
        const float kks = kk * gam;
        gam *= wv;
        const float ig = __builtin_amdgcn_rcpf(gam);
        LAS float* p = wl + gi * SVEC + lane;
        const float rf = bf2f(R.rx[gi]);
        p[0] = gam; p[64] = __builtin_bit_cast(float, pk2(kd * ig, bb * ig)); p[128] = kks; p[256] = rf * gam; p[320] = bf2f(R.vx[gi]);
        LAS bf16* fr = (LAS bf16*)(wl + gi * SVEC + 192);
        const int fo = ((((lane >> 5) * 2 + ((lane >> 4) & 1)) * 2 + ((lane >> 2) & 1)) * 8) + 4 * ((lane >> 3) & 1) + (lane & 3);
        fr[fo] = f2bf1((last_of_16 && gi == SG - 1) ? rf : rf * gam); fr[64 + fo] = f2bf1(kks);
    }
    if (last_of_16) gam = 1.0f;
}
__device__ __forceinline__ void fmac_(float& acc, float x, float y) { asm("v_fmac_f32 %0, %1, %2" : "+v"(acc) : "v"(x), "v"(y)); }
__device__ __forceinline__ float fma_(float x, float y, float z) { float d; asm("v_fma_f32 %0, %1, %2, %3" : "=v"(d) : "v"(x), "v"(y), "v"(z)); return d; }
__device__ __forceinline__ float mul_(float x, float y) { float d; asm("v_mul_f32 %0, %1, %2" : "=v"(d) : "v"(x), "v"(y)); return d; }
__device__ __forceinline__ void dot4_(float& acc, float s0, float s1, float s2, float s3, f32x4 k) {
    asm("v_fmac_f32 %0, %1, %5\n\tv_fmac_f32 %0, %2, %6\n\tv_fmac_f32 %0, %3, %7\n\tv_fmac_f32 %0, %4, %8"
        : "+v"(acc) : "v"(s0), "v"(s1), "v"(s2), "v"(s3), "v"(k.x), "v"(k.y), "v"(k.z), "v"(k.w));
}
__device__ __forceinline__ void dot4x4_(float& a0, float& a1, float& a2, float& a3, const float* s0, const float* s1, const float* s2, const float* s3, f32x4 k) {
    asm("v_fmac_f32 %0, %4, %20\n\tv_fmac_f32 %1, %8, %20\n\tv_fmac_f32 %2, %12, %20\n\tv_fmac_f32 %3, %16, %20\n\t"
        "v_fmac_f32 %0, %5, %21\n\tv_fmac_f32 %1, %9, %21\n\tv_fmac_f32 %2, %13, %21\n\tv_fmac_f32 %3, %17, %21\n\t"
        "v_fmac_f32 %0, %6, %22\n\tv_fmac_f32 %1, %10, %22\n\tv_fmac_f32 %2, %14, %22\n\tv_fmac_f32 %3, %18, %22\n\t"
        "v_fmac_f32 %0, %7, %23\n\tv_fmac_f32 %1, %11, %23\n\tv_fmac_f32 %2, %15, %23\n\tv_fmac_f32 %3, %19, %23"
        : "+v"(a0), "+v"(a1), "+v"(a2), "+v"(a3)
        : "v"(s0[0]), "v"(s0[1]), "v"(s0[2]), "v"(s0[3]), "v"(s1[0]), "v"(s1[1]), "v"(s1[2]), "v"(s1[3]),
          "v"(s2[0]), "v"(s2[1]), "v"(s2[2]), "v"(s2[3]), "v"(s3[0]), "v"(s3[1]), "v"(s3[2]), "v"(s3[3]), "v"(k.x), "v"(k.y), "v"(k.z), "v"(k.w));
}
__device__ __forceinline__ void upd4_p(float& s0, float& s1, float& s2, float& s3, float d, f32x4 w, f32x4 b) {
    float t0, t1, t2, t3;
    asm("v_mul_f32 %4, %8, %13\n\tv_mul_f32 %5, %8, %14\n\tv_mul_f32 %6, %8, %15\n\tv_mul_f32 %7, %8, %16\n\t"
        "v_fma_f32 %0, %0, %9, %4\n\tv_fma_f32 %1, %1, %10, %5\n\tv_fma_f32 %2, %2, %11, %6\n\tv_fma_f32 %3, %3, %12, %7"
        : "+v"(s0), "+v"(s1), "+v"(s2), "+v"(s3), "=&v"(t0), "=&v"(t1), "=&v"(t2), "=&v"(t3)
        : "v"(d), "v"(w.x), "v"(w.y), "v"(w.z), "v"(w.w), "v"(b.x), "v"(b.y), "v"(b.z), "v"(b.w));
}
__device__ __forceinline__ void upd4_l(float& s0, float& s1, float& s2, float& s3, float d, float v, f32x4 w, f32x4 k, f32x4 b) {
    float t0, t1, t2, t3;
    asm("v_mul_f32 %4, %8, %14\n\tv_mul_f32 %5, %8, %15\n\tv_mul_f32 %6, %8, %16\n\tv_mul_f32 %7, %8, %17\n\t"
        "v_fmac_f32 %4, %9, %18\n\tv_fmac_f32 %5, %9, %19\n\tv_fmac_f32 %6, %9, %20\n\tv_fmac_f32 %7, %9, %21\n\t"
        "v_fma_f32 %0, %0, %10, %4\n\tv_fma_f32 %1, %1, %11, %5\n\tv_fma_f32 %2, %2, %12, %6\n\tv_fma_f32 %3, %3, %13, %7"
        : "+v"(s0), "+v"(s1), "+v"(s2), "+v"(s3), "=&v"(t0), "=&v"(t1), "=&v"(t2), "=&v"(t3)
        : "v"(d), "v"(v), "v"(w.x), "v"(w.y), "v"(w.z), "v"(w.w), "v"(b.x), "v"(b.y), "v"(b.z), "v"(b.w), "v"(k.x), "v"(k.y), "v"(k.z), "v"(k.w));
}
__device__ __forceinline__ float qsum(float x) {
    float r;
    asm("s_nop 1\n\tv_add_f32_dpp %0, %1, %1 quad_perm:[1,0,3,2] row_mask:0xf bank_mask:0xf" : "=v"(r) : "v"(x));
    asm("s_nop 1\n\tv_add_f32_dpp %0, %1, %1 quad_perm:[2,3,0,1] row_mask:0xf bank_mask:0xf" : "=v"(x) : "v"(r));
    return x;
}

__device__ __forceinline__ bf16x8 mk_frag(unsigned w0) { const u32x4 w = {w0, 0u, 0u, 0u}; return __builtin_bit_cast(bf16x8, w); }
__device__ __forceinline__ void ph_scan1(const Args& a, int l, LAS unsigned char* lds, int lane, int wave) {
    LAS float* wl = (LAS float*)(lds + wave * SCAN_WLDS);
    float* PC = (float*)(a.ws + WS_PC); float* LC = (float*)(a.ws + WS_LC);
    const int gw = blockIdx.x * 8 + wave, NGW = gridDim.x * 8;
    const int l31 = lane & 31, hh = lane >> 5;
    for (int item = gw; item < 2048; item += NGW) {
        const int c = item & 15, dir = (item >> 4) & 1, h = (item >> 5) & 7, b = item >> 8;
        if (c == NCH - 1) continue;
        const int hc = h * 64 + lane;
        const float kkw = a.in[I_KK][l * 512 + hc], kaw = a.in[I_KA][l * 512 + hc];
        const float w0b = a.in[I_W0][(l * 2 + dir) * 512 + hc], a0b = a.in[I_A0][(l * 2 + dir) * 512 + hc];
        f32x16 CP[2][2], CL[2][2];
        { int ln = lane; asm volatile("" : "+v"(ln));
          const int dg = (ln & 31) - 4 * (ln >> 5);
#pragma unroll
          for (int tr = 0; tr < 2; ++tr)
#pragma unroll
            for (int tc = 0; tc < 2; ++tc)
#pragma unroll
                for (int r = 0; r < 16; ++r) { CP[tr][tc][r] = (tr == tc && dg == (r & 3) + 8 * (r >> 2)) ? 1.0f : 0.0f; CL[tr][tc][r] = 0.f; } }
        ScanRaw R; float gam = 1.0f;
        scan_load(a, l, b, h, dir, c * CHL, R, lane);
        for (int s0 = c * CHL; s0 < (c + 1) * CHL; s0 += SG) {
            const bool renorm = (((s0 - c * CHL) >> 2) & 3) == 3;
            __builtin_amdgcn_sched_barrier(0);
            scan_write(R, kkw, kaw, w0b, a0b, wl, lane, gam, renorm);
            if (s0 + SG < (c + 1) * CHL) scan_load(a, l, b, h, dir, s0 + SG, R, lane);
            __builtin_amdgcn_sched_barrier(0);
#pragma unroll 1
            for (int gi = 0; gi < SG; ++gi) {
                const LAS float* base = wl + gi * SVEC;
                const LAS f32x4* pv = (const LAS f32x4*)(base + 4 * hh);
                f32x4 KK[2][4];
#pragma unroll
                for (int tr = 0; tr < 2; ++tr)
#pragma unroll
                    for (int g = 0; g < 4; ++g) KK[tr][g] = pv[32 + 8 * tr + 2 * g];
                float aop[2], vrr[2];
#pragma unroll
                for (int t = 0; t < 2; ++t) { aop[t] = base[64 + 32 * t + l31]; vrr[t] = base[320 + 32 * t + l31]; }
                __builtin_amdgcn_sched_barrier(0);
                const bf16x8 af[2] = {mk_frag(hh ? 0u : __builtin_bit_cast(unsigned, aop[0])), mk_frag(hh ? 0u : __builtin_bit_cast(unsigned, aop[1]))};
                float ra, rb;
                float dp[2];
#pragma unroll
                for (int tc = 0; tc < 2; ++tc) { float p0 = 0.f, p1 = 0.f;
#pragma unroll
                    for (int g = 0; g < 4; ++g)
#pragma unroll
                        for (int i = 0; i < 4; ++i) { p0 = __builtin_fmaf(CP[0][tc][4 * g + i], KK[0][g][i], p0); p1 = __builtin_fmaf(CP[1][tc][4 * g + i], KK[1][g][i], p1); }
                    dp[tc] = p0 + p1; }
                float dp0, dp1;
                swap32(dp[0], dp[1], ra, rb); { const float sd = ra + rb; swap32(sd, sd, dp0, dp1); }
                const bf16x8 bp0 = mk_frag(hh ? 0u : pk2(0.f, -dp0)), bp1 = mk_frag(hh ? 0u : pk2(0.f, -dp1));
                __builtin_amdgcn_sched_barrier(0);
                CP[0][0] = __builtin_amdgcn_mfma_f32_32x32x16_bf16(af[0], bp0, CP[0][0], 0, 0, 0);
                CP[1][0] = __builtin_amdgcn_mfma_f32_32x32x16_bf16(af[1], bp0, CP[1][0], 0, 0, 0);
                CP[0][1] = __builtin_amdgcn_mfma_f32_32x32x16_bf16(af[0], bp1, CP[0][1], 0, 0, 0);
                CP[1][1] = __builtin_amdgcn_mfma_f32_32x32x16_bf16(af[1], bp1, CP[1][1], 0, 0, 0);
                __builtin_amdgcn_sched_barrier(0);
                float dl[2];
#pragma unroll
                for (int tc = 0; tc < 2; ++tc) { float q0 = 0.f, q1 = 0.f;
#pragma unroll
                    for (int g = 0; g < 4; ++g)
#pragma unroll
                        for (int i = 0; i < 4; ++i) { q0 = __builtin_fmaf(CL[0][tc][4 * g + i], KK[0][g][i], q0); q1 = __builtin_fmaf(CL[1][tc][4 * g + i], KK[1][g][i], q1); }
                    dl[tc] = q0 + q1; }
                float dl0, dl1;
                swap32(dl[0], dl[1], ra, rb); { const float sd = ra + rb; swap32(sd, sd, dl0, dl1); }
                const bf16x8 bl0 = mk_frag(hh ? 0u : pk2(vrr[0], -dl0)), bl1 = mk_frag(hh ? 0u : pk2(vrr[1], -dl1));
                __builtin_amdgcn_sched_barrier(0);
                CL[0][0] = __builtin_amdgcn_mfma_f32_32x32x16_bf16(af[0], bl0, CL[0][0], 0, 0, 0);
                CL[1][0] = __builtin_amdgcn_mfma_f32_32x32x16_bf16(af[1], bl0, CL[1][0], 0, 0, 0);
                CL[0][1] = __builtin_amdgcn_mfma_f32_32x32x16_bf16(af[0], bl1, CL[0][1], 0, 0, 0);
                CL[1][1] = __builtin_amdgcn_mfma_f32_32x32x16_bf16(af[1], bl1, CL[1][1], 0, 0, 0);
                __builtin_amdgcn_sched_barrier(0);
                if (renorm && gi == SG - 1) {
#pragma unroll
                    for (int tr = 0; tr < 2; ++tr)
#pragma unroll
                        for (int g = 0; g < 4; ++g) { const f32x4 G = pv[8 * tr + 2 * g];
#pragma unroll
                            for (int tc = 0; tc < 2; ++tc)
#pragma unroll
                                for (int i = 0; i < 4; ++i) { CP[tr][tc][4 * g + i] *= G[i]; CL[tr][tc][4 * g + i] *= G[i]; } }
                }
            }
        }
        int item_o = item; asm volatile("" : "+s"(item_o));
#pragma unroll
        for (int tc = 0; tc < 2; ++tc) { float* po = PC + ((size_t)item_o * 64 + 32 * tc + l31) * 64 + 4 * hh; float* lo = LC + ((size_t)item_o * 64 + 32 * tc + l31) * 64 + 4 * hh;
#pragma unroll
            for (int tr = 0; tr < 2; ++tr)
#pragma unroll
                for (int g = 0; g < 4; ++g) { *(f32x4*)(po + 32 * tr + 8 * g) = (f32x4){CP[tr][tc][4 * g], CP[tr][tc][4 * g + 1], CP[tr][tc][4 * g + 2], CP[tr][tc][4 * g + 3]};
                    *(f32x4*)(lo + 32 * tr + 8 * g) = (f32x4){CL[tr][tc][4 * g], CL[tr][tc][4 * g + 1], CL[tr][tc][4 * g + 2], CL[tr][tc][4 * g + 3]}; } }
    }
}

__device__ __forceinline__ void split_bf16x8(const float (&x)[8], bf16x8& hi, bf16x8& lo) {
    u32x4 h, l;
    h.x = pk2(x[0], x[1]); h.y = pk2(x[2], x[3]); h.z = pk2(x[4], x[5]); h.w = pk2(x[6], x[7]);
    l.x = pk2(x[0] - bflo(h.x), x[1] - bfhi(h.x)); l.y = pk2(x[2] - bflo(h.y), x[3] - bfhi(h.y)); l.z = pk2(x[4] - bflo(h.z), x[5] - bfhi(h.z)); l.w = pk2(x[6] - bflo(h.w), x[7] - bfhi(h.w));
    hi = __builtin_bit_cast(bf16x8, h); lo = __builtin_bit_cast(bf16x8, l);
}
template <int VAR> __device__ __forceinline__ void ph_scan2(const Args& a, LAS unsigned char* lds, int tid, int lane, int wave) {
    const float* PC = (const float*)(a.ws + WS_PC); float* LC = (float*)(a.ws + WS_LC);
    const int l31 = lane & 31, hh = lane >> 5;
    if (wave != 0) {
        for (int u = blockIdx.x; u < 256; u += gridDim.x) {
            const int sid = u >> 1, t = (wave - 1) * 64 + lane; float sink = 0.f;
#pragma unroll
            for (int k = 0; k < 6; ++k) { const int id = t + 448 * k;
                if (id < 14 * 192) { const int c = 1 + id / 192, r = id % 192;
                    const float* pl = r < 128 ? PC + (size_t)(sid * 16 + c) * 4096 + r * 32 : LC + ((size_t)(sid * 16 + c) * 64 + 32 * (u & 1)) * 64 + (r - 128) * 32;
                    sink += *pl; } }
            asm volatile("" :: "v"(sink));
        }
        return;
    }
    for (int u = blockIdx.x; u < 256; u += gridDim.x) {
        const int sid = u >> 1, i = 32 * (u & 1) + l31;
        f32x16 acc[2];
#pragma unroll
        for (int ct = 0; ct < 2; ++ct)
#pragma unroll
            for (int g = 0; g < 4; ++g) { const f32x4 x = *(const f32x4*)(LC + ((size_t)(sid * 16) * 64 + i) * 64 + 32 * ct + 8 * g + 4 * hh); acc[ct][4 * g] = x.x; acc[ct][4 * g + 1] = x.y; acc[ct][4 * g + 2] = x.z; acc[ct][4 * g + 3] = x.w; }
        float pr[8][8]; f32x4 lr[2][4];
#define SC2_LOADP(co_, pc_) do { _Pragma("unroll") for (int k_ = 0; k_ < 4; ++k_) { const float* pb_ = (pc_) + (16 * k_ + 4 * hh) * 64 + 32 * (co_) + l31; \
            _Pragma("unroll") for (int jj = 0; jj < 8; ++jj) pr[(co_) * 4 + k_][jj] = pb_[((jj & 3) + 8 * (jj >> 2)) * 64]; } } while (0)
#define SC2_LOADL(cc_) do { const float* lp_ = LC + ((size_t)(sid * 16 + (cc_)) * 64 + i) * 64 + 4 * hh; _Pragma("unroll") for (int ct = 0; ct < 2; ++ct) _Pragma("unroll") for (int g = 0; g < 4; ++g) lr[ct][g] = *(const f32x4*)(lp_ + 32 * ct + 8 * g); } while (0)
        { const float* pc = PC + (size_t)(sid * 16 + 1) * 4096; SC2_LOADP(0, pc); SC2_LOADP(1, pc); SC2_LOADL(1); }
#pragma unroll 1
        for (int c = 1; c < NCH - 1; ++c) {
            const bool more = c + 1 < NCH - 1;
            const float* pcn = PC + (size_t)(sid * 16 + c + 1) * 4096;
            bf16x8 bh[4], bl[4];
#pragma unroll
            for (int ck = 0; ck < 2; ++ck)
#pragma unroll
                for (int sI = 0; sI < 2; ++sI) { float x[8];
#pragma unroll
                    for (int jj = 0; jj < 8; ++jj) x[jj] = acc[ck][8 * sI + jj];
                    split_bf16x8(x, bh[ck * 2 + sI], bl[ck * 2 + sI]); }
#pragma unroll
            for (int ct = 0; ct < 2; ++ct)
#pragma unroll
                for (int g = 0; g < 4; ++g) { acc[ct][4 * g] = lr[ct][g].x; acc[ct][4 * g + 1] = lr[ct][g].y; acc[ct][4 * g + 2] = lr[ct][g].z; acc[ct][4 * g + 3] = lr[ct][g].w; }
            __builtin_amdgcn_sched_barrier(0);
            if (more) SC2_LOADL(c + 1);
#pragma unroll
            for (int co = 0; co < 2; ++co) {
                bf16x8 ah[4], al[4];
#pragma unroll
                for (int k = 0; k < 4; ++k) split_bf16x8(pr[co * 4 + k], ah[k], al[k]);
                __builtin_amdgcn_sched_barrier(0);
                if (more) { if (co == 0) SC2_LOADP(0, pcn); else SC2_LOADP(1, pcn); }
                __builtin_amdgcn_sched_barrier(0);
#pragma unroll
                for (int k = 0; k < 4; ++k) {
                    acc[co] = __builtin_amdgcn_mfma_f32_32x32x16_bf16(ah[k], bh[k], acc[co], 0, 0, 0);
                    acc[co] = __builtin_amdgcn_mfma_f32_32x32x16_bf16(ah[k], bl[k], acc[co], 0, 0, 0);
                    acc[co] = __builtin_amdgcn_mfma_f32_32x32x16_bf16(al[k], bh[k], acc[co], 0, 0, 0); }
                __builtin_amdgcn_sched_barrier(0);
            }
            float* lcp = LC + ((size_t)(sid * 16 + c) * 64 + i) * 64 + 4 * hh;
#pragma unroll
            for (int ct = 0; ct < 2; ++ct)
#pragma unroll
                for (int g = 0; g < 4; ++g) if (VAR == 0 || acc[ct][4 * g] == 12345.678f) *(f32x4*)(lcp + 32 * ct + 8 * g) = (f32x4){acc[ct][4 * g], acc[ct][4 * g + 1], acc[ct][4 * g + 2], acc[ct][4 * g + 3]};
        }
#undef SC2_LOADP
#undef SC2_LOADL
    }
}

#ifndef PVAR
#define PVAR 0
#endif
template <int VAR> __device__ __forceinline__ void ph_scan3(const Args& a, int l, LAS unsigned char* lds, int lane, int wave) {
    LAS float* wl = (LAS float*)(lds + wave * (2 * SCAN_WLDS));
    LAS float* zer = (LAS float*)(lds + 8 * 2 * SCAN_WLDS + wave * 128);
    const float* LC = (const float*)(a.ws + WS_LC); bf16* Y = (bf16*)(a.ws + WS_Y);
    const int gw = blockIdx.x * 8 + wave, NGW = gridDim.x * 8;
    const int l31 = lane & 31, hh = lane >> 5;
    if (lane < 32) zer[lane] = 0.f;
    for (int item = gw; item < 2048; item += NGW) {
        if ((VAR & 16) && wave >= 4) continue;
        const int c = item & 15, dir = (item >> 4) & 1, h = (item >> 5) & 7, b = item >> 8;
        const int hc = h * 64 + lane;
        const float kkw = a.in[I_KK][l * 512 + hc], kaw = a.in[I_KA][l * 512 + hc];
        const float w0b = a.in[I_W0][(l * 2 + dir) * 512 + hc], a0b = a.in[I_A0][(l * 2 + dir) * 512 + hc];
        f32x16 C[2][2];
        if (c == 0) {
#pragma unroll
            for (int tr = 0; tr < 2; ++tr)
#pragma unroll
                for (int tc = 0; tc < 2; ++tc)
#pragma unroll
                    for (int i = 0; i < 16; ++i) C[tr][tc][i] = 0.f;
        } else {
#pragma unroll
            for (int tc = 0; tc < 2; ++tc) { const float* si = LC + ((size_t)(item - 1) * 64 + 32 * tc + l31) * 64 + 4 * hh;
#pragma unroll
                for (int tr = 0; tr < 2; ++tr)
#pragma unroll
                    for (int g = 0; g < 4; ++g) { const f32x4 x = *(const f32x4*)(si + 32 * tr + 8 * g); C[tr][tc][4 * g] = x.x; C[tr][tc][4 * g + 1] = x.y; C[tr][tc][4 * g + 2] = x.z; C[tr][tc][4 * g + 3] = x.w; } } }
        ScanRaw R; float gam = 1.0f;
        scan_load(a, l, b, h, dir, c * CHL, R, lane);
        int prow = 0;
        for (int s0 = c * CHL, grp = 0; s0 < (c + 1) * CHL; s0 += SG, ++grp) {
            const bool renorm = (grp & 3) == 3;
            LAS float* wg = wl + (grp & 1) * (SG * SVEC);
            __builtin_amdgcn_sched_barrier(0);
            scan_write(R, kkw, kaw, w0b, a0b, wg, lane, gam, renorm);
            if (s0 + SG < (c + 1) * CHL) scan_load(a, l, b, h, dir, s0 + SG, R, lane);
            __builtin_amdgcn_sched_barrier(0);
#pragma unroll 1
            for (int gi = 0; gi < SG; ++gi) {
                const LAS float* base = wg + gi * SVEC;
                const LAS float* pbase = gi > 0 ? base - SVEC : wl + ((grp & 1) ^ 1) * (SG * SVEC) + (SG - 1) * SVEC;
                const bool first = (grp == 0 && gi == 0);
                const LAS bf16* asrc = (l31 == 0) ? (first ? (const LAS bf16*)zer : (const LAS bf16*)(pbase + 192)) : (l31 == 1 ? (const LAS bf16*)(base + 192) + 64 : (const LAS bf16*)zer);
                const int astep = (l31 < 2 && !(l31 == 0 && first)) ? 16 : 0;
                bf16x8 afr[4];
#pragma unroll
                for (int f = 0; f < 4; ++f) afr[f] = *(const LAS bf16x8*)(asrc + (f * astep) + (l31 < 2 && !(l31 == 0 && first) ? hh * 8 : 0));
                float aop[2], vrr[2];
#pragma unroll
                for (int t = 0; t < 2; ++t) { aop[t] = base[64 + 32 * t + l31]; vrr[t] = base[320 + 32 * t + l31]; }
                __builtin_amdgcn_sched_barrier(0);
                f32x16 out[2];
#pragma unroll
                for (int tc = 0; tc < 2; ++tc) {
#pragma unroll
                    for (int i = 0; i < 16; ++i) out[tc][i] = 0.f;
#pragma unroll
                    for (int tr = 0; tr < 2; ++tr)
#pragma unroll
                        for (int sI = 0; sI < 2; ++sI) { u32x4 w; w.x = pk2(C[tr][tc][8 * sI + 0], C[tr][tc][8 * sI + 1]); w.y = pk2(C[tr][tc][8 * sI + 2], C[tr][tc][8 * sI + 3]);
                            w.z = pk2(C[tr][tc][8 * sI + 4], C[tr][tc][8 * sI + 5]); w.w = pk2(C[tr][tc][8 * sI + 6], C[tr][tc][8 * sI + 7]);
                            out[tc] = __builtin_amdgcn_mfma_f32_32x32x16_bf16(afr[tr * 2 + sI], __builtin_bit_cast(bf16x8, w), out[tc], 0, 0, 0); }
                }
                if (!first && lane < 32 && (VAR == 0 || out[0][0] == 12345.678f)) {
                    bf16* yp = Y + ((size_t)dir * NT + prow) * 512 + h * 64 + l31;
                    yp[0] = f2bf1(out[0][0]); yp[32] = f2bf1(out[1][0]); }
                const bf16x8 bop0 = mk_frag(hh ? 0u : pk2(vrr[0], -out[0][1])), bop1 = mk_frag(hh ? 0u : pk2(vrr[1], -out[1][1]));
                const bf16x8 af[2] = {mk_frag(hh ? 0u : __builtin_bit_cast(unsigned, aop[0])), mk_frag(hh ? 0u : __builtin_bit_cast(unsigned, aop[1]))};
                C[0][0] = __builtin_amdgcn_mfma_f32_32x32x16_bf16(af[0], bop0, C[0][0], 0, 0, 0);
                C[1][0] = __builtin_amdgcn_mfma_f32_32x32x16_bf16(af[1], bop0, C[1][0], 0, 0, 0);
                C[0][1] = __builtin_amdgcn_mfma_f32_32x32x16_bf16(af[0], bop1, C[0][1], 0, 0, 0);
                C[1][1] = __builtin_amdgcn_mfma_f32_32x32x16_bf16(af[1], bop1, C[1][1], 0, 0, 0);
                if (renorm && gi == SG - 1) {
                    const LAS f32x4* pv = (const LAS f32x4*)(base + 4 * hh);
#pragma unroll
                    for (int tr = 0; tr < 2; ++tr)
#pragma unroll
                        for (int g = 0; g < 4; ++g) { const f32x4 G = pv[8 * tr + 2 * g];
#pragma unroll
                            for (int tc = 0; tc < 2; ++tc)
#pragma unroll
                                for (int i = 0; i < 4; ++i) C[tr][tc][4 * g + i] *= G[i]; }
                }
                const int sx = s0 + gi, pos = dir == 0 ? sx : (sx < CTXL ? CTXL - 1 - sx : POSN + CTXL - 1 - sx);
                prow = row_of(b, pos);
            }
        }
        {
            const LAS float* pbase = wl + (((CHL / SG - 1) & 1)) * (SG * SVEC) + (SG - 1) * SVEC;
            const LAS bf16* asrc = (l31 == 0) ? (const LAS bf16*)(pbase + 192) : (const LAS bf16*)zer;
            bf16x8 afr[4];
#pragma unroll
            for (int f = 0; f < 4; ++f) afr[f] = *(const LAS bf16x8*)(asrc + (l31 == 0 ? f * 16 + hh * 8 : 0));
            f32x16 out[2];
#pragma unroll
            for (int tc = 0; tc < 2; ++tc) {
#pragma unroll
                for (int i = 0; i < 16; ++i) out[tc][i] = 0.f;
#pragma unroll
                for (int tr = 0; tr < 2; ++tr)
#pragma unroll
                    for (int sI = 0; sI < 2; ++sI) { u32x4 w; w.x = pk2(C[tr][tc][8 * sI + 0], C[tr][tc][8 * sI + 1]); w.y = pk2(C[tr][tc][8 * sI + 2], C[tr][tc][8 * sI + 3]);
                        w.z = pk2(C[tr][tc][8 * sI + 4], C[tr][tc][8 * sI + 5]); w.w = pk2(C[tr][tc][8 * sI + 6], C[tr][tc][8 * sI + 7]);
                        out[tc] = __builtin_amdgcn_mfma_f32_32x32x16_bf16(afr[tr * 2 + sI], __builtin_bit_cast(bf16x8, w), out[tc], 0, 0, 0); }
            }
            if (lane < 32 && (VAR == 0 || out[0][0] == 12345.678f)) { bf16* yp = Y + ((size_t)dir * NT + prow) * 512 + h * 64 + l31; yp[0] = f2bf1(out[0][0]); yp[32] = f2bf1(out[1][0]); }
        }
    }
}

constexpr int BT = 16, FRS = 72;
constexpr int B_FRK = 0, B_FRR = 2304, B_FRD = 4608, B_FRB = 6912;
constexpr int B_KMD = 9216, B_KMB = 11264;
constexpr int B_GT = 13312;
constexpr int B_GAM = 17408;
constexpr int B_WLDS = 17664;

template <int T0> __device__ __forceinline__ void blk_stage(const ScanRaw& R, float kkw, float kaw, float w0b, float a0b, LAS unsigned char* wb, int lane, int fo, float& gam, float (&V)[BT], unsigned (&kc)[4]) {
    unsigned lowk[SG], lowb[SG];
    const float w0n = -1.4426950408889634f * w0b, a0n = -1.4426950408889634f * a0b, omk = 1.0f - kaw;
#pragma unroll
    for (int gi = 0; gi < SG; ++gi) {
        constexpr int dummy = 0; (void)dummy;
        const int t = T0 + gi;
        const float kxf = bf2f(R.kx[gi]);
        const float wv = __builtin_amdgcn_exp2f(-0.8750387753291099f * sigmoid_nb(bf2f(R.wx[gi]), w0n)), av = sigmoid_nb(bf2f(R.ax[gi]), a0n);
        const float kk = kxf * kkw * R.rn[gi];
        const float kd = kxf * __builtin_fmaf(kaw, av, omk), bb = kk * av;
        const float kks = kk * gam;
        gam *= wv;
        const float ig = __builtin_amdgcn_rcpf(gam);
        const unsigned pkb = pk2(kd * ig, bb * ig), prk = pk2(bf2f(R.rx[gi]) * gam, kks);
        ((LAS bf16*)(wb + B_FRD))[t * FRS + fo] = (bf16)(pkb & 0xffffu); ((LAS bf16*)(wb + B_FRB))[t * FRS + fo] = (bf16)(pkb >> 16);
        ((LAS bf16*)(wb + B_FRR))[t * FRS + fo] = (bf16)(prk & 0xffffu); ((LAS bf16*)(wb + B_FRK))[t * FRS + fo] = (bf16)(prk >> 16);
        lowk[gi] = pkb & 0xffffu; lowb[gi] = pkb >> 16;
        V[t] = bf2f(R.vx[gi]);
        if (t == BT - 1) { ((LAS float*)(wb + B_GAM))[lane] = gam; gam = 1.0f; }
    }
    const unsigned k0 = lowk[0] | (lowk[1] << 16), k1 = lowk[2] | (lowk[3] << 16), b0 = lowb[0] | (lowb[1] << 16), b1 = lowb[2] | (lowb[3] << 16);
    if ((T0 & 4) == 0) { kc[0] = k0; kc[1] = k1; kc[2] = b0; kc[3] = b1; }
    else { *(LAS u32x4*)(wb + B_KMD + ((T0 >> 3) * 64 + lane) * 16) = (u32x4){kc[0], kc[1], k0, k1}; *(LAS u32x4*)(wb + B_KMB + ((T0 >> 3) * 64 + lane) * 16) = (u32x4){kc[2], kc[3], b0, b1}; }
}
__device__ __forceinline__ void blk_stepA(const f32x16 (&C)[2][2], LAS unsigned char* wb, int l31, int hh, f32x16 (&out)[2]) {
    const LAS bf16* arow = (const LAS bf16*)(wb + (l31 < 16 ? B_FRR : B_FRK)) + (l31 & 15) * FRS + hh * 8;
    bf16x8 afr[4];
#pragma unroll
    for (int f = 0; f < 4; ++f) afr[f] = *(const LAS bf16x8*)(arow + f * 16);
#pragma unroll
    for (int tc = 0; tc < 2; ++tc) {
#pragma unroll
        for (int i = 0; i < 16; ++i) out[tc][i] = 0.f;
#pragma unroll
        for (int tr = 0; tr < 2; ++tr)
#pragma unroll
            for (int sI = 0; sI < 2; ++sI) { u32x4 w; w.x = pk2(C[tr][tc][8 * sI + 0], C[tr][tc][8 * sI + 1]); w.y = pk2(C[tr][tc][8 * sI + 2], C[tr][tc][8 * sI + 3]);
                w.z = pk2(C[tr][tc][8 * sI + 4], C[tr][tc][8 * sI + 5]); w.w = pk2(C[tr][tc][8 * sI + 6], C[tr][tc][8 * sI + 7]);
                out[tc] = __builtin_amdgcn_mfma_f32_32x32x16_bf16(afr[tr * 2 + sI], __builtin_bit_cast(bf16x8, w), out[tc], 0, 0, 0); }
    }
}
__device__ __forceinline__ void blk_stepB(LAS unsigned char* wb, int l31, int hh) {
    const LAS bf16* arow = (const LAS bf16*)(wb + (l31 < 16 ? B_FRD : B_FRB)) + (l31 & 15) * FRS + hh * 8;
    const LAS bf16* brow = (const LAS bf16*)(wb + (l31 < 16 ? B_FRK : B_FRR)) + (l31 & 15) * FRS + hh * 8;
    f32x16 g;
#pragma unroll
    for (int i = 0; i < 16; ++i) g[i] = 0.f;
#pragma unroll
    for (int f = 0; f < 4; ++f) g = __builtin_amdgcn_mfma_f32_32x32x16_bf16(*(const LAS bf16x8*)(arow + f * 16), *(const LAS bf16x8*)(brow + f * 16), g, 0, 0, 0);
    LAS float* gt = (LAS float*)(wb + B_GT) + l31 * 32 + 4 * hh;
#pragma unroll
    for (int q = 0; q < 4; ++q) *(LAS f32x4*)(gt + 8 * q) = (f32x4){g[4 * q], g[4 * q + 1], g[4 * q + 2], g[4 * q + 3]};
}
__device__ __forceinline__ void blk_gather(const f32x16 (&out)[2], int rbase  , float (&X)[BT]) {
#pragma unroll
    for (int q = 0; q < 2; ++q)
#pragma unroll
        for (int i = 0; i < 4; ++i) { float ra, rb; swap32(out[0][rbase + 4 * q + i], out[1][rbase + 4 * q + i], ra, rb); X[8 * q + i] = ra; X[8 * q + 4 + i] = rb; }
}
__device__ __forceinline__ void blk_bfrag(const float (&X)[BT], float sgn, bf16x8& b0, bf16x8& b1) {
    u32x4 lo, hi, r0, r1;
    lo.x = pk2(sgn * X[0], sgn * X[1]); lo.y = pk2(sgn * X[2], sgn * X[3]); lo.z = pk2(sgn * X[4], sgn * X[5]); lo.w = pk2(sgn * X[6], sgn * X[7]);
    hi.x = pk2(sgn * X[8], sgn * X[9]); hi.y = pk2(sgn * X[10], sgn * X[11]); hi.z = pk2(sgn * X[12], sgn * X[13]); hi.w = pk2(sgn * X[14], sgn * X[15]);
#pragma unroll
    for (int d = 0; d < 4; ++d) { const unsigned ul = lo[d], uh = hi[d];
        float ra, rb; swap32(__builtin_bit_cast(float, ul), __builtin_bit_cast(float, uh), ra, rb); r0[d] = __builtin_bit_cast(unsigned, ra); r1[d] = __builtin_bit_cast(unsigned, rb); }
    b0 = __builtin_bit_cast(bf16x8, r0); b1 = __builtin_bit_cast(bf16x8, r1);
}

__device__ __forceinline__ void ph_scan3b(const Args& a, int l, LAS unsigned char* lds, int lane, int wave) {
    LAS unsigned char* wb = lds + wave * B_WLDS;
    const float* LC = (const float*)(a.ws + WS_LC); bf16* Y = (bf16*)(a.ws + WS_Y);
    const int gw = blockIdx.x * 8 + wave, NGW = gridDim.x * 8;
    const int l31 = lane & 31, hh = lane >> 5;
    const int fo = ((((lane >> 5) * 2 + ((lane >> 4) & 1)) * 2 + ((lane >> 2) & 1)) * 8) + 4 * ((lane >> 3) & 1) + (lane & 3);
    for (int item = gw; item < 2048; item += NGW) {
        const int c = item & 15, dir = (item >> 4) & 1, h = (item >> 5) & 7, b = item >> 8;
        const int hc = h * 64 + lane;
        const float kkw = a.in[I_KK][l * 512 + hc], kaw = a.in[I_KA][l * 512 + hc];
        const float w0b = a.in[I_W0][(l * 2 + dir) * 512 + hc], a0b = a.in[I_A0][(l * 2 + dir) * 512 + hc];
        f32x16 C[2][2];
        if (c == 0) {
#pragma unroll
            for (int tr = 0; tr < 2; ++tr)
#pragma unroll
                for (int tc = 0; tc < 2; ++tc)
#pragma unroll
                    for (int i = 0; i < 16; ++i) C[tr][tc][i] = 0.f;
        } else {
#pragma unroll
            for (int tc = 0; tc < 2; ++tc) { const float* si = LC + ((size_t)(item - 1) * 64 + 32 * tc + l31) * 64 + 4 * hh;
#pragma unroll
                for (int tr = 0; tr < 2; ++tr)
#pragma unroll
                    for (int g = 0; g < 4; ++g) { const f32x4 x = *(const f32x4*)(si + 32 * tr + 8 * g); C[tr][tc][4 * g] = x.x; C[tr][tc][4 * g + 1] = x.y; C[tr][tc][4 * g + 2] = x.z; C[tr][tc][4 * g + 3] = x.w; } } }
        ScanRaw R0, R1; float gam = 1.0f;
        scan_load(a, l, b, h, dir, c * CHL, R0, lane);
        scan_load(a, l, b, h, dir, c * CHL + SG, R1, lane);
#pragma unroll 1
        for (int blk = 0; blk < CHL / BT; ++blk) {
            const int s0 = c * CHL + blk * BT; const bool more = blk + 1 < CHL / BT;
            float V[BT]; unsigned kc[4];
            __builtin_amdgcn_sched_barrier(0);
            blk_stage<0>(R0, kkw, kaw, w0b, a0b, wb, lane, fo, gam, V, kc);  scan_load(a, l, b, h, dir, s0 + 2 * SG, R0, lane);
            __builtin_amdgcn_sched_barrier(0);
            blk_stage<4>(R1, kkw, kaw, w0b, a0b, wb, lane, fo, gam, V, kc);  scan_load(a, l, b, h, dir, s0 + 3 * SG, R1, lane);
            __builtin_amdgcn_sched_barrier(0);
            blk_stage<8>(R0, kkw, kaw, w0b, a0b, wb, lane, fo, gam, V, kc);  if (more) scan_load(a, l, b, h, dir, s0 + 4 * SG, R0, lane);
            __builtin_amdgcn_sched_barrier(0);
            blk_stage<12>(R1, kkw, kaw, w0b, a0b, wb, lane, fo, gam, V, kc); if (more) scan_load(a, l, b, h, dir, s0 + 5 * SG, R1, lane);
            __builtin_amdgcn_sched_barrier(0);
            f32x16 out[2];
            blk_stepB(wb, l31, hh);
            blk_stepA(C, wb, l31, hh, out);
            const LAS float* GT = (const LAS float*)(wb + B_GT);
            bf16x8 bv0, bv1, bd0, bd1, a2, a3;
            blk_bfrag(V, 1.0f, bv0, bv1);
            { const LAS float* gp = GT + (l31 ^ 16) * 32 + 8 * hh;
              const int thr = (l31 < 16 ? l31 + 1 : l31 - 16) - 8 * hh, thr3 = (l31 < 16 ? l31 + 1 : 0) - 8 * hh;
              const f32x4 x0 = *(const LAS f32x4*)gp, x1 = *(const LAS f32x4*)(gp + 4), y0 = *(const LAS f32x4*)(gp + 16), y1 = *(const LAS f32x4*)(gp + 20);
              u32x4 w2, w3;
              w2.x = pk2(0 < thr ? x0.x : 0.f, 1 < thr ? x0.y : 0.f); w2.y = pk2(2 < thr ? x0.z : 0.f, 3 < thr ? x0.w : 0.f);
              w2.z = pk2(4 < thr ? x1.x : 0.f, 5 < thr ? x1.y : 0.f); w2.w = pk2(6 < thr ? x1.z : 0.f, 7 < thr ? x1.w : 0.f);
              w3.x = pk2(0 < thr3 ? y0.x : 0.f, 1 < thr3 ? y0.y : 0.f); w3.y = pk2(2 < thr3 ? y0.z : 0.f, 3 < thr3 ? y0.w : 0.f);
              w3.z = pk2(4 < thr3 ? y1.x : 0.f, 5 < thr3 ? y1.y : 0.f); w3.w = pk2(6 < thr3 ? y1.z : 0.f, 7 < thr3 ? y1.w : 0.f);
              a2 = __builtin_bit_cast(bf16x8, w2); a3 = __builtin_bit_cast(bf16x8, w3); }
            out[0] = __builtin_amdgcn_mfma_f32_32x32x16_bf16(a2, bv0, out[0], 0, 0, 0);
            out[1] = __builtin_amdgcn_mfma_f32_32x32x16_bf16(a2, bv1, out[1], 0, 0, 0);
            float D[BT];
            blk_gather(out, 8, D);
#pragma unroll
            for (int t = 1; t < BT; ++t) {
                float acc = D[t];
                f32x4 g2[4];
#pragma unroll
                for (int q = 0; q < 4; ++q) if (4 * q < t) g2[q] = *(const LAS f32x4*)(GT + t * 32 + 16 + 4 * q);
#pragma unroll
                for (int s = 0; s < t; ++s) acc = __builtin_fmaf(-D[s], g2[s >> 2][s & 3], acc);
                D[t] = acc;
            }
            blk_bfrag(D, -1.0f, bd0, bd1);
            out[0] = __builtin_amdgcn_mfma_f32_32x32x16_bf16(a3, bd0, out[0], 0, 0, 0);
            out[1] = __builtin_amdgcn_mfma_f32_32x32x16_bf16(a3, bd1, out[1], 0, 0, 0);
#pragma unroll
            for (int rr = 0; rr < 8; ++rr) {
                const int tb = (rr & 3) + 8 * (rr >> 2);
                const int sa = s0 + tb, sb = sa + 4;
                const int posa = dir == 0 ? sa : (sa < CTXL ? CTXL - 1 - sa : POSN + CTXL - 1 - sa), posb = dir == 0 ? sb : (sb < CTXL ? CTXL - 1 - sb : POSN + CTXL - 1 - sb);
                const int row = hh ? row_of(b, posb) : row_of(b, posa);
                bf16* yp = Y + ((size_t)dir * NT + row) * 512 + h * 64 + l31;
                yp[0] = f2bf1(out[0][rr]); yp[32] = f2bf1(out[1][rr]);
            }
#pragma unroll
            for (int tr = 0; tr < 2; ++tr) {
                const bf16x8 ad = *(const LAS bf16x8*)(wb + B_KMD + (hh * 64 + 32 * tr + l31) * 16), ab = *(const LAS bf16x8*)(wb + B_KMB + (hh * 64 + 32 * tr + l31) * 16);
                C[tr][0] = __builtin_amdgcn_mfma_f32_32x32x16_bf16(ad, bv0, C[tr][0], 0, 0, 0); C[tr][0] = __builtin_amdgcn_mfma_f32_32x32x16_bf16(ab, bd0, C[tr][0], 0, 0, 0);
                C[tr][1] = __builtin_amdgcn_mfma_f32_32x32x16_bf16(ad, bv1, C[tr][1], 0, 0, 0); C[tr][1] = __builtin_amdgcn_mfma_f32_32x32x16_bf16(ab, bd1, C[tr][1], 0, 0, 0);
            }
            { const LAS f32x4* pg = (const LAS f32x4*)((const LAS float*)(wb + B_GAM) + 4 * hh);
#pragma unroll
              for (int tr = 0; tr < 2; ++tr)
#pragma unroll
                for (int g = 0; g < 4; ++g) { const f32x4 G = pg[8 * tr + 2 * g];
#pragma unroll
                    for (int tc = 0; tc < 2; ++tc)
#pragma unroll
                        for (int i = 0; i < 4; ++i) C[tr][tc][4 * g + i] *= G[i]; } }
        }
    }
}

struct ScanRaw1 { unsigned ka[SG], wv[SG]; float rn[SG]; };
__device__ __forceinline__ void scan_load1(const Args& a, int l, int b, int h, int dir, int s0, ScanRaw1& R, int lane) {
    const bf16* Kb = (const bf16*)(a.ws + WS_K); const bf16* Vb = (const bf16*)(a.ws + (l == 0 ? WS_V0 : WS_V1));
    const bf16* LW = (const bf16*)(a.ws + WS_P); const float* KN = (const float*)(a.ws + WS_KN);
    const int hc = h * 64 + lane;
#pragma unroll
    for (int gi = 0; gi < SG; ++gi) {
        const int s = s0 + gi, pos = dir == 0 ? s : (s < CTXL ? CTXL - 1 - s : POSN + CTXL - 1 - s), row = row_of(b, pos);
        const unsigned o5 = (unsigned)(row * 512 + hc), ol = (unsigned)(row * LWC + dir * 512 + hc);
        R.ka[gi] = (unsigned)Kb[o5] | ((unsigned)LW[ol + 1024u] << 16); R.wv[gi] = (unsigned)LW[ol] | ((unsigned)Vb[o5] << 16); R.rn[gi] = KN[row * 8 + h];
    }
}
template <int T0> __device__ __forceinline__ void blk_stage1(const ScanRaw1& R, float kkw, float kaw, float w0b, float a0b, LAS unsigned char* wb, int lane, int fo, float& gam, unsigned (&kc)[6]) {
    unsigned lowk[SG], lowb[SG];
    const float w0n = -1.4426950408889634f * w0b, a0n = -1.4426950408889634f * a0b, omk = 1.0f - kaw;
#pragma unroll
    for (int gi = 0; gi < SG; ++gi) {
        const int t = T0 + gi;
        const float kxf = bflo(R.ka[gi]);
        const float wv = __builtin_amdgcn_exp2f(-0.8750387753291099f * sigmoid_nb(bflo(R.wv[gi]), w0n)), av = sigmoid_nb(bfhi(R.ka[gi]), a0n);
        const float kk = kxf * kkw * R.rn[gi];
        const float kd = kxf * __builtin_fmaf(kaw, av, omk), bb = kk * av;
        const float kks = kk * gam;
        gam *= wv;
        const float ig = __builtin_amdgcn_rcpf(gam);
        const unsigned pkb = pk2(kd * ig, bb * ig);
        ((LAS bf16*)(wb + B_FRD))[t * FRS + fo] = (bf16)(pkb & 0xffffu); ((LAS bf16*)(wb + B_FRB))[t * FRS + fo] = (bf16)(pkb >> 16);
        ((LAS bf16*)(wb + B_FRK))[t * FRS + fo] = f2bf1(kks);
        lowk[gi] = pkb & 0xffffu; lowb[gi] = pkb >> 16;
        if (t == BT - 1) { ((LAS float*)(wb + B_GAM))[lane] = gam; gam = 1.0f; }
    }
    const unsigned k0 = lowk[0] | (lowk[1] << 16), k1 = lowk[2] | (lowk[3] << 16), b0 = lowb[0] | (lowb[1] << 16), b1 = lowb[2] | (lowb[3] << 16);
    const unsigned v0 = (R.wv[0] >> 16) | (R.wv[1] & 0xffff0000u), v1 = (R.wv[2] >> 16) | (R.wv[3] & 0xffff0000u);
    if ((T0 & 4) == 0) { kc[0] = k0; kc[1] = k1; kc[2] = b0; kc[3] = b1; kc[4] = v0; kc[5] = v1; }
    else { *(LAS u32x4*)(wb + B_KMD + ((T0 >> 3) * 64 + lane) * 16) = (u32x4){kc[0], kc[1], k0, k1}; *(LAS u32x4*)(wb + B_KMB + ((T0 >> 3) * 64 + lane) * 16) = (u32x4){kc[2], kc[3], b0, b1};
           *(LAS u32x4*)(wb + B_FRR + ((T0 >> 3) * 64 + lane) * 16) = (u32x4){kc[4], kc[5], v0, v1}; }
}
__device__ __forceinline__ void blk_d0(const f32x16 (&C)[2][2], LAS unsigned char* wb, int l31, int hh, float (&X)[BT]) {
    f32x16 out[2];
    blk_stepA(C, wb, l31, hh, out);
    blk_gather(out, 8, X);
}
__device__ __forceinline__ void blk_bfrag_lds(const LAS unsigned char* rowp, bf16x8& b0, bf16x8& b1) {
    const u32x4 lo = *(const LAS u32x4*)rowp, hi = *(const LAS u32x4*)(rowp + 1024); u32x4 r0, r1;
#pragma unroll
    for (int d = 0; d < 4; ++d) { const unsigned ul = lo[d], uh = hi[d]; float ra, rb; swap32(__builtin_bit_cast(float, ul), __builtin_bit_cast(float, uh), ra, rb); r0[d] = __builtin_bit_cast(unsigned, ra); r1[d] = __builtin_bit_cast(unsigned, rb); }
    b0 = __builtin_bit_cast(bf16x8, r0); b1 = __builtin_bit_cast(bf16x8, r1);
}
__device__ __forceinline__ void ph_scan1b(const Args& a, int l, LAS unsigned char* lds, int lane, int wave) {
    LAS unsigned char* wb = lds + wave * B_WLDS;
    float* PC = (float*)(a.ws + WS_PC); float* LC = (float*)(a.ws + WS_LC);
    const int gw = blockIdx.x * 8 + wave, NGW = gridDim.x * 8;
    const int l31 = lane & 31, hh = lane >> 5;
    const int fo = ((((lane >> 5) * 2 + ((lane >> 4) & 1)) * 2 + ((lane >> 2) & 1)) * 8) + 4 * ((lane >> 3) & 1) + (lane & 3);
    for (int item = gw; item < 2048; item += NGW) {
        const int c = item & 15, dir = (item >> 4) & 1, h = (item >> 5) & 7, b = item >> 8;
        if (c == NCH - 1) continue;
        const int hc = h * 64 + lane;
        const float kkw = a.in[I_KK][l * 512 + hc], kaw = a.in[I_KA][l * 512 + hc];
        const float w0b = a.in[I_W0][(l * 2 + dir) * 512 + hc], a0b = a.in[I_A0][(l * 2 + dir) * 512 + hc];
        f32x16 CP[2][2], CL[2][2];
        { int ln = lane; asm volatile("" : "+v"(ln));
          const int dg = (ln & 31) - 4 * (ln >> 5);
#pragma unroll
          for (int tr = 0; tr < 2; ++tr)
#pragma unroll
            for (int tc = 0; tc < 2; ++tc)
#pragma unroll
                for (int r = 0; r < 16; ++r) { CP[tr][tc][r] = (tr == tc && dg == (r & 3) + 8 * (r >> 2)) ? 1.0f : 0.0f; CL[tr][tc][r] = 0.f; } }
        ScanRaw1 R0, R1; float gam = 1.0f;
        scan_load1(a, l, b, h, dir, c * CHL, R0, lane);
        scan_load1(a, l, b, h, dir, c * CHL + SG, R1, lane);
#pragma unroll 1
        for (int blk = 0; blk < CHL / BT; ++blk) {
            const int s0 = c * CHL + blk * BT; const bool more = blk + 1 < CHL / BT;
            unsigned kc[6];
            __builtin_amdgcn_sched_barrier(0);
            blk_stage1<0>(R0, kkw, kaw, w0b, a0b, wb, lane, fo, gam, kc);  scan_load1(a, l, b, h, dir, s0 + 2 * SG, R0, lane);
            __builtin_amdgcn_sched_barrier(0);
            blk_stage1<4>(R1, kkw, kaw, w0b, a0b, wb, lane, fo, gam, kc);  scan_load1(a, l, b, h, dir, s0 + 3 * SG, R1, lane);
            __builtin_amdgcn_sched_barrier(0);
            blk_stage1<8>(R0, kkw, kaw, w0b, a0b, wb, lane, fo, gam, kc);
            __builtin_amdgcn_sched_barrier(0);
            blk_stage1<12>(R1, kkw, kaw, w0b, a0b, wb, lane, fo, gam, kc);
            __builtin_amdgcn_sched_barrier(0);
            blk_stepB(wb, l31, hh);
            const LAS unsigned char* vrow = wb + B_FRR + lane * 16;
            const LAS float* GT = (const LAS float*)(wb + B_GT);
            bf16x8 bl0, bl1, bp0, bp1;
            {
                float DL[BT];
                { f32x16 out[2];
                  blk_stepA(CL, wb, l31, hh, out);
                  bf16x8 bv0, bv1, a2;
                  blk_bfrag_lds(vrow, bv0, bv1);
                  { const LAS float* gp = GT + (l31 & 15) * 32 + 8 * hh;
                    const int thr = (l31 >= 16 ? l31 - 16 : 0) - 8 * hh;
                    const f32x4 x0 = *(const LAS f32x4*)gp, x1 = *(const LAS f32x4*)(gp + 4);
                    u32x4 w2;
                    w2.x = pk2(0 < thr ? x0.x : 0.f, 1 < thr ? x0.y : 0.f); w2.y = pk2(2 < thr ? x0.z : 0.f, 3 < thr ? x0.w : 0.f);
                    w2.z = pk2(4 < thr ? x1.x : 0.f, 5 < thr ? x1.y : 0.f); w2.w = pk2(6 < thr ? x1.z : 0.f, 7 < thr ? x1.w : 0.f);
                    a2 = __builtin_bit_cast(bf16x8, w2); }
                  out[0] = __builtin_amdgcn_mfma_f32_32x32x16_bf16(a2, bv0, out[0], 0, 0, 0);
                  out[1] = __builtin_amdgcn_mfma_f32_32x32x16_bf16(a2, bv1, out[1], 0, 0, 0);
                  blk_gather(out, 8, DL); }
#pragma unroll
                for (int t = 1; t < BT; ++t) {
                    float accl = DL[t];
#pragma unroll
                    for (int q = 0; q < 4; ++q) if (4 * q < t) { const f32x4 g2 = *(const LAS f32x4*)(GT + t * 32 + 16 + 4 * q);
#pragma unroll
                        for (int i = 0; i < 4; ++i) if (4 * q + i < t) accl = __builtin_fmaf(-DL[4 * q + i], g2[i], accl); }
                    DL[t] = accl;
                }
                blk_bfrag(DL, -1.0f, bl0, bl1);
            }
            __builtin_amdgcn_sched_barrier(0);
            {   float DP[BT];
                blk_d0(CP, wb, l31, hh, DP);
#pragma unroll
                for (int t = 1; t < BT; ++t) {
                    float accp = DP[t];
#pragma unroll
                    for (int q = 0; q < 4; ++q) if (4 * q < t) { const f32x4 g2 = *(const LAS f32x4*)(GT + t * 32 + 16 + 4 * q);
#pragma unroll
                        for (int i = 0; i < 4; ++i) if (4 * q + i < t) accp = __builtin_fmaf(-DP[4 * q + i], g2[i], accp); }
                    DP[t] = accp;
                }
                blk_bfrag(DP, -1.0f, bp0, bp1);
            }
            __builtin_amdgcn_sched_barrier(0);
            if (more) { scan_load1(a, l, b, h, dir, s0 + 4 * SG, R0, lane); scan_load1(a, l, b, h, dir, s0 + 5 * SG, R1, lane); }
            __builtin_amdgcn_sched_barrier(0);
            bf16x8 bv0, bv1;
            blk_bfrag_lds(vrow, bv0, bv1);
#pragma unroll
            for (int tr = 0; tr < 2; ++tr) {
                const bf16x8 ad = *(const LAS bf16x8*)(wb + B_KMD + (hh * 64 + 32 * tr + l31) * 16), ab = *(const LAS bf16x8*)(wb + B_KMB + (hh * 64 + 32 * tr + l31) * 16);
                CL[tr][0] = __builtin_amdgcn_mfma_f32_32x32x16_bf16(ad, bv0, CL[tr][0], 0, 0, 0); CL[tr][0] = __builtin_amdgcn_mfma_f32_32x32x16_bf16(ab, bl0, CL[tr][0], 0, 0, 0);
                CL[tr][1] = __builtin_amdgcn_mfma_f32_32x32x16_bf16(ad, bv1, CL[tr][1], 0, 0, 0); CL[tr][1] = __builtin_amdgcn_mfma_f32_32x32x16_bf16(ab, bl1, CL[tr][1], 0, 0, 0);
                CP[tr][0] = __builtin_amdgcn_mfma_f32_32x32x16_bf16(ab, bp0, CP[tr][0], 0, 0, 0); CP[tr][1] = __builtin_amdgcn_mfma_f32_32x32x16_bf16(ab, bp1, CP[tr][1], 0, 0, 0);
            }
            { const LAS f32x4* pg = (const LAS f32x4*)((const LAS float*)(wb + B_GAM) + 4 * hh);
#pragma unroll
              for (int tr = 0; tr < 2; ++tr)
#pragma unroll
                for (int g = 0; g < 4; ++g) { const f32x4 G = pg[8 * tr + 2 * g];
#pragma unroll
                    for (int tc = 0; tc < 2; ++tc)
#pragma unroll
                        for (int i = 0; i < 4; ++i) { CL[tr][tc][4 * g + i] *= G[i]; CP[tr][tc][4 * g + i] *= G[i]; } } }
        }
        int item_o = item; asm volatile("" : "+s"(item_o));
#pragma unroll
        for (int tc = 0; tc < 2; ++tc) { float* po = PC + ((size_t)item_o * 64 + 32 * tc + l31) * 64 + 4 * hh; float* lo = LC + ((size_t)item_o * 64 + 32 * tc + l31) * 64 + 4 * hh;
#pragma unroll
            for (int tr = 0; tr < 2; ++tr)
#pragma unroll
                for (int g = 0; g < 4; ++g) { *(f32x4*)(po + 32 * tr + 8 * g) = (f32x4){CP[tr][tc][4 * g], CP[tr][tc][4 * g + 1], CP[tr][tc][4 * g + 2], CP[tr][tc][4 * g + 3]};
                    *(f32x4*)(lo + 32 * tr + 8 * g) = (f32x4){CL[tr][tc][4 * g], CL[tr][tc][4 * g + 1], CL[tr][tc][4 * g + 2], CL[tr][tc][4 * g + 3]}; } }
    }
}

__device__ __forceinline__ void ph_readout(const Args& a, int l, int lane, int wave) {
    const int gw = blockIdx.x * 8 + wave, NGW = gridDim.x * 8;
    unsigned char* ws = a.ws;
    const bf16* Y = (const bf16*)(ws + WS_Y); const bf16* Rb = (const bf16*)(ws + WS_R); const bf16* Kb = (const bf16*)(ws + WS_K); const bf16* Vb = (const bf16*)(ws + (l == 0 ? WS_V0 : WS_V1));
    const bf16* LW = (const bf16*)(ws + WS_P); bf16* H = (bf16*)(ws + WS_H);
    const int c0 = lane * 8;
    float ka[8], rk[8], lw[8], lb[8], ab0[8], ab1[8];
    { const float* p0 = a.in[I_KA] + l * 512 + c0; const float* p1 = a.in[I_RK] + l * 512 + c0; const float* p2 = a.in[I_LNW] + l * 512 + c0; const float* p3 = a.in[I_LNB] + l * 512 + c0;
      const float* p4 = a.in[I_A0] + l * 1024 + c0;
#pragma unroll
      for (int i = 0; i < 8; ++i) { ka[i] = p0[i]; rk[i] = p1[i]; lw[i] = p2[i]; lb[i] = p3[i]; ab0[i] = p4[i]; ab1[i] = p4[512 + i]; } }
    const int nrows = (l == 1) ? NTL : NT;
    for (int row = gw; row < nrows; row += NGW) {
        float y0[8], y1[8], r[8], k[8], v[8], a0[8], a1[8], g[8];
        unpack8(*(const u32x4*)(Y + (size_t)row * 512 + c0), y0); unpack8(*(const u32x4*)(Y + ((size_t)NT + row) * 512 + c0), y1);
        unpack8(*(const u32x4*)(Rb + (size_t)row * 512 + c0), r); unpack8(*(const u32x4*)(Kb + (size_t)row * 512 + c0), k); unpack8(*(const u32x4*)(Vb + (size_t)row * 512 + c0), v);
        unpack8(*(const u32x4*)(LW + (size_t)row * LWC + 1024 + c0), a0); unpack8(*(const u32x4*)(LW + (size_t)row * LWC + 1536 + c0), a1); unpack8(*(const u32x4*)(LW + (size_t)row * LWC + 2048 + c0), g);
        float s = 0.f, bs = 0.f;
#pragma unroll
        for (int i = 0; i < 8; ++i) { a0[i] = sigmoidf_(a0[i] + ab0[i]); a1[i] = sigmoidf_(a1[i] + ab1[i]); }
#pragma unroll
        for (int i = 0; i < 8; ++i) { y0[i] += y1[i]; s += y0[i];
            const float kd0 = k[i] * (1.0f + (a0[i] - 1.0f) * ka[i]), kd1 = k[i] * (1.0f + (a1[i] - 1.0f) * ka[i]); bs += r[i] * (kd0 + kd1) * rk[i]; }
        s = sum8_(s);
        bs = sum8_(bs);
        const float mu = s * (1.0f / 64.0f); float q = 0.f;
#pragma unroll
        for (int i = 0; i < 8; ++i) { const float d = y0[i] - mu; q += d * d; }
        q = sum8_(q);
        const float rstd = rsqrtf(q * (1.0f / 64.0f) + 64e-5f);
        float o[8];
#pragma unroll
        for (int i = 0; i < 8; ++i) o[i] = ((y0[i] - mu) * rstd * lw[i] + lb[i] + bs * v[i]) * g[i];
        *(u32x4*)(H + (size_t)row * DM + 512 + c0) = pack8(o);
    }
}

template <int VAR> __device__ __forceinline__ void ph_norm2_router(const Args& a, int l, LAS unsigned char* lds, int tid, int lane, int wave) {
    const int gw = blockIdx.x * 8 + wave, NGW = gridDim.x * 8;
    unsigned char* ws = a.ws;
    const float* XC = (const float*)(ws + WS_XC);
    const int nrows = (l == 1) ? NTL : NT;
    f32x4 nv0[4], nv1[4];
#define RT_LOAD(pr_) do { const int row_ = 2 * (pr_); const float* src_ = row_ < NTL ? a.out + (size_t)row_ * DM : XC + (size_t)(row_ - NTL) * DM; \
        _Pragma("unroll") for (int j = 0; j < 4; ++j) { nv0[j] = *(const f32x4*)(src_ + 4 * (lane + 64 * j)); nv1[j] = *(const f32x4*)(src_ + DM + 4 * (lane + 64 * j)); } } while (0)
    if (2 * gw < nrows) RT_LOAD(gw);
    LAS float* rwl = (LAS float*)lds;
    for (int i = tid; i < 16384; i += 512) rwl[(i & 15) * 1024 + (i >> 4)] = a.in[I_RW][i];
    LAS int* wcnt = (LAS int*)(lds + 65536);
    LAS int* woff = wcnt + 128;
    if (tid < 128) wcnt[tid] = 0;
    __syncthreads();
    const float* modv = (const float*)(ws + WS_MODV) + (size_t)l * 9 * 6144; bf16* H = (bf16*)(ws + WS_H);
    unsigned* cnt = (unsigned*)(ws + WS_CTL) + CW_CNT + 64 * l; int* route = (int*)(ws + WS_ROUTE);
    const int lq = lane >> 4, eb = 8 * (lq & 1), rsel = lq >> 1;
    float rb[8];
#pragma unroll
    for (int e = 0; e < 8; ++e) rb[e] = a.in[I_RB][eb + e];
    for (int pr = gw; 2 * pr < nrows; pr += NGW) {
        const int row = 2 * pr;
        const int mr = row < NTL ? (row >> 12) : 8;
        f32x4 v0[4], v1[4], h0[4], h1[4];
#pragma unroll
        for (int j = 0; j < 4; ++j) { v0[j] = nv0[j]; v1[j] = nv1[j]; }
        if (2 * (pr + NGW) < nrows) RT_LOAD(pr + NGW);
        {
            float ss0 = 0.f, ss1 = 0.f;
#pragma unroll
            for (int j = 0; j < 4; ++j) { ss0 += (v0[j].x * v0[j].x + v0[j].y * v0[j].y) + (v0[j].z * v0[j].z + v0[j].w * v0[j].w); ss1 += (v1[j].x * v1[j].x + v1[j].y * v1[j].y) + (v1[j].z * v1[j].z + v1[j].w * v1[j].w); }
            float ra, rbb; swap32(ss0, ss1, ra, rbb); float sq = ra + rbb;
            { float t0, t1; swap16(sq, sq, t0, t1); sq = t0 + t1; }
            sq = dpp_add_(sq, 0); sq = dpp_add_(sq, 1); sq = dpp_add_(sq, 2); sq = dpp_add_(sq, 3);
            const float tot0 = __builtin_bit_cast(float, __builtin_amdgcn_readlane(__builtin_bit_cast(int, sq), 0)), tot1 = __builtin_bit_cast(float, __builtin_amdgcn_readlane(__builtin_bit_cast(int, sq), 32));
            const float rms0 = rsqrtf(tot0 * (1.0f / DM) + 1e-6f), rms1 = rsqrtf(tot1 * (1.0f / DM) + 1e-6f);
            const float* g = a.in[I_NFFN] + l * DM; const float* sc = modv + (size_t)mr * 6144 + 4096; const float* sh = modv + (size_t)mr * 6144 + 3072;
            bf16* o0 = H + (size_t)row * DM;
#pragma unroll
            for (int j = 0; j < 4; ++j) { const int c = 4 * (lane + 64 * j);
                const f32x4 gg = *(const f32x4*)(g + c), s1 = *(const f32x4*)(sc + c), s0 = *(const f32x4*)(sh + c);
                const f32x4 x0 = (v0[j] * rms0 * gg) * (s1 + 1.0f) + s0, x1 = (v1[j] * rms1 * gg) * (s1 + 1.0f) + s0; h0[j] = x0; h1[j] = x1;
                u32x2 w0, w1; w0.x = pk2(x0.x, x0.y); w0.y = pk2(x0.z, x0.w); w1.x = pk2(x1.x, x1.y); w1.y = pk2(x1.z, x1.w);
                if (VAR == 0 || x0.x == 12345.678f) { *(u32x2*)(o0 + c) = w0; *(u32x2*)(o0 + DM + c) = w1; } }
        }
        float lg0[16], lg1[16];
#pragma unroll
        for (int e = 0; e < 16; ++e) { lg0[e] = 0.f; lg1[e] = 0.f; }
#pragma unroll
        for (int e = 0; e < 16; ++e) {
#pragma unroll
            for (int j = 0; j < 4; ++j) { const f32x4 w = *(const LAS f32x4*)(rwl + e * 1024 + 4 * (lane + 64 * j));
                lg0[e] += (h0[j].x * w.x + h0[j].y * w.y) + (h0[j].z * w.z + h0[j].w * w.w); lg1[e] += (h1[j].x * w.x + h1[j].y * w.y) + (h1[j].z * w.z + h1[j].w * w.w); }
            if ((e & 3) == 3) __builtin_amdgcn_sched_barrier(0); }
        float x[16], z[8];
#pragma unroll
        for (int e = 0; e < 16; ++e) { float ra, rbb; swap32(lg0[e], lg1[e], ra, rbb); x[e] = ra + rbb; }
#pragma unroll
        for (int k = 0; k < 8; ++k) { float ra, rbb; swap16(x[k], x[k + 8], ra, rbb); z[k] = ra + rbb; }
#pragma unroll
        for (int k = 0; k < 8; ++k) { z[k] = dpp_add_(z[k], 0); z[k] = dpp_add_(z[k], 1); z[k] = dpp_add_(z[k], 2); z[k] = dpp_add_(z[k], 3); }
        float sc[8], bs[8];
#pragma unroll
        for (int e = 0; e < 8; ++e) { sc[e] = sigmoidf_(z[e]); bs[e] = sc[e] + rb[e]; }
        float gsv[2];
#pragma unroll
        for (int g = 0; g < 2; ++g) { const float x0 = bs[4 * g], x1 = bs[4 * g + 1], x2 = bs[4 * g + 2], x3 = bs[4 * g + 3];
            const float h1 = fmaxf(x0, x1), l1 = fminf(x0, x1), h2 = fmaxf(x2, x3), l2 = fminf(x2, x3);
            gsv[g] = fmaxf(h1, h2) + fmaxf(fminf(h1, h2), fmaxf(l1, l2)); }
        const int lb = gsv[1] > gsv[0] ? 1 : 0; const float lbv = lb ? gsv[1] : gsv[0];
        float ev, od; swap16(lbv, lbv, ev, od);
        const bool mine = (lq & 1) ? (od > ev) : !(od > ev);
        const float g0 = lb ? bs[4] : bs[0], g1 = lb ? bs[5] : bs[1], g2 = lb ? bs[6] : bs[2], g3 = lb ? bs[7] : bs[3];
        const float s0 = lb ? sc[4] : sc[0], s1 = lb ? sc[5] : sc[1], s2 = lb ? sc[6] : sc[2], s3 = lb ? sc[7] : sc[3];
        int i0 = 0; float m0 = g0, t0 = s0;
        if (g1 > m0) { m0 = g1; i0 = 1; t0 = s1; } if (g2 > m0) { m0 = g2; i0 = 2; t0 = s2; } if (g3 > m0) { m0 = g3; i0 = 3; t0 = s3; }
        int i1 = -1; float m1 = 0.f, t1 = 0.f;
        if (i0 != 0) { m1 = g0; i1 = 0; t1 = s0; }
        if (i0 != 1 && (i1 < 0 || g1 > m1)) { m1 = g1; i1 = 1; t1 = s1; }
        if (i0 != 2 && (i1 < 0 || g2 > m1)) { m1 = g2; i1 = 2; t1 = s2; }
        if (i0 != 3 && (i1 < 0 || g3 > m1)) { m1 = g3; i1 = 3; t1 = s3; }
        const bool writer = mine && (lane & 15) == 0 && (VAR == 0 || t0 == 12345.678f);
        const int e0 = eb + lb * 4 + i0, e1 = eb + lb * 4 + i1; const float inv = 1.0f / (t0 + t1);
#pragma unroll
        for (int r = 0; r < 2; ++r)
            if (writer && rsel == r) {
                const int sl0 = wcnt[wave * 16 + e0]; wcnt[wave * 16 + e0] = sl0 + 1;
                const int sl1 = wcnt[wave * 16 + e1]; wcnt[wave * 16 + e1] = sl1 + 1;
                int* rp = route + (size_t)(row + r) * 8;
                rp[0] = e0; rp[1] = e1; rp[2] = sl0; rp[3] = sl1; rp[6] = __float_as_int(t0 * inv); rp[7] = __float_as_int(t1 * inv);
            }
    }
    __syncthreads();
    if (VAR == 0 && tid < 16) {
        int tot = 0;
#pragma unroll
        for (int w = 0; w < 8; ++w) tot += wcnt[w * 16 + tid];
        int run = (int)atomicAdd(cnt + tid, (unsigned)tot);
#pragma unroll
        for (int w = 0; w < 8; ++w) { woff[w * 16 + tid] = run; run += wcnt[w * 16 + tid]; }
    }
    asm volatile("s_waitcnt vmcnt(0)" ::: "memory");
    __syncthreads();
    { const int row = 2 * (gw + (lane >> 1) * NGW) + (lane & 1);
      if (VAR == 0 && row < nrows) { int* rp = route + (size_t)row * 8; const int e0 = rp[0], e1 = rp[1]; rp[2] += woff[wave * 16 + e0]; rp[3] += woff[wave * 16 + e1]; } }
    __syncthreads();
#undef RT_LOAD
}

__device__ __forceinline__ void ph_plan_gather(const Args& a, int l, LAS unsigned char* lds, int tid, int lane, int wave) {
    const int gw = blockIdx.x * 8 + wave, NGW = gridDim.x * 8;
    unsigned char* ws = a.ws;
    const unsigned* cnt = (const unsigned*)(ws + WS_CTL) + CW_CNT + 64 * l; int* plan = (int*)(ws + WS_CTL) + CW_PLAN + 512 * l;
    LAS int* ps = (LAS int*)lds;
    if (tid == 0) {
        int acc = 0;
        for (int e = 0; e < 16; ++e) { const int c = (int)cnt[e], pd = (c + 255) & ~255; ps[e] = acc;
            if (blockIdx.x == 0) { for (int t = acc >> 8; t < (acc + pd) >> 8; ++t) plan[16 + t] = e; plan[320 + e] = acc; }
            acc += pd; }
        if (blockIdx.x == 0) plan[0] = acc >> 8;
    }
    __syncthreads();
    int* route = (int*)(ws + WS_ROUTE); const bf16* H = (const bf16*)(ws + WS_H); bf16* Xs = (bf16*)(ws + WS_XS);
    const int ntok = (l == 1) ? NTL : NT;
    for (int it = gw; it < 2 * ntok; it += NGW) {
        const int tok = it >> 1, k = it & 1; int* rp = route + (size_t)tok * 8;
        const int e = rp[k], sl = rp[2 + k], dest = ps[e] + sl;
        if (lane == 0) rp[4 + k] = dest;
        const u32x4* s = (const u32x4*)(H + (size_t)tok * DM); u32x4* d = (u32x4*)(Xs + (size_t)dest * DM);
        __builtin_nontemporal_store(s[lane], d + lane); __builtin_nontemporal_store(s[lane + 64], d + lane + 64);
    }
    __syncthreads();
}

template <int VAR> __device__ __forceinline__ void ph_combine(const Args& a, int l, int lane, int wave) {
    const int gw = blockIdx.x * 8 + wave, NGW = gridDim.x * 8;
    unsigned char* ws = a.ws;
    const float* modv = (const float*)(ws + WS_MODV); const int* route = (const int*)(ws + WS_ROUTE); const bf16* Y2 = (const bf16*)(ws + WS_XS);
    float* XC = (float*)(ws + WS_XC); bf16* H = (bf16*)(ws + WS_H);
    const int nrows = (l == 1) ? NTL : NT;
    for (int row = gw; row < nrows; row += NGW) {
        float* xr = row < NTL ? a.out + (size_t)row * DM : XC + (size_t)(row - NTL) * DM;
        const int mr = row < NTL ? (row >> 12) : 8;
        const int* rp = route + (size_t)row * 8; const int d0 = rp[4], d1 = rp[5]; const float g0 = __int_as_float(rp[6]), g1 = __int_as_float(rp[7]);
        const float* gf = modv + ((size_t)l * 9 + mr) * 6144 + 5120;
        f32x4 v[4];
#pragma unroll
        for (int j = 0; j < 4; ++j) { const int c = 4 * (lane + 64 * j);
            const f32x4 x = *(const f32x4*)(xr + c), gg = *(const f32x4*)(gf + c);
            const u32x2 w0 = __builtin_nontemporal_load((const u32x2*)(Y2 + (size_t)d0 * DM + c)), w1 = __builtin_nontemporal_load((const u32x2*)(Y2 + (size_t)d1 * DM + c));
            const f32x4 ya = (f32x4){bflo(w0.x), bfhi(w0.x), bflo(w0.y), bfhi(w0.y)}, yb = (f32x4){bflo(w1.x), bfhi(w1.x), bflo(w1.y), bfhi(w1.y)};
            v[j] = x + gg * (ya * g0 + yb * g1); }
        if (l == 0) {
#pragma unroll
            for (int j = 0; j < 4; ++j) if (VAR == 0 || v[j].x == 12345.678f) __builtin_nontemporal_store(v[j], (f32x4*)(xr + 4 * (lane + 64 * j)));
            f32x4 h[4];
            norm_mod_store(v, a.in[I_NMIX] + DM, modv + ((size_t)9 + mr) * 6144 + 1024, modv + ((size_t)9 + mr) * 6144, H + (size_t)row * DM, lane, h, VAR == 0);
        } else {
            float ss = 0.f;
#pragma unroll
            for (int j = 0; j < 4; ++j) ss += (v[j].x * v[j].x + v[j].y * v[j].y) + (v[j].z * v[j].z + v[j].w * v[j].w);
            const float rms = rsqrtf(wave_sum(ss) * (1.0f / DM) + 1e-6f);
#pragma unroll
            for (int j = 0; j < 4; ++j) { const int c = 4 * (lane + 64 * j); const f32x4 ov = v[j] * rms * *(const f32x4*)(a.in[I_FNG] + c); if (VAR == 0 || ov.x == 12345.678f) __builtin_nontemporal_store(ov, (f32x4*)(xr + c)); }
        }
    }
}

#define IN(k) (lo <= (k) && (k) < hi)
#define SEAM(k) do { if ((k) + 1 < hi) xcd_barrier(bar); } while (0)
template <int MASK, int l> __device__ __forceinline__ void layer_phases(const Args& args, LAS unsigned char* lds, const XcdBarrier& bar, int lo, int hi, int tid, int lane, int wave) {
    constexpr int pb = 2 + 13 * l;
    const int G = gridDim.x, cid = blockIdx.x;
    unsigned char* ws = args.ws;

        if (HAS(2) && IN(pb + 0)) {
            pg8::Gemm g{(const bf16*)(ws + WS_H), (const bf16*)(ws + WS_WIN) + (size_t)l * INCP * DM, DM, DM, DM};
            pg8::DenseOrder S; S.init(NT / 256, INCP / 256, G, cid, DM, DM, 0);
            pg8::EpiStore E{(bf16*)(ws + WS_P), INCP};
            for (int rep_ = 0; rep_ < REPS(2); ++rep_) pg8::gemm_phase<pg8::EpiStore, pg8::DenseOrder, true, true>(lds, g, S, E);
            SEAM(pb + 0);
        }
        if (HAS(3) && IN(pb + 1)) { ph_postproj(args, l, lds, tid, lane, wave); if (REPS(3) > 1) ph_postproj(args, l, lds, tid, lane, wave); if (REPS(3) > 2) ph_postproj(args, l, lds, tid, lane, wave); SEAM(pb + 1); }
        if (HAS(4) && IN(pb + 2)) {
            pg8::Gemm g{(const bf16*)(ws + WS_AP), (const bf16*)(ws + WS_WL) + (size_t)l * LWC * 128, APC, 128, 128};
            pg8::DenseOrder S; S.init(NT / 256, LWC / 256, G, cid, APC, 128, 1);
            pg8::EpiStore E{(bf16*)(ws + WS_P), LWC};
            for (int rep_ = 0; rep_ < REPS(4); ++rep_) pg8::gemm_phase<pg8::EpiStore, pg8::DenseOrder, true, true>(lds, g, S, E);
            SEAM(pb + 2);
        }
        if (HAS(5) && IN(pb + 3)) {
#if REPK == 15 || REPK == 16
            if (HAS(15)) for (int rep_ = 0; rep_ < REPS(15); ++rep_) ph_attention(args, l, lane, wave);
            if (HAS(16)) for (int rep_ = 0; rep_ < REPS(16); ++rep_) ph_scan1b(args, l, lds, lane, wave);
#else
            if (wave < 4) { ph_scan1b(args, l, lds, lane, wave); __builtin_amdgcn_sched_barrier(0); ph_attention(args, l, lane, wave); }
            else { ph_attention(args, l, lane, wave); __builtin_amdgcn_sched_barrier(0); ph_scan1b(args, l, lds, lane, wave); }
#endif
            SEAM(pb + 3); }
        if (HAS(6) && IN(pb + 4)) { ph_scan2<0>(args, lds, tid, lane, wave); for (int rep_ = 1; rep_ < REPS(6); ++rep_) ph_scan2<1>(args, lds, tid, lane, wave); SEAM(pb + 4); }
        if (HAS(7) && IN(pb + 5)) { ph_scan3b(args, l, lds, lane, wave); for (int rep_ = 1; rep_ < REPS(7); ++rep_) ph_scan3b(args, l, lds, lane, wave); SEAM(pb + 5); }
        if (HAS(8) && IN(pb + 6)) { for (int rep_ = 0; rep_ < REPS(8); ++rep_) ph_readout(args, l, lane, wave); SEAM(pb + 6); }
        if (HAS(9) && IN(pb + 7)) {
            pg8::Gemm g{(const bf16*)(ws + WS_H), (const bf16*)(ws + WS_WOUT) + (size_t)l * DM * DM, DM, DM, DM};
            pg8::DenseOrder S; S.init((l == 1 ? NTL : NT) / 256, DM / 256, G, cid, DM, DM, 0);
            pg8::EpiResid E{l == 0 ? args.in[I_X] : args.out, l == 0 ? args.in[I_CTX] : (const float*)(ws + WS_XC), args.out, (float*)(ws + WS_XC), (const float*)(ws + WS_MODV) + (size_t)l * 9 * 6144, 0};
            pg8::gemm_phase<pg8::EpiResid, pg8::DenseOrder, true, true>(lds, g, S, E);
            if (REPS(9) > 1) { pg8::EpiResid E2 = E; E2.dummy = 1; pg8::gemm_phase<pg8::EpiResid, pg8::DenseOrder, true, true>(lds, g, S, E2); if (REPS(9) > 2) pg8::gemm_phase<pg8::EpiResid, pg8::DenseOrder, true, true>(lds, g, S, E2); }
            SEAM(pb + 7);
        }
        if (HAS(10) && IN(pb + 8)) { ph_norm2_router<0>(args, l, lds, tid, lane, wave); for (int rep_ = 1; rep_ < REPS(17); ++rep_) ph_norm2_router<1>(args, l, lds, tid, lane, wave); for (int rep_ = 0; rep_ < REPS(10); ++rep_) convert_experts(args, l, lds, lane, wave); SEAM(pb + 8); }
        if (HAS(11) && IN(pb + 9)) { for (int rep_ = 0; rep_ < REPS(11); ++rep_) ph_plan_gather(args, l, lds, tid, lane, wave); SEAM(pb + 9); }
        if (HAS(12) && IN(pb + 10)) {
            pg8::Gemm g{(const bf16*)(ws + WS_XS), (const bf16*)(ws + WS_WE), DM, DM, DM};
            pg8::MoeOrder S; S.init((const int*)(ws + WS_CTL) + CW_PLAN + 512 * l, 8, G, cid, DM, DM, 2048);
            pg8::EpiGateUp E{(bf16*)(ws + WS_HM)};
            for (int rep_ = 0; rep_ < REPS(12); ++rep_) pg8::gemm_phase<pg8::EpiGateUp, pg8::MoeOrder, true, true>(lds, g, S, E);
            SEAM(pb + 10);
        }
        if (HAS(13) && IN(pb + 11)) {
            pg8::Gemm g{(const bf16*)(ws + WS_HM), (const bf16*)(ws + WS_WE) + (size_t)16 * 2048 * 1024, DM, DM, DM};
            pg8::MoeOrder S; S.init((const int*)(ws + WS_CTL) + CW_PLAN + 512 * l, 4, G, cid, DM, DM, 1024);
            pg8::EpiStore E{(bf16*)(ws + WS_XS), DM};
            for (int rep_ = 0; rep_ < REPS(13); ++rep_) pg8::gemm_phase<pg8::EpiStore, pg8::MoeOrder, true, true>(lds, g, S, E);
            SEAM(pb + 11);
        }
        if (HAS(14) && IN(pb + 12)) { if (REPS(14) > 1) ph_combine<1>(args, l, lane, wave); if (REPS(14) > 2) ph_combine<1>(args, l, lane, wave); ph_combine<0>(args, l, lane, wave); SEAM(pb + 12); }
    }
#undef IN
#undef SEAM

template <int MASK> __global__ void __launch_bounds__(512, 2) __attribute__((target("no-packed-fp32-ops"))) mega_fwd(Args args) {
    extern __shared__ __attribute__((aligned(16))) unsigned char lds_raw[];
    LAS unsigned char* lds = (LAS unsigned char*)lds_raw;
    const int tid = threadIdx.x, lane = tid & 63, wave = __builtin_amdgcn_readfirstlane(tid >> 6);
    const int lo = args.ph_lo, hi = args.ph_hi;
    volatile LAS unsigned* MISC = (volatile LAS unsigned*)(lds + MISC_OFF);
    if (tid < 64) MISC[tid] = 0u;
    __syncthreads();
    unsigned* ctl = (unsigned*)(args.ws + WS_CTL);
    XcdBarrier bar; bar.bar = ctl + CW_BAR; bar.x = 0; bar.st = MISC + 8;
    if (hi - lo > 1) bar = xcd_barrier_post(ctl + CW_BAR, MISC + 8);
#define IN(k) (lo <= (k) && (k) < hi)
#define SEAM(k) do { if ((k) + 1 < hi) xcd_barrier(bar); } while (0)
    const int G = gridDim.x, cid = blockIdx.x;
    unsigned char* ws = args.ws;

    if (HAS(0) && IN(0)) { for (int rep_ = 0; rep_ < REPS(0); ++rep_) { ph_prologue(args, lds, tid, lane, wave); __syncthreads(); } SEAM(0); }
    if (HAS(1) && IN(1)) { for (int rep_ = 0; rep_ < REPS(1); ++rep_) ph_norm1_l0(args, lane, wave); SEAM(1); }
    layer_phases<MASK, 0>(args, lds, bar, lo, hi, tid, lane, wave);
    layer_phases<MASK, 1>(args, lds, bar, lo, hi, tid, lane, wave);
#undef IN
#undef SEAM
}

template <int MASK> static void launch_one(const Args& a, int grid, hipStream_t stream) { hipLaunchKernelGGL(mega_fwd<MASK>, dim3(grid), dim3(512), LDS_BYTES, stream, a); }
template <int MASK> static bool setup_one(int* per_cu) {
    if (hipFuncSetAttribute((const void*)mega_fwd<MASK>, hipFuncAttributeMaxDynamicSharedMemorySize, LDS_BYTES) != hipSuccess) return false;
    int pc = 0; if (hipOccupancyMaxActiveBlocksPerMultiprocessor(&pc, (const void*)mega_fwd<MASK>, 512, LDS_BYTES) != hipSuccess) pc = 0;
    (void)hipGetLastError(); if (pc < *per_cu) *per_cu = pc; return true;
}
static int kind_of_phase(int p) { return p < 2 ? p : 2 + (p - 2) % 13; }

extern "C" void kernel_launch(void* const* d_in, const int* in_sizes, int n_in, void* d_out, int out_size, void* d_ws, size_t ws_size, hipStream_t stream) {
    static int grid = 0;
    if (grid == 0) {
        if (n_in != 32 || out_size != NTL * DM || ws_size < WS_END) { fprintf(stderr, "kernel_launch: unexpected sizes (n_in %d, out %d, ws %zu, need %zu)\n", n_in, out_size, ws_size, (size_t)WS_END); grid = -1; return; }
        int dev = 0, cus = 0, per_cu = 99;
        if (hipGetDevice(&dev) != hipSuccess || hipDeviceGetAttribute(&cus, hipDeviceAttributeMultiprocessorCount, dev) != hipSuccess) { grid = -1; return; }
        bool ok = true;
#if MK_MULTI
        ok = ok && setup_one<1 << 0>(&per_cu) && setup_one<1 << 1>(&per_cu) && setup_one<1 << 2>(&per_cu) && setup_one<1 << 3>(&per_cu) && setup_one<1 << 4>(&per_cu)
                && setup_one<(1 << 5) | (1 << 15)>(&per_cu) && setup_one<(1 << 5) | (1 << 16)>(&per_cu) && setup_one<1 << 6>(&per_cu) && setup_one<1 << 7>(&per_cu) && setup_one<1 << 8>(&per_cu) && setup_one<1 << 9>(&per_cu)
                && setup_one<1 << 10>(&per_cu) && setup_one<1 << 11>(&per_cu) && setup_one<1 << 12>(&per_cu) && setup_one<1 << 13>(&per_cu) && setup_one<1 << 14>(&per_cu);
#else
        ok = ok && setup_one<0x1ffff>(&per_cu);
#endif
        if (!ok) { fprintf(stderr, "kernel_launch: hipFuncSetAttribute failed\n"); grid = -1; return; }
        if (per_cu < 1) fprintf(stderr, "kernel_launch: occupancy query reports %d\n", per_cu);
        grid = cus;
    }
    if (grid < 0) return;
    (void)hipMemsetAsync((char*)d_ws + WS_CTL, 0, CTL_BYTES, stream);
    Args a{};
    for (int i = 0; i < 32; ++i) a.in[i] = (const float*)d_in[i];
    a.out = (float*)d_out; a.ws = (unsigned char*)d_ws;
#if MK_MULTI
    for (int p = 0; p < NPHASE; ++p) {
        a.ph_lo = p; a.ph_hi = p + 1;
        switch (kind_of_phase(p)) {
            case 0: launch_one<1 << 0>(a, grid, stream); break;   case 1: launch_one<1 << 1>(a, grid, stream); break;
            case 2: launch_one<1 << 2>(a, grid, stream); break;   case 3: launch_one<1 << 3>(a, grid, stream); break;
            case 4: launch_one<1 << 4>(a, grid, stream); break;   case 5: launch_one<(1 << 5) | (1 << 15)>(a, grid, stream); launch_one<(1 << 5) | (1 << 16)>(a, grid, stream); break;
            case 6: launch_one<1 << 6>(a, grid, stream); break;   case 7: launch_one<1 << 7>(a, grid, stream); break;
            case 8: launch_one<1 << 8>(a, grid, stream); break;   case 9: launch_one<1 << 9>(a, grid, stream); break;
            case 10: launch_one<1 << 10>(a, grid, stream); break; case 11: launch_one<1 << 11>(a, grid, stream); break;
            case 12: launch_one<1 << 12>(a, grid, stream); break; case 13: launch_one<1 << 13>(a, grid, stream); break;
            default: launch_one<1 << 14>(a, grid, stream); break;
        }
    }
#else
    a.ph_lo = 0; a.ph_hi = NPHASE;
    launch_one<0x1ffff>(a, grid, stream);
#endif
}
```

```cpp
#include <hip/hip_runtime.h>
#include <cstdio>
#include <cstdint>

#ifndef MK_MULTI
#define MK_MULTI 0
#endif

#ifndef PHMASK
#define PHMASK 0x1ffff
#endif
#define HAS(k) ((((PHMASK) & MASK) >> (k)) & 1)
#ifndef REPK
#define REPK -1
#endif
#ifndef REPN
#define REPN 1
#endif
#define REPS(k) ((REPK) == (k) ? (REPN) : 1)
#define LAS __attribute__((address_space(3)))
#define GAS __attribute__((address_space(1)))
typedef unsigned short bf16;
typedef short bf16x8 __attribute__((ext_vector_type(8)));
typedef float f32x4 __attribute__((ext_vector_type(4)));
typedef float f32x16 __attribute__((ext_vector_type(16)));
typedef unsigned u32x4 __attribute__((ext_vector_type(4)));
typedef unsigned u32x2 __attribute__((ext_vector_type(2)));

constexpr int NB = 8, SEQ = 4096, CTXL = 256, DM = 1024;
constexpr int NTL = NB * SEQ, NTC = NB * CTXL, NT = NTL + NTC;
constexpr int INC = 2688, INCP = 2816;
constexpr int POSN = CTXL + SEQ;
constexpr int NCH = 16, CHL = 272;
constexpr int LWC = 2560;
constexpr int APC = 384;
constexpr int MOE_ROWS = 73728;
constexpr int NPHASE = 28;

constexpr size_t MiB = 1u << 20;
constexpr size_t WS_CTL = 0, CTL_BYTES = 1 * MiB;
constexpr size_t WS_MODV = 1 * MiB;
constexpr size_t WS_WIN = 2 * MiB;
constexpr size_t WS_WOUT = 14 * MiB;
constexpr size_t WS_WL = 18 * MiB;
constexpr size_t WS_XC = 21 * MiB;
constexpr size_t WS_ROUTE = 29 * MiB;
constexpr size_t WS_H = 31 * MiB;
constexpr size_t WS_V0 = 99 * MiB;
constexpr size_t WS_T = 133 * MiB;
constexpr size_t WS_P = WS_T;
constexpr size_t WS_R = WS_T + 187 * MiB;
constexpr size_t WS_K = WS_R + 34 * MiB;
constexpr size_t WS_V1 = WS_K + 34 * MiB;
constexpr size_t WS_QR = WS_V1 + 34 * MiB;
constexpr size_t WS_KR = WS_QR + 34 * MiB;
constexpr size_t WS_VT = WS_KR + 9 * MiB;
constexpr size_t WS_AP = WS_VT + 9 * MiB;
constexpr size_t WS_Y = WS_QR;
constexpr size_t WS_PC = WS_AP + 26 * MiB;
constexpr size_t WS_LC = WS_PC + 32 * MiB;
constexpr size_t WS_KN = WS_LC + 32 * MiB;
constexpr size_t WS_MIX_END = WS_KN + 2 * MiB;
constexpr size_t WS_WE = WS_T;
constexpr size_t WS_XS = WS_T + 96 * MiB;
constexpr size_t WS_HM = WS_XS + 144 * MiB;
constexpr size_t WS_MOE_END = WS_HM + 144 * MiB;
constexpr size_t WS_END = WS_MIX_END > WS_MOE_END ? WS_MIX_END : WS_MOE_END;
static_assert((size_t)NT * INCP * 2 <= 187 * MiB && (size_t)NT * 512 * 2 <= 34 * MiB && (size_t)NT * 128 * 2 <= 9 * MiB && (size_t)NB * 2 * 64 * POSN * 2 <= 9 * MiB, "ws map");
static_assert((size_t)NT * APC * 2 <= 26 * MiB && (size_t)2 * NT * 512 * 2 <= 78 * MiB && (size_t)MOE_ROWS * 1024 * 2 <= 144 * MiB && (size_t)NT * 32 <= 2 * MiB, "ws map");
static_assert(WS_END <= (size_t)590 * MiB, "ws budget");

constexpr int CW_BAR = 4096;
constexpr int CW_CNT = 8192;
constexpr int CW_PLAN = 8448;
static_assert((CW_PLAN + 2 * 512) * 4 <= 65536, "control words inside the zeroed 64 KiB");

constexpr int RING_BYTES = 131072;
constexpr int MISC_OFF = 147456 - 256;
constexpr int LDS_BYTES = 147456;

__device__ __forceinline__ unsigned f2bf(float f) { unsigned u = __builtin_bit_cast(unsigned, f); return (u + 0x7fffu + ((u >> 16) & 1u)) >> 16; }
typedef float f32x2_t __attribute__((ext_vector_type(2)));
typedef __bf16 bf16x2_t __attribute__((ext_vector_type(2)));
__device__ __forceinline__ unsigned pk2(float lo, float hi) { const f32x2_t v = {lo, hi}; const bf16x2_t b = __builtin_convertvector(v, bf16x2_t); return __builtin_bit_cast(unsigned, b); }
__device__ __forceinline__ unsigned short f2bf1(float f) { return (unsigned short)(pk2(f, 0.f) & 0xffffu); }
__device__ __forceinline__ float bf2f(unsigned short h) { return __builtin_bit_cast(float, (unsigned)h << 16); }
__device__ __forceinline__ float bflo(unsigned w) { return __builtin_bit_cast(float, w << 16); }
__device__ __forceinline__ float bfhi(unsigned w) { return __builtin_bit_cast(float, w & 0xffff0000u); }
__device__ __forceinline__ void unpack8(u32x4 w, float* f) { f[0] = bflo(w.x); f[1] = bfhi(w.x); f[2] = bflo(w.y); f[3] = bfhi(w.y); f[4] = bflo(w.z); f[5] = bfhi(w.z); f[6] = bflo(w.w); f[7] = bfhi(w.w); }
__device__ __forceinline__ u32x4 pack8(const float* f) { u32x4 w; w.x = pk2(f[0], f[1]); w.y = pk2(f[2], f[3]); w.z = pk2(f[4], f[5]); w.w = pk2(f[6], f[7]); return w; }
__device__ __forceinline__ void swap32(float a, float b, float& ra, float& rb) {
    auto r = __builtin_amdgcn_permlane32_swap(__builtin_bit_cast(unsigned, a), __builtin_bit_cast(unsigned, b), false, false);
    const unsigned u0 = r[0], u1 = r[1];
    ra = __builtin_bit_cast(float, u0); rb = __builtin_bit_cast(float, u1);
}
__device__ __forceinline__ float dpp_add_(float x, int ctrl_sel) {
    const int xi = __builtin_bit_cast(int, x); int y;
    if (ctrl_sel == 0) y = __builtin_amdgcn_update_dpp(0, xi, 0xB1, 0xf, 0xf, false);
    else if (ctrl_sel == 1) y = __builtin_amdgcn_update_dpp(0, xi, 0x4E, 0xf, 0xf, false);
    else if (ctrl_sel == 2) y = __builtin_amdgcn_update_dpp(0, xi, 0x141, 0xf, 0xf, false);
    else y = __builtin_amdgcn_update_dpp(0, xi, 0x140, 0xf, 0xf, false);
    return x + __builtin_bit_cast(float, y);
}
__device__ __forceinline__ void swap16(float a, float b, float& ra, float& rb) {
    auto r = __builtin_amdgcn_permlane16_swap(__builtin_bit_cast(unsigned, a), __builtin_bit_cast(unsigned, b), false, false);
    const unsigned u0 = r[0], u1 = r[1];
    ra = __builtin_bit_cast(float, u0); rb = __builtin_bit_cast(float, u1);
}
__device__ __forceinline__ float xor2_(float x) { return __builtin_bit_cast(float, __builtin_amdgcn_update_dpp(0, __builtin_bit_cast(int, x), 0x4E, 0xf, 0xf, false)); }
__device__ __forceinline__ float sum8_(float x) { x = dpp_add_(x, 0); x = dpp_add_(x, 1); return dpp_add_(x, 2); }
__device__ __forceinline__ float wave_sum(float v) {
    v = dpp_add_(v, 0); v = dpp_add_(v, 1); v = dpp_add_(v, 2); v = dpp_add_(v, 3);
    float t0, t1; swap16(v, v, t0, t1); v = t0 + t1; swap32(v, v, t0, t1); return t0 + t1;
}
__device__ __forceinline__ float sigmoidf_(float x) { return __builtin_amdgcn_rcpf(1.0f + __expf(-x)); }
__device__ __forceinline__ float sigmoid_nb(float x, float nb) { return __builtin_amdgcn_rcpf(1.0f + __builtin_amdgcn_exp2f(__builtin_fmaf(x, -1.4426950408889634f, nb))); }
__device__ __forceinline__ int row_of(int b, int pos) { return pos < CTXL ? NTL + b * CTXL + pos : b * SEQ + (pos - CTXL); }

namespace pg8 {
#define PG8_LAS __attribute__((address_space(3)))
typedef unsigned short bf16_t;
constexpr int BM = 256, BK = 64, HALF = 128, HTB = HALF * BK * 2, STAGE_BYTES = 8 * HTB, NXCD = 8, WGM = 8;
__host__ __device__ __forceinline__ int lds_byte(int r, int c) { const int st = (r >> 4) * 2 + (c >> 5), rr = r & 15, cc = c & 31, ob = rr * 64 + cc * 2; return st * 1024 + (ob ^ (((ob >> 9) & 1) << 5)); }
__host__ __device__ __forceinline__ void stage_rc(int b, int& R, int& C) { const int st = b / 1024, sb = b % 1024, swz = sb ^ (((sb >> 9) & 1) << 5); R = (st >> 1) * 16 + swz / 64; C = (st & 1) * 32 + (swz % 64) / 2; }
__host__ __device__ __forceinline__ int perm32(int rho) { const int n = rho >> 4, i = rho & 15; return 8 * (i >> 2) + 4 * n + (i & 3); }

struct Unit { int pm, pn; unsigned aoff, boff; int aux; };
struct Gemm { const bf16_t* A; const bf16_t* Bt; int lda, ldb, K; };

__device__ __forceinline__ unsigned cvt_pk_bf16(float lo, float hi) { unsigned r; asm volatile("v_cvt_pk_bf16_f32 %0, %1, %2" : "=v"(r) : "v"(lo), "v"(hi)); return r; }

template <class Epi, class Sched, bool ALIGN_EPI = false, bool SP2 = false>
__device__ __forceinline__ void gemm_phase(PG8_LAS unsigned char* lds, const Gemm g, const Sched& S, const Epi& E) {
    const int tid = threadIdx.x, wid = __builtin_amdgcn_readfirstlane(tid >> 6), lane = tid & 63, wr = wid >> 2, wc = wid & 3, fr = lane & 15, fq = lane >> 4;
    const int K = g.K, nt = K / BK;
    unsigned voffA[2], voffB[2];
#pragma unroll
    for (int i = 0; i < 2; ++i) { int R, C; stage_rc(tid * 16 + i * 8192, R, C); const int Rb = Epi::PERM ? ((R & ~31) + perm32(R & 31)) : R;
        voffA[i] = (unsigned)(R * g.lda + C) * 2u; voffB[i] = (unsigned)(Rb * g.ldb + C) * 2u; }
    const size_t kstep = (size_t)(BK * 2);
    const size_t hstepA = (size_t)HALF * g.lda * 2, hstepB = (size_t)HALF * g.ldb * 2;
    const unsigned ldsw = (unsigned)wid * 1024u;
    const int aoff = lds_byte(wr * 64 + fr, fq * 8), boff = lds_byte(wc * 32 + fr, fq * 8);
#define PG8_SA(b, h) (((b) * 2 + (h)) * HTB)
#define PG8_SB(b, h) ((4 + (b) * 2 + (h)) * HTB)
    const __amdgpu_buffer_rsrc_t rsA = __builtin_amdgcn_make_buffer_rsrc((void*)g.A, 0, 0x7ffffffe, 0x00020000), rsB = __builtin_amdgcn_make_buffer_rsrc((void*)g.Bt, 0, 0x7ffffffe, 0x00020000);
#define PG8_STAGE(bufoff, gbase, voff) do { const bool isA_ = (const void*)(voff) == (const void*)voffA; const int so_ = (int)((const char*)(gbase) - (isA_ ? (const char*)g.A : (const char*)g.Bt)); \
        _Pragma("unroll") for (int _i = 0; _i < 2; ++_i) { if (isA_) __builtin_amdgcn_raw_ptr_buffer_load_lds(rsA, (PG8_LAS unsigned*)(lds + (bufoff) + ldsw + _i * 8192), 16, (int)(voff)[_i], so_, 0, 0); \
            else __builtin_amdgcn_raw_ptr_buffer_load_lds(rsB, (PG8_LAS unsigned*)(lds + (bufoff) + ldsw + _i * 8192), 16, (int)(voff)[_i], so_, 0, 0); } } while (0)
#define PG8_LDA(dst, b, h) do { _Pragma("unroll") for (int m = 0; m < 4; ++m) _Pragma("unroll") for (int k = 0; k < 2; ++k) dst[m][k] = *(const PG8_LAS bf16x8*)(lds + PG8_SA(b, h) + aoff + m * 2048 + k * 1024); } while (0)
#define PG8_LDB(dst, b, h) do { _Pragma("unroll") for (int n = 0; n < 2; ++n) _Pragma("unroll") for (int k = 0; k < 2; ++k) dst[n][k] = *(const PG8_LAS bf16x8*)(lds + PG8_SB(b, h) + boff + n * 2048 + k * 1024); } while (0)
#define PG8_MMA(ai, bj, At, Bt) do { __builtin_amdgcn_s_setprio(1); _Pragma("unroll") for (int m = 0; m < 4; ++m) _Pragma("unroll") for (int n = 0; n < 2; ++n) _Pragma("unroll") for (int k = 0; k < 2; ++k) \
        acc[ai][bj][m][n] = __builtin_amdgcn_mfma_f32_16x16x32_bf16(Bt[n][k], At[m][k], acc[ai][bj][m][n], 0, 0, 0); __builtin_amdgcn_s_setprio(0); } while (0)
#define PG8_WAIT_V(n) asm volatile("s_waitcnt vmcnt(" #n ")" ::: "memory")
#define PG8_WAIT_L(n) asm volatile("s_waitcnt lgkmcnt(" #n ")" ::: "memory")
#define PG8_BAR __builtin_amdgcn_s_barrier()
#define PG8_SCHED __builtin_amdgcn_sched_barrier(0)
    Unit cur, nxt; int ui = 0;
    if (!S.next(0, cur)) return;
    f32x4 acc[2][2][4][2];
#pragma unroll
    for (int a = 0; a < 2; ++a)
#pragma unroll
        for (int b = 0; b < 2; ++b)
#pragma unroll
            for (int m = 0; m < 4; ++m)
#pragma unroll
                for (int n = 0; n < 2; ++n) acc[a][b][m][n] = (f32x4){0.f, 0.f, 0.f, 0.f};
    bf16x8 At[4][2], B0[2][2], B1[2][2];
    const char* cA = (const char*)g.A + (size_t)cur.aoff; const char* cB = (const char*)g.Bt + (size_t)cur.boff;
    if constexpr (SP2) {
        PG8_STAGE(PG8_SB(0, 0), cB, voffB); PG8_STAGE(PG8_SB(0, 1), cB + hstepB, voffB); PG8_STAGE(PG8_SA(0, 0), cA, voffA); PG8_STAGE(PG8_SA(0, 1), cA + hstepA, voffA);
        if (wr == 1) PG8_BAR;
        PG8_WAIT_V(2); PG8_BAR;
        PG8_STAGE(PG8_SB(1, 0), cB + kstep, voffB); PG8_STAGE(PG8_SA(1, 0), cA + kstep, voffA); PG8_STAGE(PG8_SB(1, 1), cB + hstepB + kstep, voffB);
        PG8_WAIT_V(6); PG8_BAR;
    } else {
        PG8_STAGE(PG8_SB(0, 0), cB, voffB); PG8_STAGE(PG8_SA(0, 0), cA, voffA); PG8_STAGE(PG8_SB(0, 1), cB + hstepB, voffB); PG8_STAGE(PG8_SA(0, 1), cA + hstepA, voffA);
        if (wr == 1) PG8_BAR;
        PG8_WAIT_V(4); PG8_BAR;
        PG8_STAGE(PG8_SB(1, 0), cB + kstep, voffB); PG8_STAGE(PG8_SA(1, 0), cA + kstep, voffA); PG8_STAGE(PG8_SB(1, 1), cB + hstepB + kstep, voffB);
        PG8_WAIT_V(6); PG8_BAR;
    }
    for (;;) {
        const bool has_next = S.next(ui + 1, nxt);
        const char* nA = has_next ? (const char*)g.A + (size_t)nxt.aoff : cA; const char* nB = has_next ? (const char*)g.Bt + (size_t)nxt.boff : cB;
#pragma unroll 1
        for (int t = 0; t < nt; t += 2) {
            const bool last = (t == nt - 2);
            const char* a1 = cA + (size_t)(t + 1) * kstep;
            const char* a2 = last ? nA : cA + (size_t)(t + 2) * kstep; const char* b2 = last ? nB : cB + (size_t)(t + 2) * kstep;
            const char* a3 = a2 + kstep; const char* b3 = b2 + kstep;
            if constexpr (SP2) {
            PG8_LDB(B0, 0, 0); PG8_LDB(B1, 0, 1); PG8_SCHED; PG8_LDA(At, 0, 0); PG8_STAGE(PG8_SA(1, 1), a1 + hstepA, voffA);
            PG8_WAIT_V(8); PG8_WAIT_L(0); PG8_BAR; PG8_MMA(0, 0, At, B0); PG8_MMA(0, 1, At, B1); PG8_BAR; PG8_SCHED;
            PG8_LDA(At, 0, 1); PG8_STAGE(PG8_SB(0, 0), b2, voffB); PG8_STAGE(PG8_SB(0, 1), b2 + hstepB, voffB); PG8_STAGE(PG8_SA(0, 0), a2, voffA);
            PG8_WAIT_V(8); PG8_WAIT_L(0); PG8_BAR; PG8_MMA(1, 0, At, B0); PG8_MMA(1, 1, At, B1); PG8_BAR; PG8_SCHED;
            PG8_LDB(B0, 1, 0); PG8_LDB(B1, 1, 1); PG8_SCHED; PG8_LDA(At, 1, 0); PG8_STAGE(PG8_SA(0, 1), a2 + hstepA, voffA);
            PG8_WAIT_V(8); PG8_WAIT_L(0); PG8_BAR; PG8_MMA(0, 0, At, B0); PG8_MMA(0, 1, At, B1); PG8_BAR; PG8_SCHED;
            PG8_LDA(At, 1, 1); PG8_STAGE(PG8_SB(1, 0), b3, voffB); PG8_STAGE(PG8_SB(1, 1), b3 + hstepB, voffB); PG8_STAGE(PG8_SA(1, 0), a3, voffA);
            PG8_WAIT_V(8); PG8_WAIT_L(0); PG8_BAR; PG8_MMA(1, 0, At, B0); PG8_MMA(1, 1, At, B1); PG8_BAR; PG8_SCHED;
            } else {
            PG8_LDB(B0, 0, 0); PG8_SCHED; PG8_LDA(At, 0, 0); PG8_STAGE(PG8_SA(1, 1), a1 + hstepA, voffA);
            PG8_WAIT_L(8); PG8_BAR; PG8_WAIT_L(0); PG8_MMA(0, 0, At, B0); PG8_BAR; PG8_SCHED;
            PG8_LDB(B1, 0, 1); PG8_STAGE(PG8_SB(0, 0), b2, voffB);
            PG8_BAR; PG8_WAIT_L(0); PG8_MMA(0, 1, At, B1); PG8_BAR;
            PG8_LDA(At, 0, 1); PG8_STAGE(PG8_SA(0, 0), a2, voffA);
            PG8_BAR; PG8_WAIT_L(0); PG8_MMA(1, 0, At, B0); PG8_BAR; PG8_SCHED;
            PG8_STAGE(PG8_SB(0, 1), b2 + hstepB, voffB);
            PG8_WAIT_V(6); PG8_BAR; PG8_MMA(1, 1, At, B1); PG8_BAR;
            PG8_LDB(B0, 1, 0); PG8_SCHED; PG8_LDA(At, 1, 0); PG8_STAGE(PG8_SA(0, 1), a2 + hstepA, voffA);
            PG8_WAIT_L(8); PG8_BAR; PG8_WAIT_L(0); PG8_MMA(0, 0, At, B0); PG8_BAR; PG8_SCHED;
            PG8_LDB(B1, 1, 1); PG8_STAGE(PG8_SB(1, 0), b3, voffB);
            PG8_BAR; PG8_WAIT_L(0); PG8_MMA(0, 1, At, B1); PG8_BAR;
            PG8_LDA(At, 1, 1); PG8_STAGE(PG8_SA(1, 0), a3, voffA);
            PG8_BAR; PG8_WAIT_L(0); PG8_MMA(1, 0, At, B0); PG8_BAR; PG8_SCHED;
            PG8_STAGE(PG8_SB(1, 1), b3 + hstepB, voffB);
            PG8_WAIT_V(6); PG8_BAR; PG8_MMA(1, 1, At, B1); PG8_BAR;
            }
        }
        if constexpr (ALIGN_EPI) { if (wr == 0) PG8_BAR; }
        E(acc, cur, wr, wc, fr, fq);
        if (!has_next) break;
#pragma unroll
        for (int a = 0; a < 2; ++a)
#pragma unroll
            for (int b = 0; b < 2; ++b)
#pragma unroll
                for (int m = 0; m < 4; ++m)
#pragma unroll
                    for (int n = 0; n < 2; ++n) acc[a][b][m][n] = (f32x4){0.f, 0.f, 0.f, 0.f};
        cur = nxt; cA = nA; cB = nB; ++ui;
        if constexpr (ALIGN_EPI) { if (wr == 1) PG8_BAR; }
    }
    PG8_WAIT_V(0);
    if constexpr (!ALIGN_EPI) { if (wr == 0) PG8_BAR; }
    PG8_BAR;
#undef PG8_SA
#undef PG8_SB
#undef PG8_STAGE
#undef PG8_LDA
#undef PG8_LDB
#undef PG8_MMA
#undef PG8_WAIT_V
#undef PG8_WAIT_L
#undef PG8_BAR
#undef PG8_SCHED
}

struct DenseOrder {
    int nM, nN, nwg, G, c; unsigned atile, btile; int lora;
    __device__ __forceinline__ void init(int nM_, int nN_, int G_, int c_, int lda, int ldb, int lora_) { nM = nM_; nN = nN_; nwg = nM * nN; G = G_; c = c_; atile = (unsigned)(BM * lda * 2); btile = (unsigned)(BM * ldb * 2); lora = lora_; }
    __device__ __forceinline__ bool next(int i, Unit& u) const {
        const long L = (long)i * G + c; if (L >= nwg) return false;
        int wgid = (int)L; { const int q = nwg / NXCD, r = nwg % NXCD, xcd = wgid % NXCD, off = wgid / NXCD; wgid = (xcd < r ? xcd * (q + 1) : r * (q + 1) + (xcd - r) * q) + off; }
        const int nig = WGM * nN, gid = wgid / nig, fm = gid * WGM, gsz = (nM - fm) < WGM ? (nM - fm) : WGM;
        u.pm = fm + ((wgid % nig) % gsz); u.pn = (wgid % nig) / gsz;
        u.aoff = (unsigned)u.pm * atile + (lora ? (u.pn < 4 ? 0u : (u.pn < 8 ? 256u : 512u)) : 0u); u.boff = (unsigned)u.pn * btile; u.aux = 0; return true;
    }
};
struct MoeOrder {
    const int* plan; int ntiles, npn, G, c; unsigned atile, brow; int nper;
    __device__ __forceinline__ void init(const int* plan_, int npn_, int G_, int c_, int lda, int ldb, int nper_) { plan = plan_; ntiles = plan_[0]; npn = npn_; G = G_; c = c_; atile = (unsigned)(BM * lda * 2); brow = (unsigned)(ldb * 2); nper = nper_; }
    __device__ __forceinline__ bool next(int i, Unit& u) const {
        const int L = i * G + c, x = L & 7, off = L >> 3;
        const int q = ntiles >> 3, r = ntiles & 7, first = x * q + (x < r ? x : r), ntx = q + (x < r ? 1 : 0);
        if (off >= ntx * npn) return false;
        u.pm = first + off / npn; u.pn = off % npn; const int e = plan[16 + u.pm]; u.aux = e;
        u.aoff = (unsigned)u.pm * atile; u.boff = (unsigned)(e * nper + u.pn * BM) * brow; return true;
    }
};

struct EpiStore {
    static constexpr bool PERM = true;
    bf16_t* O; int ldc;
    __device__ __forceinline__ void operator()(const f32x4 (&acc)[2][2][4][2], const Unit& u, int wr, int wc, int fr, int fq) const {
        const int row0 = u.pm * BM + wr * 64 + fr, col0 = u.pn * BM + wc * 32 + 8 * fq;
#pragma unroll
        for (int ai = 0; ai < 2; ++ai)
#pragma unroll
            for (int m = 0; m < 4; ++m) { bf16_t* rowp = O + (size_t)(row0 + ai * HALF + m * 16) * ldc + col0;
#pragma unroll
                for (int bj = 0; bj < 2; ++bj) { const f32x4 v0 = acc[ai][bj][m][0], v1 = acc[ai][bj][m][1];
                    u32x4 w; w.x = cvt_pk_bf16(v0[0], v0[1]); w.y = cvt_pk_bf16(v0[2], v0[3]); w.z = cvt_pk_bf16(v1[0], v1[1]); w.w = cvt_pk_bf16(v1[2], v1[3]);
                    __builtin_nontemporal_store(w, (u32x4*)(rowp + bj * HALF)); } }
    }
};
struct EpiGateUp {
    static constexpr bool PERM = true;
    bf16_t* O;
    __device__ __forceinline__ void operator()(const f32x4 (&acc)[2][2][4][2], const Unit& u, int wr, int wc, int fr, int fq) const {
        const int row0 = u.pm * BM + wr * 64 + fr, col0 = u.pn * HALF + wc * 32 + 8 * fq;
#pragma unroll
        for (int ai = 0; ai < 2; ++ai)
#pragma unroll
            for (int m = 0; m < 4; ++m) { bf16_t* rowp = O + (size_t)(row0 + ai * HALF + m * 16) * 1024 + col0;
                f32x4 h0, h1;
#pragma unroll
                for (int i = 0; i < 4; ++i) { const float g0 = acc[ai][0][m][0][i], g1 = acc[ai][0][m][1][i];
                    h0[i] = g0 * sigmoidf_(g0) * acc[ai][1][m][0][i]; h1[i] = g1 * sigmoidf_(g1) * acc[ai][1][m][1][i]; }
                u32x4 w; w.x = cvt_pk_bf16(h0[0], h0[1]); w.y = cvt_pk_bf16(h0[2], h0[3]); w.z = cvt_pk_bf16(h1[0], h1[1]); w.w = cvt_pk_bf16(h1[2], h1[3]);
                __builtin_nontemporal_store(w, (u32x4*)rowp); }
    }
};
struct EpiResid {
    static constexpr bool PERM = false;
    const float* baseL; const float* baseC; float* outL; float* outC; const float* modv; int dummy;
    __device__ __forceinline__ void operator()(const f32x4 (&acc)[2][2][4][2], const Unit& u, int wr, int wc, int fr, int fq) const {
        const bool lat = u.pm < NTL / BM;
        const int rowt = (lat ? u.pm : u.pm - NTL / BM) * BM + wr * 64 + fr, col0 = u.pn * BM + wc * 32 + 4 * fq;
        const float* base = lat ? baseL : baseC; float* out = lat ? outL : outC;
        const int mr = lat ? (u.pm >> 4) : 8;
        const float* gp = modv + (size_t)mr * 6144 + 2048 + col0;
        f32x4 gv[2][2];
#pragma unroll
        for (int bj = 0; bj < 2; ++bj)
#pragma unroll
            for (int n = 0; n < 2; ++n) gv[bj][n] = *(const f32x4*)(gp + bj * HALF + n * 16);
#pragma unroll
        for (int ai = 0; ai < 2; ++ai)
#pragma unroll
            for (int m = 0; m < 4; ++m) { const size_t off = (size_t)(rowt + ai * HALF + m * 16) * DM + col0;
#pragma unroll
                for (int bj = 0; bj < 2; ++bj)
#pragma unroll
                    for (int n = 0; n < 2; ++n) { const f32x4 bs = *(const f32x4*)(base + off + bj * HALF + n * 16);
                        const f32x4 ov = bs + gv[bj][n] * acc[ai][bj][m][n]; if (!dummy || ov[0] == 12345.678f) *(f32x4*)(out + off + bj * HALF + n * 16) = ov; } }
    }
};
}

#define XB_TMO      128
#define XB_XCNT(j)  (256  + 64 * (j))
#define XB_XSUB(j)  (1280 + 64 * (j))
#define XB_XGEN(j)  (2304 + 64 * (j))
#define XB_TOP      3328
#define XB_TOPGEN   3392
#define XCD_BAR_WORDS 3456
#define XB_SPIN_CAP (1u << 20)
__device__ __forceinline__ unsigned xb_ld(unsigned* p)              { return __hip_atomic_load(p, __ATOMIC_RELAXED, __HIP_MEMORY_SCOPE_AGENT); }
__device__ __forceinline__ unsigned xb_add(unsigned* p, unsigned v) { return __hip_atomic_fetch_add(p, v, __ATOMIC_RELAXED, __HIP_MEMORY_SCOPE_AGENT); }
__device__ __forceinline__ unsigned xb_xcc_id() { return (unsigned)__builtin_amdgcn_s_getreg((3 << 11) | 20) & 0xFu; }
#define XB_SPIN(cond, bar) do { unsigned _sp = 0; while (cond) { __builtin_amdgcn_s_sleep(1); \
    if ((++_sp & 255u) == 0u) { if (xb_ld(&(bar)[XB_TMO])) break; if (_sp > XB_SPIN_CAP) { atomicAdd(&(bar)[XB_TMO], 1u); break; } } } } while (0)
struct XcdBarrier { unsigned* bar; unsigned x; volatile LAS unsigned* st; };
__device__ __forceinline__ XcdBarrier xcd_barrier_post(unsigned* bar, volatile LAS unsigned* st) {
    XcdBarrier b; b.bar = bar; b.x = xb_xcc_id(); b.st = st;
    if (threadIdx.x == 0) (void)xb_add(&bar[XB_XCNT(b.x)], 1u);
    return b;
}
__device__ __forceinline__ void xcd_barrier_complete(unsigned* bar, unsigned x, unsigned& nloc, unsigned& nx) {
    const unsigned G = gridDim.x * gridDim.y * gridDim.z;
    unsigned sum, cnt, mine, sp = 0u;
    for (;;) {
        sum = 0u; cnt = 0u; mine = 0u;
#pragma unroll
        for (unsigned j = 0; j < 16; ++j) { const unsigned c = xb_ld(&bar[XB_XCNT(j)]); sum += c; cnt += (c > 0u) ? 1u : 0u; mine = (j == x) ? c : mine; }
        if (sum == G) break;
        __builtin_amdgcn_s_sleep(1);
        if ((++sp & 255u) == 0u) { if (xb_ld(&bar[XB_TMO])) break; if (sp > XB_SPIN_CAP) { atomicAdd(&bar[XB_TMO], 1u); break; } }
    }
    nloc = mine > 0u ? mine : 1u; nx = cnt > 0u ? cnt : 1u;
}
__device__ __forceinline__ void xcd_barrier(const XcdBarrier& b) {
    asm volatile("s_waitcnt vmcnt(0)" ::: "memory");
    __syncthreads();
    if (threadIdx.x == 0) {
        unsigned* bar = b.bar;
        __builtin_amdgcn_s_waitcnt(0);
        unsigned nloc = b.st[0], nx = b.st[1];
        if (nloc == 0u) { xcd_barrier_complete(bar, b.x, nloc, nx); b.st[0] = nloc; b.st[1] = nx; }
        const unsigned old = xb_add(&bar[XB_XSUB(b.x)], 1u);
        const unsigned gen = old / nloc;
        if (old + 1u == (gen + 1u) * nloc) {
            __builtin_amdgcn_fence(__ATOMIC_RELEASE, "agent");
            asm volatile("s_waitcnt vmcnt(0)" ::: "memory");
            const unsigned og = xb_add(&bar[XB_TOP], 1u);
            const unsigned tg = og / nx;
            if (og + 1u == (tg + 1u) * nx) xb_add(&bar[XB_TOPGEN], 1u);
            else XB_SPIN(xb_ld(&bar[XB_TOPGEN]) == tg, bar);
            __builtin_amdgcn_fence(__ATOMIC_ACQUIRE, "agent");
            xb_add(&bar[XB_XGEN(b.x)], 1u);
            asm volatile("s_waitcnt vmcnt(0)" ::: "memory");
        } else {
            XB_SPIN(xb_ld(&bar[XB_XGEN(b.x)]) == gen, bar);
            __builtin_amdgcn_fence(__ATOMIC_ACQUIRE, "agent");
            asm volatile("s_waitcnt vmcnt(0)" ::: "memory");
        }
    }
    __syncthreads();
}

struct Args { const float* in[32]; float* out; unsigned char* ws; int ph_lo, ph_hi; };
enum { I_X = 0, I_C, I_CTX, I_CCTX, I_WMOD, I_BMOD, I_NMIX, I_NFFN, I_WIN, I_WOUT, I_SINK, I_MUP, I_MUN, I_W0, I_W2, I_A0, I_A2, I_V0, I_V1, I_V2, I_G2,
       I_KK, I_KA, I_RK, I_LNW, I_LNB, I_RW, I_RB, I_EG, I_EU, I_ED, I_FNG };

__device__ __forceinline__ void transpose_item(const float* W, int N, int k0, int n0, bf16* dst, int Kp, LAS float* scr, int lane) {
#pragma unroll 8
    for (int i = 0; i < 32; ++i) { const int kk = 2 * i + (lane >> 5); scr[kk * 33 + (lane & 31)] = __builtin_nontemporal_load(W + (size_t)(k0 + kk) * N + n0 + (lane & 31)); }
    asm volatile("s_waitcnt lgkmcnt(0)" ::: "memory");
    const int c = lane & 7;
#pragma unroll
    for (int j = 0; j < 4; ++j) { const int n = (lane >> 3) + 8 * j; const LAS float* s = scr + (8 * c) * 33 + n;
        u32x4 o; o.x = pk2(s[0 * 33], s[1 * 33]); o.y = pk2(s[2 * 33], s[3 * 33]); o.z = pk2(s[4 * 33], s[5 * 33]); o.w = pk2(s[6 * 33], s[7 * 33]);
        __builtin_nontemporal_store(o, (u32x4*)(dst + (size_t)n * Kp + k0 + 8 * c)); }
    asm volatile("s_waitcnt lgkmcnt(0)" ::: "memory");
}

__device__ __forceinline__ void ph_prologue(const Args& a, LAS unsigned char* lds, int tid, int lane, int wave) {
    const int gw = blockIdx.x * 8 + wave, NGW = gridDim.x * 8;
    unsigned char* ws = a.ws;
    LAS float* scr = (LAS float*)(lds + wave * 16384);
    bf16* WinT = (bf16*)(ws + WS_WIN); bf16* WoutT = (bf16*)(ws + WS_WOUT); bf16* WL = (bf16*)(ws + WS_WL);
    constexpr int I_IN = 16 * 84, I_OUT = 16 * 32, I_L = I_IN + I_OUT;
    for (int it = gw; it < 2 * I_L; it += NGW) {
        const int l = it / I_L; int r = it % I_L;
        if (r < I_IN) { const int kb = r / 84, nb = r % 84; transpose_item(a.in[I_WIN] + (size_t)l * DM * INC, INC, kb * 64, nb * 32, WinT + ((size_t)l * INCP + nb * 32) * DM, DM, scr, lane); }
        else { r -= I_IN; const int kb = r / 32, nb = r % 32; transpose_item(a.in[I_WOUT] + (size_t)l * DM * DM, DM, kb * 64, nb * 32, WoutT + ((size_t)l * DM + nb * 32) * DM, DM, scr, lane); }
    }
    for (int i = blockIdx.x * 512 + tid; i < 2 * 128 * DM / 8; i += gridDim.x * 512) { const int l = i / (128 * DM / 8), r = i % (128 * DM / 8);
        *(u32x4*)(WinT + ((size_t)l * INCP + INC) * DM + (size_t)r * 8) = (u32x4){0u, 0u, 0u, 0u}; }
    for (int i = blockIdx.x * 512 + tid; i < 2 * LWC * 128; i += gridDim.x * 512) {
        const int l = i / (LWC * 128), r = i % (LWC * 128), n = r >> 7, k = r & 127; float v = 0.f;
        if (n < 1024) { const int dir = n >> 9, c = n & 511; if ((k >> 6) == dir) v = a.in[I_W2][((size_t)(l * 2 + dir) * 64 + (k & 63)) * 512 + c]; }
        else if (n < 2048) { const int n2 = n - 1024, dir = n2 >> 9, c = n2 & 511; if ((k >> 6) == dir) v = a.in[I_A2][((size_t)(l * 2 + dir) * 64 + (k & 63)) * 512 + c]; }
        else { const int c = n - 2048; v = a.in[I_G2][((size_t)l * 128 + k) * 512 + c]; }
        WL[i] = (bf16)f2bf(v);
    }
    __syncthreads();
    {
        LAS float* sc = (LAS float*)lds; LAS float* red = (LAS float*)(lds + 9 * 1024 * 4);
        float* modv = (float*)(ws + WS_MODV);
        for (int idx = tid; idx < 9 * 1024; idx += 512) { const int r = idx >> 10, k = idx & 1023; const float cv = r < 8 ? a.in[I_C][r * 1024 + k] : a.in[I_CCTX][k]; sc[idx] = cv / (1.0f + __expf(-cv)); }
        __syncthreads();
        for (int it = blockIdx.x; it < 192; it += gridDim.x) {
            const int l = it / 96, n0 = (it % 96) * 64;
            float acc[9];
#pragma unroll
            for (int r = 0; r < 9; ++r) acc[r] = 0.f;
            const float* wp = a.in[I_WMOD] + ((size_t)l * 1024 + wave * 128) * 6144 + n0 + lane;
#pragma unroll 4
            for (int kk = 0; kk < 128; ++kk) { const float wv = wp[(size_t)kk * 6144];
#pragma unroll
                for (int r = 0; r < 9; ++r) acc[r] += sc[r * 1024 + wave * 128 + kk] * wv; }
#pragma unroll
            for (int r = 0; r < 9; ++r) red[(wave * 9 + r) * 64 + lane] = acc[r];
            __syncthreads();
            for (int idx = tid; idx < 576; idx += 512) { const int r = idx >> 6, ln = idx & 63; float s = a.in[I_BMOD][l * 6144 + n0 + ln];
#pragma unroll
                for (int w = 0; w < 8; ++w) s += red[(w * 9 + r) * 64 + ln];
                modv[((size_t)l * 9 + r) * 6144 + n0 + ln] = s; }
            __syncthreads();
        }
    }
}

constexpr int CV_ITEMS = 3 * 16 * 512, CV_EARLY = 8192;
__device__ __forceinline__ void convert_experts(const Args& a, int l, LAS unsigned char* lds, int lane, int wave, int it0, int it1, int wrk, int nwrk) {
    LAS float* scr = (LAS float*)(lds + wave * 16384);
    bf16* WEgu = (bf16*)(a.ws + WS_WE); bf16* WEd = WEgu + (size_t)16 * 2048 * 1024;
    for (int it = it0 + wrk; it < it1; it += nwrk) {
        const int mat = it / 8192, r = it % 8192, e = r >> 9, kb = (r >> 5) & 15, nb = r & 31, n0 = nb * 32;
        const float* W = a.in[I_EG + mat] + ((size_t)(l * 16 + e) << 20);
        bf16* dst = mat < 2 ? WEgu + ((size_t)e * 2048 + (n0 >> 7) * 256 + (n0 & 127) + mat * 128) * 1024 : WEd + ((size_t)e * 1024 + n0) * 1024;
        transpose_item(W, 1024, kb * 64, n0, dst, 1024, scr, lane);
    }
}

__device__ __forceinline__ void norm_mod_store(const f32x4 (&v)[4], const float* g, const float* sc, const float* sh, bf16* orow, int lane, f32x4 (&hout)[4], bool dostore = true) {
    float ss = 0.f;
#pragma unroll
    for (int j = 0; j < 4; ++j) ss += (v[j].x * v[j].x + v[j].y * v[j].y) + (v[j].z * v[j].z + v[j].w * v[j].w);
    const float rms = rsqrtf(wave_sum(ss) * (1.0f / DM) + 1e-6f);
#pragma unroll
    for (int j = 0; j < 4; ++j) { const int c = 4 * (lane + 64 * j);
        const f32x4 gg = *(const f32x4*)(g + c), s1 = *(const f32x4*)(sc + c), s0 = *(const f32x4*)(sh + c);
        const f32x4 h = (v[j] * rms * gg) * (s1 + 1.0f) + s0; hout[j] = h;
        u32x2 w; w.x = pk2(h.x, h.y); w.y = pk2(h.z, h.w); if (dostore || h.x == 12345.678f) *(u32x2*)(orow + c) = w; }
}

__device__ __forceinline__ void ph_norm1_l0(const Args& a, int lane, int wave) {
    const int gw = blockIdx.x * 8 + wave, NGW = gridDim.x * 8;
    const float* modv = (const float*)(a.ws + WS_MODV); bf16* H = (bf16*)(a.ws + WS_H);
    for (int row = gw; row < NT; row += NGW) {
        const float* src = row < NTL ? a.in[I_X] + (size_t)row * DM : a.in[I_CTX] + (size_t)(row - NTL) * DM;
        const int mr = row < NTL ? (row >> 12) : 8;
        f32x4 v[4], h[4];
#pragma unroll
        for (int j = 0; j < 4; ++j) v[j] = *(const f32x4*)(src + 4 * (lane + 64 * j));
        norm_mod_store(v, a.in[I_NMIX], modv + (size_t)mr * 6144 + 1024, modv + (size_t)mr * 6144, H + (size_t)row * DM, lane, h);
    }
}

__device__ __forceinline__ void ph_postproj(const Args& a, int l, LAS unsigned char* lds, int tid, int lane, int wave) {
    LAS bf16* vtl = (LAS bf16*)lds;
    LAS bf16* ktl = (LAS bf16*)(lds + 107520);
    LAS bf16* v1T = (LAS bf16*)(lds + 8192); LAS bf16* v2P = (LAS bf16*)(lds + 41472); LAS bf16* VT = (LAS bf16*)(lds + 74240);
    unsigned char* ws = a.ws;
    const bf16* P = (const bf16*)(ws + WS_P);
    bf16* Qr = (bf16*)(ws + WS_QR); bf16* Kr = (bf16*)(ws + WS_KR); bf16* Vt = (bf16*)(ws + WS_VT); bf16* AP = (bf16*)(ws + WS_AP);
    bf16* Rb = (bf16*)(ws + WS_R); bf16* Kb = (bf16*)(ws + WS_K); bf16* V0 = (bf16*)(ws + WS_V0); bf16* Vb = l == 0 ? V0 : (bf16*)(ws + WS_V1);
    const int c0 = lane * 8;
    const u32x4 zero4 = (u32x4){0u, 0u, 0u, 0u};
    u32x4 wp[4], wc[4], wn[4], rq, rk, rv;
#define PP_LOAD_FIRST(tile_) do { const int rowb_ = (tile_) * 32 + wave * 4; const int tb_ = rowb_ >= NTL ? ((rowb_ - NTL) & 255) : (rowb_ & 4095); const bf16* pr0 = P + (size_t)rowb_ * INCP; \
      _Pragma("unroll") for (int j = 0; j < 4; ++j) { const int cg = 768 + j * 512 + c0; const bool act = (j < 3) || (lane < 48); \
          wc[j] = act ? *(const u32x4*)(pr0 + cg) : zero4; wp[j] = (act && tb_ > 0) ? *(const u32x4*)(pr0 - INCP + cg) : zero4; wn[j] = act ? *(const u32x4*)(pr0 + INCP + cg) : zero4; } \
      rq = *(const u32x4*)(pr0 + c0); rk = *(const u32x4*)(pr0 + 512 + (lane & 15) * 8); rv = *(const u32x4*)(pr0 + 640 + (lane & 15) * 8); } while (0)
    if (blockIdx.x < NT / 32) PP_LOAD_FIRST(blockIdx.x);
    if (l > 0) {
        const float* v1 = a.in[I_V1] + (size_t)(l - 1) * 512 * 32; const float* v2 = a.in[I_V2] + (size_t)(l - 1) * 32 * 512;
        for (int idx = tid; idx < 16384; idx += 512) { const int c = idx >> 5, j = idx & 31; v1T[j * 520 + c] = (bf16)f2bf(v1[idx]); }
        for (int idx = tid; idx < 16384; idx += 512) { const int j = idx >> 9, c = idx & 511;
            v2P[c * 32 + ((((j >> 4) * 2 + ((j >> 2) & 1)) * 8) + 4 * ((j >> 3) & 1) + (j & 3))] = (bf16)f2bf(v2[idx]); }
        __syncthreads();
    }
    float* KN = (float*)(ws + WS_KN);
    float kkp[8];
#pragma unroll
    for (int i = 0; i < 8; ++i) kkp[i] = a.in[I_KK][l * 512 + c0 + i];
    float mp[4][8], mn[4][8], vz[8];
    { const float* mup = a.in[I_MUP] + l * 1920; const float* mun = a.in[I_MUN] + l * 1920;
#pragma unroll
      for (int j = 0; j < 4; ++j) { const int cg = j * 512 + c0; const bool act = (j < 3) || (lane < 48);
#pragma unroll
          for (int i = 0; i < 8; ++i) { mp[j][i] = act ? mup[cg + i] : 0.f; mn[j][i] = act ? mun[cg + i] : 0.f; } }
#pragma unroll
      for (int i = 0; i < 8; ++i) vz[i] = l > 0 ? a.in[I_V0][(size_t)(l - 1) * 512 + c0 + i] : 0.f; }
    const int fbase = 8 * (lane & 1), axis = (lane >> 2) & 1, second = (lane >> 1) & 1;
    LAS float* rct = (LAS float*)(lds + 116224); LAS float* rst = (LAS float*)(lds + 120320);
    for (int idx = tid; idx < 1024; idx += 512) { const float ang = (float)(idx >> 4) * exp2f(-(float)(idx & 15) * (13.287712379549449f / 16.0f)); rct[idx] = __cosf(ang); rst[idx] = __sinf(ang); }
    __syncthreads();
    const float QSCALE = 0.125f * 1.4426950408889634f;
    for (int tile = blockIdx.x; tile < NT / 32; tile += gridDim.x) {
    const int rowb = tile * 32 + wave * 4;
    const bool isctx = rowb >= NTL; int tb, len;
    if (!isctx) { tb = rowb & 4095; len = SEQ; } else { tb = (rowb - NTL) & 255; len = CTXL; }
#pragma unroll 1
    for (int rr = 0; rr < 4; ++rr) {
        const int tl = wave * 4 + rr, row = rowb + rr;
        const int t = tb + rr;
        u32x4 nn[4], nq = zero4, nk = zero4, nv = zero4;
        { const bf16* pr2 = P + (size_t)(row + 2) * INCP; const bool ok2 = rr < 3 && (t + 2 < len);
#pragma unroll
          for (int j = 0; j < 4; ++j) { const int cg = 768 + j * 512 + c0; const bool act = (j < 3) || (lane < 48); nn[j] = (act && ok2) ? *(const u32x4*)(pr2 + cg) : zero4; }
          if (rr < 3) { const bf16* pr1 = P + (size_t)(row + 1) * INCP;
              nq = *(const u32x4*)(pr1 + c0); nk = *(const u32x4*)(pr1 + 512 + (lane & 15) * 8); nv = *(const u32x4*)(pr1 + 640 + (lane & 15) * 8); } }
        u32x4 rc[4], rp[4], rn[4];
#pragma unroll
        for (int j = 0; j < 4; ++j) { rc[j] = wc[j]; rp[j] = wp[j]; rn[j] = wn[j]; }
        __builtin_amdgcn_sched_barrier(0);
        float cs[8], sn[8];
        { const int pi = (axis ? (t & 63) : (t >> 6)) * 16 + fbase;
          const f32x4 c0v = *(const LAS f32x4*)(rct + pi), c1v = *(const LAS f32x4*)(rct + pi + 4), s0v = *(const LAS f32x4*)(rst + pi), s1v = *(const LAS f32x4*)(rst + pi + 4);
          cs[0] = c0v.x; cs[1] = c0v.y; cs[2] = c0v.z; cs[3] = c0v.w; cs[4] = c1v.x; cs[5] = c1v.y; cs[6] = c1v.z; cs[7] = c1v.w;
          sn[0] = s0v.x; sn[1] = s0v.y; sn[2] = s0v.z; sn[3] = s0v.w; sn[4] = s1v.x; sn[5] = s1v.y; sn[6] = s1v.z; sn[7] = s1v.w; }
        { float q[8], pq[8]; unpack8(rq, q);
#pragma unroll
          for (int i = 0; i < 8; ++i) pq[i] = xor2_(q[i]);
          if (!isctx) {
#pragma unroll
              for (int i = 0; i < 8; ++i) q[i] = second ? (q[i] * cs[i] + pq[i] * sn[i]) : (q[i] * cs[i] - pq[i] * sn[i]); }
#pragma unroll
          for (int i = 0; i < 8; ++i) q[i] *= QSCALE;
          *(u32x4*)(Qr + (size_t)row * 512 + c0) = pack8(q); }
        { float k[8], pk[8];
          unpack8(rk, k);
#pragma unroll
          for (int i = 0; i < 8; ++i) pk[i] = xor2_(k[i]);
          if (!isctx) {
#pragma unroll
              for (int i = 0; i < 8; ++i) k[i] = second ? (k[i] * cs[i] + pk[i] * sn[i]) : (k[i] * cs[i] - pk[i] * sn[i]); }
          if (lane < 16) {
              *(LAS u32x4*)(ktl + tl * 136 + c0) = pack8(k);
              LAS bf16* vp = vtl + c0 * 32 + tl;
              vp[0 * 32] = (bf16)(rv.x & 0xffffu); vp[1 * 32] = (bf16)(rv.x >> 16); vp[2 * 32] = (bf16)(rv.y & 0xffffu); vp[3 * 32] = (bf16)(rv.y >> 16);
              vp[4 * 32] = (bf16)(rv.z & 0xffffu); vp[5 * 32] = (bf16)(rv.z >> 16); vp[6 * 32] = (bf16)(rv.w & 0xffffu); vp[7 * 32] = (bf16)(rv.w >> 16);
          } }
        float vv[8];
#pragma unroll
        for (int j = 0; j < 4; ++j) {
            float u[8], cur[8], pv[8], nx[8];
            unpack8(rc[j], cur); unpack8(rp[j], pv); unpack8(rn[j], nx);
#pragma unroll
            for (int i = 0; i < 8; ++i) u[i] = cur[i] + mp[j][i] * (pv[i] - cur[i]) + mn[j][i] * (nx[i] - cur[i]);
            if (j == 0) *(u32x4*)(Rb + (size_t)row * 512 + c0) = pack8(u);
            else if (j == 1) { const u32x4 kw = pack8(u); *(u32x4*)(Kb + (size_t)row * 512 + c0) = kw;
                float kq[8]; unpack8(kw, kq); float ss = 0.f;
#pragma unroll
                for (int i = 0; i < 8; ++i) { const float t = kq[i] * kkp[i]; ss += t * t; }
                ss = sum8_(ss);
                if ((lane & 7) == 0) KN[(size_t)row * 8 + (lane >> 3)] = __builtin_amdgcn_rsqf(fmaxf(ss, 1e-24f)); }
            else if (j == 2) {
#pragma unroll
                for (int i = 0; i < 8; ++i) vv[i] = u[i];
            } else if (lane < 48) {
                if (lane < 16) {
#pragma unroll
                    for (int i = 0; i < 8; ++i) { const float e2 = __expf(2.0f * u[i]); u[i] = 1.0f - 2.0f * __builtin_amdgcn_rcpf(e2 + 1.0f); }
                } else if (lane >= 32) {
#pragma unroll
                    for (int i = 0; i < 8; ++i) u[i] = sigmoidf_(u[i]);
                }
                *(u32x4*)(AP + (size_t)row * APC + c0) = pack8(u);
            }
        }
        if (l > 0) *(LAS u32x4*)(VT + tl * 520 + c0) = pack8(vv);
        else *(u32x4*)(Vb + (size_t)row * 512 + c0) = pack8(vv);
#pragma unroll
        for (int j = 0; j < 4; ++j) { wp[j] = wc[j]; wc[j] = wn[j]; wn[j] = nn[j]; }
        rq = nq; rk = nk; rv = nv;
    }
        if (tile + (int)gridDim.x < NT / 32) PP_LOAD_FIRST(tile + (int)gridDim.x);
        if (l > 0) {
            const int l31 = lane & 31, hh = lane >> 5;
            u32x2 fwv[2][4];
#pragma unroll
            for (int ci = 0; ci < 2; ++ci)
#pragma unroll
                for (int g = 0; g < 4; ++g) fwv[ci][g] = *(const u32x2*)(V0 + (size_t)(tile * 32 + l31) * 512 + 32 * (2 * wave + ci) + 8 * g + 4 * hh);
            __syncthreads();
            f32x16 t1;
#pragma unroll
            for (int i = 0; i < 16; ++i) t1[i] = 0.f;
#pragma unroll 8
            for (int ks = 0; ks < 32; ++ks) t1 = __builtin_amdgcn_mfma_f32_32x32x16_bf16(*(const LAS bf16x8*)(v1T + l31 * 520 + 16 * ks + 8 * hh), *(const LAS bf16x8*)(VT + l31 * 520 + 16 * ks + 8 * hh), t1, 0, 0, 0);
            bf16x8 tb[2];
#pragma unroll
            for (int sI = 0; sI < 2; ++sI) { u32x4 w; w.x = pk2(t1[8 * sI + 0], t1[8 * sI + 1]); w.y = pk2(t1[8 * sI + 2], t1[8 * sI + 3]); w.z = pk2(t1[8 * sI + 4], t1[8 * sI + 5]); w.w = pk2(t1[8 * sI + 6], t1[8 * sI + 7]); tb[sI] = __builtin_bit_cast(bf16x8, w); }
            const int row0 = tile * 32;
            __syncthreads();
#pragma unroll
            for (int ci = 0; ci < 2; ++ci) {
                const int ct = 2 * wave + ci;
                f32x16 z;
#pragma unroll
                for (int i = 0; i < 16; ++i) z[i] = 0.f;
#pragma unroll
                for (int sI = 0; sI < 2; ++sI) z = __builtin_amdgcn_mfma_f32_32x32x16_bf16(*(const LAS bf16x8*)(v2P + (32 * ct + l31) * 32 + (sI * 2 + hh) * 8), tb[sI], z, 0, 0, 0);
#pragma unroll
                for (int g = 0; g < 4; ++g) { const int c = 32 * ct + 8 * g + 4 * hh;
                    const f32x4 zb = *(const f32x4*)(a.in[I_V0] + (size_t)(l - 1) * 512 + c);
                    LAS u32x2* vp = (LAS u32x2*)(VT + l31 * 520 + c); const u32x2 vw = *vp, fw = fwv[ci][g];
                    const float v0_ = bflo(vw.x), v1_ = bfhi(vw.x), v2_ = bflo(vw.y), v3_ = bfhi(vw.y), f0 = bflo(fw.x), f1 = bfhi(fw.x), f2 = bflo(fw.y), f3 = bfhi(fw.y);
                    u32x2 ow; ow.x = pk2(v0_ + (f0 - v0_) * sigmoidf_(z[4 * g] + zb.x), v1_ + (f1 - v1_) * sigmoidf_(z[4 * g + 1] + zb.y));
                    ow.y = pk2(v2_ + (f2 - v2_) * sigmoidf_(z[4 * g + 2] + zb.z), v3_ + (f3 - v3_) * sigmoidf_(z[4 * g + 3] + zb.w)); *vp = ow; }
            }
            __syncthreads();
#pragma unroll
            for (int rr = 0; rr < 4; ++rr) { const int tl = wave * 4 + rr; *(u32x4*)(Vb + (size_t)(row0 + tl) * 512 + c0) = *(const LAS u32x4*)(VT + tl * 520 + c0); }
        }
        __syncthreads();
        { const int row0 = tile * 32; const bool isctx = row0 >= NTL; int b, pt;
          if (!isctx) { b = row0 >> 12; pt = (CTXL + (row0 & 4095)) >> 5; } else { const int r2 = row0 - NTL; b = r2 >> 8; pt = (r2 & 255) >> 5; }
          const int hk = tid >> 8, f = (tid >> 6) & 3, ln = tid & 63, l31 = ln & 31, lh = ln >> 5;
          const size_t toff = ((size_t)((b * 2 + hk) * 136 + pt)) * 2048 + (size_t)(f * 64 + ln) * 8;
          *(u32x4*)(Kr + toff) = *(const LAS u32x4*)(ktl + l31 * 136 + hk * 64 + 16 * f + 8 * lh);
          const LAS bf16* vp = vtl + (hk * 64 + (f >> 1) * 32 + l31) * 32 + 16 * (f & 1) + 4 * lh;
          const u32x2 lo = *(const LAS u32x2*)vp, hi2 = *(const LAS u32x2*)(vp + 8);
          *(u32x4*)(Vt + toff) = (u32x4){lo.x, lo.y, hi2.x, hi2.y}; }
        __syncthreads();
    }
#undef PP_LOAD_FIRST
}

__device__ __forceinline__ bf16x8 ld_bf16x8(const bf16* p) { return *(const bf16x8*)p; }
struct AttnFrag { bf16x8 kf[4]; };
__device__ __forceinline__ void attn_load(AttnFrag& F, const bf16* ktile, int lane) {
#pragma unroll
    for (int s = 0; s < 4; ++s) F.kf[s] = ld_bf16x8(ktile + (s * 64 + lane) * 8);
}
__device__ __forceinline__ void attn_compute(f32x16 (&o)[2][2], float (&m)[2], float (&ls)[2], const bf16x8 (&qf)[2][4], const AttnFrag& F, const bf16* vtile  ,
                                             bool masked, int kj0, int qi0, int lane, int r32, int hi) {
    bf16x8 vf[2][2];
#pragma unroll
    for (int dt = 0; dt < 2; ++dt)
#pragma unroll
        for (int s2 = 0; s2 < 2; ++s2) vf[dt][s2] = ld_bf16x8(vtile + ((dt * 2 + s2) * 64 + lane) * 8);
#pragma unroll
    for (int qt = 0; qt < 2; ++qt) {
        f32x16 s;
        { const float nm = -m[qt];
#pragma unroll
          for (int i = 0; i < 16; ++i) s[i] = nm; }
        __builtin_amdgcn_s_setprio(1);
#pragma unroll
        for (int ks = 0; ks < 4; ++ks) s = __builtin_amdgcn_mfma_f32_32x32x16_bf16(F.kf[ks], qf[qt][ks], s, 0, 0, 0);
        __builtin_amdgcn_s_setprio(0);
        if (masked && ((kj0 + 31) - (qi0 + qt * 32) > 128 || kj0 - (qi0 + qt * 32 + 31) < -128)) {
            const int qi = qi0 + qt * 32 + r32;
#pragma unroll
            for (int i = 0; i < 16; ++i) { const int kj = kj0 + (i & 3) + 8 * (i >> 2) + 4 * hi; const int d = kj - qi; s[i] = (d <= 128 && d >= -128) ? s[i] : -1e30f; } }
        float tm = s[0];
#pragma unroll
        for (int i = 1; i < 16; ++i) tm = fmaxf(tm, s[i]);
        { float ra_, rb_; swap32(tm, tm, ra_, rb_); tm = fmaxf(ra_, rb_); }
        if (!__all(tm <= 8.0f)) {
            const float d = fmaxf(tm, 0.f), alpha = __builtin_amdgcn_exp2f(-d);
            m[qt] += d; ls[qt] *= alpha;
#pragma unroll
            for (int dt = 0; dt < 2; ++dt)
#pragma unroll
                for (int i = 0; i < 16; ++i) o[qt][dt][i] *= alpha;
#pragma unroll
            for (int i = 0; i < 16; ++i) s[i] -= d;
        }
        float ps = 0.f; float p[16];
#pragma unroll
        for (int i = 0; i < 16; ++i) { p[i] = __builtin_amdgcn_exp2f(s[i]); ps += p[i]; }
        ls[qt] += ps;
        bf16x8 pf[2];
#pragma unroll
        for (int s2 = 0; s2 < 2; ++s2) { u32x4 w; w.x = pk2(p[8 * s2 + 0], p[8 * s2 + 1]); w.y = pk2(p[8 * s2 + 2], p[8 * s2 + 3]); w.z = pk2(p[8 * s2 + 4], p[8 * s2 + 5]); w.w = pk2(p[8 * s2 + 6], p[8 * s2 + 7]); pf[s2] = __builtin_bit_cast(bf16x8, w); }
        __builtin_amdgcn_s_setprio(1);
#pragma unroll
        for (int dt = 0; dt < 2; ++dt)
#pragma unroll
            for (int s2 = 0; s2 < 2; ++s2) o[qt][dt] = __builtin_amdgcn_mfma_f32_32x32x16_bf16(vf[dt][s2], pf[s2], o[qt][dt], 0, 0, 0);
        __builtin_amdgcn_s_setprio(0);
    }
}

__device__ __forceinline__ void ph_attention(const Args& a, int l, int lane, int wave) {
    unsigned char* ws = a.ws;
    const bf16* Qr = (const bf16*)(ws + WS_QR); const bf16* Kr = (const bf16*)(ws + WS_KR); const bf16* Vt = (const bf16*)(ws + WS_VT); bf16* H = (bf16*)(ws + WS_H);
    const bool redeal = l == 0 && gridDim.x == 256;
    const int nunits = 512 + ((l == 0 && !redeal) ? 32 : 0);
    const int nmain = (nunits - (int)blockIdx.x + (int)gridDim.x - 1) / (int)gridDim.x, nextra = (redeal && (blockIdx.x & 1) && wave == 7) ? 2 : 0;
    const int r32 = lane & 31, hi = lane >> 5;
    for (int it = 0; it < nmain + nextra; ++it) {
        int un, g, qh;
        if (it < nmain) { un = blockIdx.x + it * gridDim.x; g = wave >> 1; qh = wave & 1; }
        else { const int j = (blockIdx.x >> 1) * 2 + (it - nmain); un = 512 + (j >> 3); g = (j >> 1) & 3; qh = j & 1; }
        const bool cq = un >= 512; int b, hkv, n;
        if (!cq) { const int xg = un & 7, rk = un >> 3, pair = xg * 2 + (rk >> 5); b = pair >> 1; hkv = pair & 1; n = rk & 31; } else { const int u2 = un - 512; b = u2 >> 2; hkv = (u2 >> 1) & 1; n = u2 & 1; }
        const int hq = hkv * 4 + g;
        const int qrow0 = (cq ? NTL + b * CTXL : b * SEQ) + n * 128 + qh * 64;
        bf16x8 qf[2][4];
#pragma unroll
        for (int qt = 0; qt < 2; ++qt)
#pragma unroll
            for (int s = 0; s < 4; ++s) qf[qt][s] = ld_bf16x8(Qr + (size_t)(qrow0 + qt * 32 + r32) * 512 + hq * 64 + 16 * s + 8 * hi);
        f32x16 o[2][2];
#pragma unroll
        for (int qt = 0; qt < 2; ++qt)
#pragma unroll
            for (int dt = 0; dt < 2; ++dt)
#pragma unroll
                for (int i = 0; i < 16; ++i) o[qt][dt][i] = 0.f;
        float m[2], ls[2];
        const float sk = a.in[I_SINK][l * 8 + hq] * 1.4426950408889634f;
        m[0] = sk; m[1] = sk; ls[0] = hi == 0 ? 1.0f : 0.0f; ls[1] = ls[0];
        int jmin = 2 * qh, jmax = 2 * qh + 10;
        if (!cq) { const int lo = 4 - 4 * n, hi2 = (SEQ + 128 - 128 * n) / 32; jmin = jmin > lo ? jmin : lo; jmax = jmax < hi2 ? jmax : hi2; } else { jmax = jmin; }
        const int nw = jmax - jmin, T = nw + 8;
        const size_t hbase = (size_t)((b * 2 + hkv) * 136) * 2048;
        const int wt0 = 4 + 4 * n + jmin;
        AttnFrag F0, F1;
#define ATT_TI(t) ((t) < nw ? wt0 + (t) : (t) - nw)
#define ATT_LOAD(F, t) attn_load(F, Kr + hbase + (size_t)ATT_TI(t) * 2048, lane)
#define ATT_VB(t) (Vt + hbase + (size_t)ATT_TI(t) * 2048)
        ATT_LOAD(F0, 0);
        for (int t = 0; t < T; t += 2) {
            ATT_LOAD(F1, t + 1);
            attn_compute(o, m, ls, qf, F0, ATT_VB(t), t < nw, -128 + 32 * (jmin + t), qh * 64, lane, r32, hi);
            if (t + 2 < T) ATT_LOAD(F0, t + 2);
            attn_compute(o, m, ls, qf, F1, ATT_VB(t + 1), t + 1 < nw, -128 + 32 * (jmin + t + 1), qh * 64, lane, r32, hi);
        }
#undef ATT_TI
#undef ATT_VB
#undef ATT_LOAD
#pragma unroll
        for (int qt = 0; qt < 2; ++qt) {
            float lt; { float ra_, rb_; swap32(ls[qt], ls[qt], ra_, rb_); lt = ra_ + rb_; } const float inv = 1.0f / lt;
            bf16* orow = H + (size_t)(qrow0 + qt * 32 + r32) * DM + hq * 64;
#pragma unroll
            for (int dt = 0; dt < 2; ++dt)
#pragma unroll
                for (int g4 = 0; g4 < 4; ++g4) { u32x2 w; w.x = pk2(o[qt][dt][4 * g4 + 0] * inv, o[qt][dt][4 * g4 + 1] * inv); w.y = pk2(o[qt][dt][4 * g4 + 2] * inv, o[qt][dt][4 * g4 + 3] * inv);
                    *(u32x2*)(orow + dt * 32 + 8 * g4 + 4 * hi) = w; }
        }
    }
}

constexpr int SG = 4;
constexpr int SVEC = 384;
constexpr int SCAN_WLDS = SG * SVEC * 4;
struct ScanRaw { unsigned short kx[SG], rx[SG], ax[SG], wx[SG], vx[SG]; float rn[SG]; };

__device__ __forceinline__ void scan_load(const Args& a, int l, int b, int h, int dir, int s0, ScanRaw& R, int lane) {
    const __amdgpu_buffer_rsrc_t rR = __builtin_amdgcn_make_buffer_rsrc((void*)(a.ws + WS_R), 0, 0x7ffffffe, 0x00020000), rK = __builtin_amdgcn_make_buffer_rsrc((void*)(a.ws + WS_K), 0, 0x7ffffffe, 0x00020000);
    const __amdgpu_buffer_rsrc_t rV = __builtin_amdgcn_make_buffer_rsrc((void*)(a.ws + (l == 0 ? WS_V0 : WS_V1)), 0, 0x7ffffffe, 0x00020000), rW = __builtin_amdgcn_make_buffer_rsrc((void*)(a.ws + WS_P), 0, 0x7ffffffe, 0x00020000);
    const float* KN = (const float*)(a.ws + WS_KN);
    const int vo = (h * 64 + lane) * 2;
#pragma unroll
    for (int gi = 0; gi < SG; ++gi) {
        const int s = s0 + gi, pos = dir == 0 ? s : (s < CTXL ? CTXL - 1 - s : POSN + CTXL - 1 - s), row = row_of(b, pos);
        const int o5 = row * 1024, ol = row * (LWC * 2) + dir * 1024;
        R.kx[gi] = __builtin_amdgcn_raw_buffer_load_b16(rK, vo, o5, 0); R.rx[gi] = __builtin_amdgcn_raw_buffer_load_b16(rR, vo, o5, 0); R.vx[gi] = __builtin_amdgcn_raw_buffer_load_b16(rV, vo, o5, 0);
        R.wx[gi] = __builtin_amdgcn_raw_buffer_load_b16(rW, vo, ol, 0); R.ax[gi] = __builtin_amdgcn_raw_buffer_load_b16(rW, vo, ol + 2048, 0); R.rn[gi] = KN[row * 8 + h];
    }
}
__device__ __forceinline__ void scan_write(const ScanRaw& R, float kkw, float kaw, float w0b, float a0b, LAS float* wl, int lane, float& gam, bool last_of_16) {
#pragma unroll
    for (int gi = 0; gi < SG; ++gi) {
        const float kxf = bf2f(R.kx[gi]);
        const float wv = __expf(-0.60653066f * sigmoidf_(bf2f(R.wx[gi]) + w0b)), av = sigmoidf_(bf2f(R.ax[gi]) + a0b);
        const float kk = kxf * kkw * R.rn[gi];
        const float kd = kxf * (1.0f + (av - 1.0f) * kaw), bb = kk * av;
        const float kks = kk * gam;
        gam *= wv;
        const float ig = __builtin_amdgcn_rcpf(gam);
        LAS float* p = wl + gi * SVEC + lane;
        const float rf = bf2f(R.rx[gi]);
        p[0] = gam; p[64] = __builtin_bit_cast(float, pk2(kd * ig, bb * ig)); p[128] = kks; p[256] = rf * gam; p[320] = bf2f(R.vx[gi]);
        LAS bf16* fr = (LAS bf16*)(wl + gi * SVEC + 192);
        const int fo = ((((lane >> 5) * 2 + ((lane >> 4) & 1)) * 2 + ((lane >> 2) & 1)) * 8) + 4 * ((lane >> 3) & 1) + (lane & 3);
        fr[fo] = f2bf1((last_of_16 && gi == SG - 1) ? rf : rf * gam); fr[64 + fo] = f2bf1(kks);
    }
    if (last_of_16) gam = 1.0f;
}
__device__ __forceinline__ void fmac_(float& acc, float x, float y) { asm("v_fmac_f32 %0, %1, %2" : "+v"(acc) : "v"(x), "v"(y)); }
__device__ __forceinline__ float fma_(float x, float y, float z) { float d; asm("v_fma_f32 %0, %1, %2, %3" : "=v"(d) : "v"(x), "v"(y), "v"(z)); return d; }
__device__ __forceinline__ float mul_(float x, float y) { float d; asm("v_mul_f32 %0, %1, %2" : "=v"(d) : "v"(x), "v"(y)); return d; }
__device__ __forceinline__ void dot4_(float& acc, float s0, float s1, float s2, float s3, f32x4 k) {
    asm("v_fmac_f32 %0, %1, %5\n\tv_fmac_f32 %0, %2, %6\n\tv_fmac_f32 %0, %3, %7\n\tv_fmac_f32 %0, %4, %8"
        : "+v"(acc) : "v"(s0), "v"(s1), "v"(s2), "v"(s3), "v"(k.x), "v"(k.y), "v"(k.z), "v"(k.w));
}
__device__ __forceinline__ void dot4x4_(float& a0, float& a1, float& a2, float& a3, const float* s0, const float* s1, const float* s2, const float* s3, f32x4 k) {
    asm("v_fmac_f32 %0, %4, %20\n\tv_fmac_f32 %1, %8, %20\n\tv_fmac_f32 %2, %12, %20\n\tv_fmac_f32 %3, %16, %20\n\t"
        "v_fmac_f32 %0, %5, %21\n\tv_fmac_f32 %1, %9, %21\n\tv_fmac_f32 %2, %13, %21\n\tv_fmac_f32 %3, %17, %21\n\t"
        "v_fmac_f32 %0, %6, %22\n\tv_fmac_f32 %1, %10, %22\n\tv_fmac_f32 %2, %14, %22\n\tv_fmac_f32 %3, %18, %22\n\t"
        "v_fmac_f32 %0, %7, %23\n\tv_fmac_f32 %1, %11, %23\n\tv_fmac_f32 %2, %15, %23\n\tv_fmac_f32 %3, %19, %23"
        : "+v"(a0), "+v"(a1), "+v"(a2), "+v"(a3)
        : "v"(s0[0]), "v"(s0[1]), "v"(s0[2]), "v"(s0[3]), "v"(s1[0]), "v"(s1[1]), "v"(s1[2]), "v"(s1[3]),
          "v"(s2[0]), "v"(s2[1]), "v"(s2[2]), "v"(s2[3]), "v"(s3[0]), "v"(s3[1]), "v"(s3[2]), "v"(s3[3]), "v"(k.x), "v"(k.y), "v"(k.z), "v"(k.w));
}
__device__ __forceinline__ void upd4_p(float& s0, float& s1, float& s2, float& s3, float d, f32x4 w, f32x4 b) {
    float t0, t1, t2, t3;
    asm("v_mul_f32 %4, %8, %13\n\tv_mul_f32 %5, %8, %14\n\tv_mul_f32 %6, %8, %15\n\tv_mul_f32 %7, %8, %16\n\t"
        "v_fma_f32 %0, %0, %9, %4\n\tv_fma_f32 %1, %1, %10, %5\n\tv_fma_f32 %2, %2, %11, %6\n\tv_fma_f32 %3, %3, %12, %7"
        : "+v"(s0), "+v"(s1), "+v"(s2), "+v"(s3), "=&v"(t0), "=&v"(t1), "=&v"(t2), "=&v"(t3)
        : "v"(d), "v"(w.x), "v"(w.y), "v"(w.z), "v"(w.w), "v"(b.x), "v"(b.y), "v"(b.z), "v"(b.w));
}
__device__ __forceinline__ void upd4_l(float& s0, float& s1, float& s2, float& s3, float d, float v, f32x4 w, f32x4 k, f32x4 b) {
    float t0, t1, t2, t3;
    asm("v_mul_f32 %4, %8, %14\n\tv_mul_f32 %5, %8, %15\n\tv_mul_f32 %6, %8, %16\n\tv_mul_f32 %7, %8, %17\n\t"
        "v_fmac_f32 %4, %9, %18\n\tv_fmac_f32 %5, %9, %19\n\tv_fmac_f32 %6, %9, %20\n\tv_fmac_f32 %7, %9, %21\n\t"
        "v_fma_f32 %0, %0, %10, %4\n\tv_fma_f32 %1, %1, %11, %5\n\tv_fma_f32 %2, %2, %12, %6\n\tv_fma_f32 %3, %3, %13, %7"
        : "+v"(s0), "+v"(s1), "+v"(s2), "+v"(s3), "=&v"(t0), "=&v"(t1), "=&v"(t2), "=&v"(t3)
        : "v"(d), "v"(v), "v"(w.x), "v"(w.y), "v"(w.z), "v"(w.w), "v"(b.x), "v"(b.y), "v"(b.z), "v"(b.w), "v"(k.x), "v"(k.y), "v"(k.z), "v"(k.w));
}
__device__ __forceinline__ float qsum(float x) {
    float r;
    asm("s_nop 1\n\tv_add_f32_dpp %0, %1, %1 quad_perm:[1,0,3,2] row_mask:0xf bank_mask:0xf" : "=v"(r) : "v"(x));
    asm("s_nop 1\n\tv_add_f32_dpp %0, %1, %1 quad_perm:[2,3,0,1] row_mask:0xf bank_mask:0xf" : "=v"(x) : "v"(r));
    return x;
}

__device__ __forceinline__ bf16x8 mk_frag(unsigned w0) { const u32x4 w = {w0, 0u, 0u, 0u}; return __builtin_bit_cast(bf16x8, w); }
__device__ __forceinline__ void ph_scan1(const Args& a, int l, LAS unsigned char* lds, int lane, int wave) {
    LAS float* wl = (LAS float*)(lds + wave * SCAN_WLDS);
    float* PC = (float*)(a.ws + WS_PC); float* LC = (float*)(a.ws + WS_LC);
    const int gw = blockIdx.x * 8 + wave, NGW = gridDim.x * 8;
    const int l31 = lane & 31, hh = lane >> 5;
    for (int item = gw; item < 2048; item += NGW) {
        const int c = item & 15, dir = (item >> 4) & 1, h = (item >> 5) & 7, b = item >> 8;
        if (c == NCH - 1) continue;
        const int hc = h * 64 + lane;
        const float kkw = a.in[I_KK][l * 512 + hc], kaw = a.in[I_KA][l * 512 + hc];
        const float w0b = a.in[I_W0][(l * 2 + dir) * 512 + hc], a0b = a.in[I_A0][(l * 2 + dir) * 512 + hc];
        f32x16 CP[2][2], CL[2][2];
        { int ln = lane; asm volatile("" : "+v"(ln));
          const int dg = (ln & 31) - 4 * (ln >> 5);
#pragma unroll
          for (int tr = 0; tr < 2; ++tr)
#pragma unroll
            for (int tc = 0; tc < 2; ++tc)
#pragma unroll
                for (int r = 0; r < 16; ++r) { CP[tr][tc][r] = (tr == tc && dg == (r & 3) + 8 * (r >> 2)) ? 1.0f : 0.0f; CL[tr][tc][r] = 0.f; } }
        ScanRaw R; float gam = 1.0f;
        scan_load(a, l, b, h, dir, c * CHL, R, lane);
        for (int s0 = c * CHL; s0 < (c + 1) * CHL; s0 += SG) {
            const bool renorm = (((s0 - c * CHL) >> 2) & 3) == 3;
            __builtin_amdgcn_sched_barrier(0);
            scan_write(R, kkw, kaw, w0b, a0b, wl, lane, gam, renorm);
            if (s0 + SG < (c + 1) * CHL) scan_load(a, l, b, h, dir, s0 + SG, R, lane);
            __builtin_amdgcn_sched_barrier(0);
#pragma unroll 1
            for (int gi = 0; gi < SG; ++gi) {
                const LAS float* base = wl + gi * SVEC;
                const LAS f32x4* pv = (const LAS f32x4*)(base + 4 * hh);
                f32x4 KK[2][4];
#pragma unroll
                for (int tr = 0; tr < 2; ++tr)
#pragma unroll
                    for (int g = 0; g < 4; ++g) KK[tr][g] = pv[32 + 8 * tr + 2 * g];
                float aop[2], vrr[2];
#pragma unroll
                for (int t = 0; t < 2; ++t) { aop[t] = base[64 + 32 * t + l31]; vrr[t] = base[320 + 32 * t + l31]; }
                __builtin_amdgcn_sched_barrier(0);
                const bf16x8 af[2] = {mk_frag(hh ? 0u : __builtin_bit_cast(unsigned, aop[0])), mk_frag(hh ? 0u : __builtin_bit_cast(unsigned, aop[1]))};
                float ra, rb;
                float dp[2];
#pragma unroll
                for (int tc = 0; tc < 2; ++tc) { float p0 = 0.f, p1 = 0.f;
#pragma unroll
                    for (int g = 0; g < 4; ++g)
#pragma unroll
                        for (int i = 0; i < 4; ++i) { p0 = __builtin_fmaf(CP[0][tc][4 * g + i], KK[0][g][i], p0); p1 = __builtin_fmaf(CP[1][tc][4 * g + i], KK[1][g][i], p1); }
                    dp[tc] = p0 + p1; }
                float dp0, dp1;
                swap32(dp[0], dp[1], ra, rb); { const float sd = ra + rb; swap32(sd, sd, dp0, dp1); }
                const bf16x8 bp0 = mk_frag(hh ? 0u : pk2(0.f, -dp0)), bp1 = mk_frag(hh ? 0u : pk2(0.f, -dp1));
                __builtin_amdgcn_sched_barrier(0);
                CP[0][0] = __builtin_amdgcn_mfma_f32_32x32x16_bf16(af[0], bp0, CP[0][0], 0, 0, 0);
                CP[1][0] = __builtin_amdgcn_mfma_f32_32x32x16_bf16(af[1], bp0, CP[1][0], 0, 0, 0);
                CP[0][1] = __builtin_amdgcn_mfma_f32_32x32x16_bf16(af[0], bp1, CP[0][1], 0, 0, 0);
                CP[1][1] = __builtin_amdgcn_mfma_f32_32x32x16_bf16(af[1], bp1, CP[1][1], 0, 0, 0);
                __builtin_amdgcn_sched_barrier(0);
                float dl[2];
#pragma unroll
                for (int tc = 0; tc < 2; ++tc) { float q0 = 0.f, q1 = 0.f;
#pragma unroll
                    for (int g = 0; g < 4; ++g)
#pragma unroll
                        for (int i = 0; i < 4; ++i) { q0 = __builtin_fmaf(CL[0][tc][4 * g + i], KK[0][g][i], q0); q1 = __builtin_fmaf(CL[1][tc][4 * g + i], KK[1][g][i], q1); }
                    dl[tc] = q0 + q1; }
                float dl0, dl1;
                swap32(dl[0], dl[1], ra, rb); { const float sd = ra + rb; swap32(sd, sd, dl0, dl1); }
                const bf16x8 bl0 = mk_frag(hh ? 0u : pk2(vrr[0], -dl0)), bl1 = mk_frag(hh ? 0u : pk2(vrr[1], -dl1));
                __builtin_amdgcn_sched_barrier(0);
                CL[0][0] = __builtin_amdgcn_mfma_f32_32x32x16_bf16(af[0], bl0, CL[0][0], 0, 0, 0);
                CL[1][0] = __builtin_amdgcn_mfma_f32_32x32x16_bf16(af[1], bl0, CL[1][0], 0, 0, 0);
                CL[0][1] = __builtin_amdgcn_mfma_f32_32x32x16_bf16(af[0], bl1, CL[0][1], 0, 0, 0);
                CL[1][1] = __builtin_amdgcn_mfma_f32_32x32x16_bf16(af[1], bl1, CL[1][1], 0, 0, 0);
                __builtin_amdgcn_sched_barrier(0);
                if (renorm && gi == SG - 1) {
#pragma unroll
                    for (int tr = 0; tr < 2; ++tr)
#pragma unroll
                        for (int g = 0; g < 4; ++g) { const f32x4 G = pv[8 * tr + 2 * g];
#pragma unroll
                            for (int tc = 0; tc < 2; ++tc)
#pragma unroll
                                for (int i = 0; i < 4; ++i) { CP[tr][tc][4 * g + i] *= G[i]; CL[tr][tc][4 * g + i] *= G[i]; } }
                }
            }
        }
        int item_o = item; asm volatile("" : "+s"(item_o));
#pragma unroll
        for (int tc = 0; tc < 2; ++tc) { float* po = PC + ((size_t)item_o * 64 + 32 * tc + l31) * 64 + 4 * hh; float* lo = LC + ((size_t)item_o * 64 + 32 * tc + l31) * 64 + 4 * hh;
#pragma unroll
            for (int tr = 0; tr < 2; ++tr)
#pragma unroll
                for (int g = 0; g < 4; ++g) { *(f32x4*)(po + 32 * tr + 8 * g) = (f32x4){CP[tr][tc][4 * g], CP[tr][tc][4 * g + 1], CP[tr][tc][4 * g + 2], CP[tr][tc][4 * g + 3]};
                    *(f32x4*)(lo + 32 * tr + 8 * g) = (f32x4){CL[tr][tc][4 * g], CL[tr][tc][4 * g + 1], CL[tr][tc][4 * g + 2], CL[tr][tc][4 * g + 3]}; } }
    }
}

__device__ __forceinline__ void split_bf16x8(const float (&x)[8], bf16x8& hi, bf16x8& lo) {
    u32x4 h, l;
    h.x = pk2(x[0], x[1]); h.y = pk2(x[2], x[3]); h.z = pk2(x[4], x[5]); h.w = pk2(x[6], x[7]);
    l.x = pk2(x[0] - bflo(h.x), x[1] - bfhi(h.x)); l.y = pk2(x[2] - bflo(h.y), x[3] - bfhi(h.y)); l.z = pk2(x[4] - bflo(h.z), x[5] - bfhi(h.z)); l.w = pk2(x[6] - bflo(h.w), x[7] - bfhi(h.w));
    hi = __builtin_bit_cast(bf16x8, h); lo = __builtin_bit_cast(bf16x8, l);
}
template <int VAR> __device__ __forceinline__ void ph_scan2(const Args& a, LAS unsigned char* lds, int tid, int lane, int wave) {
    const float* PC = (const float*)(a.ws + WS_PC); float* LC = (float*)(a.ws + WS_LC);
    const int l31 = lane & 31, hh = lane >> 5;
    if (wave != 0) {
        for (int u = blockIdx.x; u < 256; u += gridDim.x) {
            const int sid = u >> 1, t = (wave - 1) * 64 + lane; float sink = 0.f;
#pragma unroll
            for (int k = 0; k < 6; ++k) { const int id = t + 448 * k;
                if (id < 14 * 192) { const int c = 1 + id / 192, r = id % 192;
                    const float* pl = r < 128 ? PC + (size_t)(sid * 16 + c) * 4096 + r * 32 : LC + ((size_t)(sid * 16 + c) * 64 + 32 * (u & 1)) * 64 + (r - 128) * 32;
                    sink += *pl; } }
            asm volatile("" :: "v"(sink));
        }
        return;
    }
    for (int u = blockIdx.x; u < 256; u += gridDim.x) {
        const int sid = u >> 1, i = 32 * (u & 1) + l31;
        f32x16 acc[2];
#pragma unroll
        for (int ct = 0; ct < 2; ++ct)
#pragma unroll
            for (int g = 0; g < 4; ++g) { const f32x4 x = *(const f32x4*)(LC + ((size_t)(sid * 16) * 64 + i) * 64 + 32 * ct + 8 * g + 4 * hh); acc[ct][4 * g] = x.x; acc[ct][4 * g + 1] = x.y; acc[ct][4 * g + 2] = x.z; acc[ct][4 * g + 3] = x.w; }
        float pr[8][8]; f32x4 lr[2][4];
#define SC2_LOADP(co_, pc_) do { _Pragma("unroll") for (int k_ = 0; k_ < 4; ++k_) { const float* pb_ = (pc_) + (16 * k_ + 4 * hh) * 64 + 32 * (co_) + l31; \
            _Pragma("unroll") for (int jj = 0; jj < 8; ++jj) pr[(co_) * 4 + k_][jj] = pb_[((jj & 3) + 8 * (jj >> 2)) * 64]; } } while (0)
#define SC2_LOADL(cc_) do { const float* lp_ = LC + ((size_t)(sid * 16 + (cc_)) * 64 + i) * 64 + 4 * hh; _Pragma("unroll") for (int ct = 0; ct < 2; ++ct) _Pragma("unroll") for (int g = 0; g < 4; ++g) lr[ct][g] = *(const f32x4*)(lp_ + 32 * ct + 8 * g); } while (0)
        { const float* pc = PC + (size_t)(sid * 16 + 1) * 4096; SC2_LOADP(0, pc); SC2_LOADP(1, pc); SC2_LOADL(1); }
#pragma unroll 1
        for (int c = 1; c < NCH - 1; ++c) {
            const bool more = c + 1 < NCH - 1;
            const float* pcn = PC + (size_t)(sid * 16 + c + 1) * 4096;
            bf16x8 bh[4], bl[4];
#pragma unroll
            for (int ck = 0; ck < 2; ++ck)
#pragma unroll
                for (int sI = 0; sI < 2; ++sI) { float x[8];
#pragma unroll
                    for (int jj = 0; jj < 8; ++jj) x[jj] = acc[ck][8 * sI + jj];
                    split_bf16x8(x, bh[ck * 2 + sI], bl[ck * 2 + sI]); }
#pragma unroll
            for (int ct = 0; ct < 2; ++ct)
#pragma unroll
                for (int g = 0; g < 4; ++g) { acc[ct][4 * g] = lr[ct][g].x; acc[ct][4 * g + 1] = lr[ct][g].y; acc[ct][4 * g + 2] = lr[ct][g].z; acc[ct][4 * g + 3] = lr[ct][g].w; }
            __builtin_amdgcn_sched_barrier(0);
            if (more) SC2_LOADL(c + 1);
#pragma unroll
            for (int co = 0; co < 2; ++co) {
                bf16x8 ah[4], al[4];
#pragma unroll
                for (int k = 0; k < 4; ++k) split_bf16x8(pr[co * 4 + k], ah[k], al[k]);
                __builtin_amdgcn_sched_barrier(0);
                if (more) { if (co == 0) SC2_LOADP(0, pcn); else SC2_LOADP(1, pcn); }
                __builtin_amdgcn_sched_barrier(0);
#pragma unroll
                for (int k = 0; k < 4; ++k) {
                    acc[co] = __builtin_amdgcn_mfma_f32_32x32x16_bf16(ah[k], bh[k], acc[co], 0, 0, 0);
                    acc[co] = __builtin_amdgcn_mfma_f32_32x32x16_bf16(ah[k], bl[k], acc[co], 0, 0, 0);
                    acc[co] = __builtin_amdgcn_mfma_f32_32x32x16_bf16(al[k], bh[k], acc[co], 0, 0, 0); }
                __builtin_amdgcn_sched_barrier(0);
            }
            float* lcp = LC + ((size_t)(sid * 16 + c) * 64 + i) * 64 + 4 * hh;
#pragma unroll
            for (int ct = 0; ct < 2; ++ct)
#pragma unroll
                for (int g = 0; g < 4; ++g) if (VAR == 0 || acc[ct][4 * g] == 12345.678f) *(f32x4*)(lcp + 32 * ct + 8 * g) = (f32x4){acc[ct][4 * g], acc[ct][4 * g + 1], acc[ct][4 * g + 2], acc[ct][4 * g + 3]};
        }
#undef SC2_LOADP
#undef SC2_LOADL
    }
}

#ifndef PVAR
#define PVAR 0
#endif
template <int VAR> __device__ __forceinline__ void ph_scan3(const Args& a, int l, LAS unsigned char* lds, int lane, int wave) {
    LAS float* wl = (LAS float*)(lds + wave * (2 * SCAN_WLDS));
    LAS float* zer = (LAS float*)(lds + 8 * 2 * SCAN_WLDS + wave * 128);
    const float* LC = (const float*)(a.ws + WS_LC); bf16* Y = (bf16*)(a.ws + WS_Y);
    const int gw = blockIdx.x * 8 + wave, NGW = gridDim.x * 8;
    const int l31 = lane & 31, hh = lane >> 5;
    if (lane < 32) zer[lane] = 0.f;
    for (int item = gw; item < 2048; item += NGW) {
        if ((VAR & 16) && wave >= 4) continue;
        const int c = item & 15, dir = (item >> 4) & 1, h = (item >> 5) & 7, b = item >> 8;
        const int hc = h * 64 + lane;
        const float kkw = a.in[I_KK][l * 512 + hc], kaw = a.in[I_KA][l * 512 + hc];
        const float w0b = a.in[I_W0][(l * 2 + dir) * 512 + hc], a0b = a.in[I_A0][(l * 2 + dir) * 512 + hc];
        f32x16 C[2][2];
        if (c == 0) {
#pragma unroll
            for (int tr = 0; tr < 2; ++tr)
#pragma unroll
                for (int tc = 0; tc < 2; ++tc)
#pragma unroll
                    for (int i = 0; i < 16; ++i) C[tr][tc][i] = 0.f;
        } else {
#pragma unroll
            for (int tc = 0; tc < 2; ++tc) { const float* si = LC + ((size_t)(item - 1) * 64 + 32 * tc + l31) * 64 + 4 * hh;
#pragma unroll
                for (int tr = 0; tr < 2; ++tr)
#pragma unroll
                    for (int g = 0; g < 4; ++g) { const f32x4 x = *(const f32x4*)(si + 32 * tr + 8 * g); C[tr][tc][4 * g] = x.x; C[tr][tc][4 * g + 1] = x.y; C[tr][tc][4 * g + 2] = x.z; C[tr][tc][4 * g + 3] = x.w; } } }
        ScanRaw R; float gam = 1.0f;
        scan_load(a, l, b, h, dir, c * CHL, R, lane);
        int prow = 0;
        for (int s0 = c * CHL, grp = 0; s0 < (c + 1) * CHL; s0 += SG, ++grp) {
            const bool renorm = (grp & 3) == 3;
            LAS float* wg = wl + (grp & 1) * (SG * SVEC);
            __builtin_amdgcn_sched_barrier(0);
            scan_write(R, kkw, kaw, w0b, a0b, wg, lane, gam, renorm);
            if (s0 + SG < (c + 1) * CHL) scan_load(a, l, b, h, dir, s0 + SG, R, lane);
            __builtin_amdgcn_sched_barrier(0);
#pragma unroll 1
            for (int gi = 0; gi < SG; ++gi) {
                const LAS float* base = wg + gi * SVEC;
                const LAS float* pbase = gi > 0 ? base - SVEC : wl + ((grp & 1) ^ 1) * (SG * SVEC) + (SG - 1) * SVEC;
                const bool first = (grp == 0 && gi == 0);
                const LAS bf16* asrc = (l31 == 0) ? (first ? (const LAS bf16*)zer : (const LAS bf16*)(pbase + 192)) : (l31 == 1 ? (const LAS bf16*)(base + 192) + 64 : (const LAS bf16*)zer);
                const int astep = (l31 < 2 && !(l31 == 0 && first)) ? 16 : 0;
                bf16x8 afr[4];
#pragma unroll
                for (int f = 0; f < 4; ++f) afr[f] = *(const LAS bf16x8*)(asrc + (f * astep) + (l31 < 2 && !(l31 == 0 && first) ? hh * 8 : 0));
                float aop[2], vrr[2];
#pragma unroll
                for (int t = 0; t < 2; ++t) { aop[t] = base[64 + 32 * t + l31]; vrr[t] = base[320 + 32 * t + l31]; }
                __builtin_amdgcn_sched_barrier(0);
                f32x16 out[2];
#pragma unroll
                for (int tc = 0; tc < 2; ++tc) {
#pragma unroll
                    for (int i = 0; i < 16; ++i) out[tc][i] = 0.f;
#pragma unroll
                    for (int tr = 0; tr < 2; ++tr)
#pragma unroll
                        for (int sI = 0; sI < 2; ++sI) { u32x4 w; w.x = pk2(C[tr][tc][8 * sI + 0], C[tr][tc][8 * sI + 1]); w.y = pk2(C[tr][tc][8 * sI + 2], C[tr][tc][8 * sI + 3]);
                            w.z = pk2(C[tr][tc][8 * sI + 4], C[tr][tc][8 * sI + 5]); w.w = pk2(C[tr][tc][8 * sI + 6], C[tr][tc][8 * sI + 7]);
                            out[tc] = __builtin_amdgcn_mfma_f32_32x32x16_bf16(afr[tr * 2 + sI], __builtin_bit_cast(bf16x8, w), out[tc], 0, 0, 0); }
                }
                if (!first && lane < 32 && (VAR == 0 || out[0][0] == 12345.678f)) {
                    bf16* yp = Y + ((size_t)dir * NT + prow) * 512 + h * 64 + l31;
                    yp[0] = f2bf1(out[0][0]); yp[32] = f2bf1(out[1][0]); }
                const bf16x8 bop0 = mk_frag(hh ? 0u : pk2(vrr[0], -out[0][1])), bop1 = mk_frag(hh ? 0u : pk2(vrr[1], -out[1][1]));
                const bf16x8 af[2] = {mk_frag(hh ? 0u : __builtin_bit_cast(unsigned, aop[0])), mk_frag(hh ? 0u : __builtin_bit_cast(unsigned, aop[1]))};
                C[0][0] = __builtin_amdgcn_mfma_f32_32x32x16_bf16(af[0], bop0, C[0][0], 0, 0, 0);
                C[1][0] = __builtin_amdgcn_mfma_f32_32x32x16_bf16(af[1], bop0, C[1][0], 0, 0, 0);
                C[0][1] = __builtin_amdgcn_mfma_f32_32x32x16_bf16(af[0], bop1, C[0][1], 0, 0, 0);
                C[1][1] = __builtin_amdgcn_mfma_f32_32x32x16_bf16(af[1], bop1, C[1][1], 0, 0, 0);
                if (renorm && gi == SG - 1) {
                    const LAS f32x4* pv = (const LAS f32x4*)(base + 4 * hh);
#pragma unroll
                    for (int tr = 0; tr < 2; ++tr)
#pragma unroll
                        for (int g = 0; g < 4; ++g) { const f32x4 G = pv[8 * tr + 2 * g];
#pragma unroll
                            for (int tc = 0; tc < 2; ++tc)
#pragma unroll
                                for (int i = 0; i < 4; ++i) C[tr][tc][4 * g + i] *= G[i]; }
                }
                const int sx = s0 + gi, pos = dir == 0 ? sx : (sx < CTXL ? CTXL - 1 - sx : POSN + CTXL - 1 - sx);
                prow = row_of(b, pos);
            }
        }
        {
            const LAS float* pbase = wl + (((CHL / SG - 1) & 1)) * (SG * SVEC) + (SG - 1) * SVEC;
            const LAS bf16* asrc = (l31 == 0) ? (const LAS bf16*)(pbase + 192) : (const LAS bf16*)zer;
            bf16x8 afr[4];
#pragma unroll
            for (int f = 0; f < 4; ++f) afr[f] = *(const LAS bf16x8*)(asrc + (l31 == 0 ? f * 16 + hh * 8 : 0));
            f32x16 out[2];
#pragma unroll
            for (int tc = 0; tc < 2; ++tc) {
#pragma unroll
                for (int i = 0; i < 16; ++i) out[tc][i] = 0.f;
#pragma unroll
                for (int tr = 0; tr < 2; ++tr)
#pragma unroll
                    for (int sI = 0; sI < 2; ++sI) { u32x4 w; w.x = pk2(C[tr][tc][8 * sI + 0], C[tr][tc][8 * sI + 1]); w.y = pk2(C[tr][tc][8 * sI + 2], C[tr][tc][8 * sI + 3]);
                        w.z = pk2(C[tr][tc][8 * sI + 4], C[tr][tc][8 * sI + 5]); w.w = pk2(C[tr][tc][8 * sI + 6], C[tr][tc][8 * sI + 7]);
                        out[tc] = __builtin_amdgcn_mfma_f32_32x32x16_bf16(afr[tr * 2 + sI], __builtin_bit_cast(bf16x8, w), out[tc], 0, 0, 0); }
            }
            if (lane < 32 && (VAR == 0 || out[0][0] == 12345.678f)) { bf16* yp = Y + ((size_t)dir * NT + prow) * 512 + h * 64 + l31; yp[0] = f2bf1(out[0][0]); yp[32] = f2bf1(out[1][0]); }
        }
    }
}

constexpr int BT = 16, FRS = 72;
constexpr int B_FRK = 0, B_FRR = 2304, B_FRD = 4608, B_FRB = 6912;
constexpr int B_KMD = 9216, B_KMB = 11264;
constexpr int B_GT = 13312;
constexpr int B_GAM = 17408;
constexpr int B_WLDS = 17664;

template <int T0> __device__ __forceinline__ void blk_stage(const ScanRaw& R, float kkw, float kaw, float w0b, float a0b, LAS unsigned char* wb, int lane, int fo, float& gam, float (&V)[BT], unsigned (&kc)[4], bool fold = true) {
    unsigned lowk[SG], lowb[SG];
    const float w0n = -1.4426950408889634f * w0b, a0n = -1.4426950408889634f * a0b, omk = 1.0f - kaw;
#pragma unroll
    for (int gi = 0; gi < SG; ++gi) {
        constexpr int dummy = 0; (void)dummy;
        const int t = T0 + gi;
        const float kxf = bf2f(R.kx[gi]);
        const float wv = __builtin_amdgcn_exp2f(-0.8750387753291099f * sigmoid_nb(bf2f(R.wx[gi]), w0n)), av = sigmoid_nb(bf2f(R.ax[gi]), a0n);
        const float kk = kxf * kkw * R.rn[gi];
        const float kd = kxf * __builtin_fmaf(kaw, av, omk), bb = -kk * av;
        const float kks = kk * gam;
        gam *= wv;
        const float ig = __builtin_amdgcn_rcpf(gam);
        const unsigned pkb = pk2(kd * ig, bb * ig), prk = pk2(bf2f(R.rx[gi]) * gam, kks);
        ((LAS bf16*)(wb + B_FRD))[t * FRS + fo] = (bf16)(pkb & 0xffffu); ((LAS bf16*)(wb + B_FRB))[t * FRS + fo] = (bf16)(pkb >> 16);
        ((LAS bf16*)(wb + B_FRR))[t * FRS + fo] = (bf16)(prk & 0xffffu); ((LAS bf16*)(wb + B_FRK))[t * FRS + fo] = (bf16)(prk >> 16);
        lowk[gi] = pkb & 0xffffu; lowb[gi] = pkb >> 16;
        V[t] = bf2f(R.vx[gi]);
        if (t == BT - 1 && fold) { ((LAS float*)(wb + B_GAM))[lane] = gam; gam = 1.0f; }
    }
    const unsigned k0 = lowk[0] | (lowk[1] << 16), k1 = lowk[2] | (lowk[3] << 16), b0 = lowb[0] | (lowb[1] << 16), b1 = lowb[2] | (lowb[3] << 16);
    if ((T0 & 4) == 0) { kc[0] = k0; kc[1] = k1; kc[2] = b0; kc[3] = b1; }
    else { *(LAS u32x4*)(wb + B_KMD + ((T0 >> 3) * 64 + lane) * 16) = (u32x4){kc[0], kc[1], k0, k1}; *(LAS u32x4*)(wb + B_KMB + ((T0 >> 3) * 64 + lane) * 16) = (u32x4){kc[2], kc[3], b0, b1}; }
}
__device__ __forceinline__ void blk_stepA(const f32x16 (&C)[2][2], LAS unsigned char* wb, int l31, int hh, f32x16 (&out)[2]) {
    const LAS bf16* arow = (const LAS bf16*)(wb + (l31 < 16 ? B_FRR : B_FRK)) + (l31 & 15) * FRS + hh * 8;
    bf16x8 afr[4];
#pragma unroll
    for (int f = 0; f < 4; ++f) afr[f] = *(const LAS bf16x8*)(arow + f * 16);
#pragma unroll
    for (int tc = 0; tc < 2; ++tc) {
#pragma unroll
        for (int i = 0; i < 16; ++i) out[tc][i] = 0.f;
#pragma unroll
        for (int tr = 0; tr < 2; ++tr)
#pragma unroll
            for (int sI = 0; sI < 2; ++sI) { u32x4 w; w.x = pk2(C[tr][tc][8 * sI + 0], C[tr][tc][8 * sI + 1]); w.y = pk2(C[tr][tc][8 * sI + 2], C[tr][tc][8 * sI + 3]);
                w.z = pk2(C[tr][tc][8 * sI + 4], C[tr][tc][8 * sI + 5]); w.w = pk2(C[tr][tc][8 * sI + 6], C[tr][tc][8 * sI + 7]);
                out[tc] = __builtin_amdgcn_mfma_f32_32x32x16_bf16(afr[tr * 2 + sI], __builtin_bit_cast(bf16x8, w), out[tc], 0, 0, 0); }
    }
}
__device__ __forceinline__ void blk_stepB(LAS unsigned char* wb, int l31, int hh) {
    const LAS bf16* arow = (const LAS bf16*)(wb + (l31 < 16 ? B_FRD : B_FRB)) + (l31 & 15) * FRS + hh * 8;
    const LAS bf16* brow = (const LAS bf16*)(wb + (l31 < 16 ? B_FRK : B_FRR)) + (l31 & 15) * FRS + hh * 8;
    f32x16 g;
#pragma unroll
    for (int i = 0; i < 16; ++i) g[i] = 0.f;
#pragma unroll
    for (int f = 0; f < 4; ++f) g = __builtin_amdgcn_mfma_f32_32x32x16_bf16(*(const LAS bf16x8*)(arow + f * 16), *(const LAS bf16x8*)(brow + f * 16), g, 0, 0, 0);
    LAS float* gt = (LAS float*)(wb + B_GT) + l31 * 32 + 4 * hh;
#pragma unroll
    for (int q = 0; q < 4; ++q) *(LAS f32x4*)(gt + 8 * q) = (f32x4){g[4 * q], g[4 * q + 1], g[4 * q + 2], g[4 * q + 3]};
}
__device__ __forceinline__ void blk_gather(const f32x16 (&out)[2], int rbase  , float (&X)[BT]) {
#pragma unroll
    for (int q = 0; q < 2; ++q)
#pragma unroll
        for (int i = 0; i < 4; ++i) { float ra, rb; swap32(out[0][rbase + 4 * q + i], out[1][rbase + 4 * q + i], ra, rb); X[8 * q + i] = ra; X[8 * q + 4 + i] = rb; }
}
__device__ __forceinline__ void blk_bfrag(const float (&X)[BT], float sgn, bf16x8& b0, bf16x8& b1) {
    u32x4 lo, hi, r0, r1;
    lo.x = pk2(sgn * X[0], sgn * X[1]); lo.y = pk2(sgn * X[2], sgn * X[3]); lo.z = pk2(sgn * X[4], sgn * X[5]); lo.w = pk2(sgn * X[6], sgn * X[7]);
    hi.x = pk2(sgn * X[8], sgn * X[9]); hi.y = pk2(sgn * X[10], sgn * X[11]); hi.z = pk2(sgn * X[12], sgn * X[13]); hi.w = pk2(sgn * X[14], sgn * X[15]);
#pragma unroll
    for (int d = 0; d < 4; ++d) { const unsigned ul = lo[d], uh = hi[d];
        float ra, rb; swap32(__builtin_bit_cast(float, ul), __builtin_bit_cast(float, uh), ra, rb); r0[d] = __builtin_bit_cast(unsigned, ra); r1[d] = __builtin_bit_cast(unsigned, rb); }
    b0 = __builtin_bit_cast(bf16x8, r0); b1 = __builtin_bit_cast(bf16x8, r1);
}

__device__ __forceinline__ void ph_scan3b(const Args& a, int l, LAS unsigned char* lds, int lane, int wave) {
    LAS unsigned char* wb = lds + wave * B_WLDS;
    const float* LC = (const float*)(a.ws + WS_LC); bf16* Y = (bf16*)(a.ws + WS_Y);
    const int gw = blockIdx.x * 8 + wave, NGW = gridDim.x * 8;
    const int l31 = lane & 31, hh = lane >> 5;
    const int fo = ((((lane >> 5) * 2 + ((lane >> 4) & 1)) * 2 + ((lane >> 2) & 1)) * 8) + 4 * ((lane >> 3) & 1) + (lane & 3);
    for (int item = gw; item < 2048; item += NGW) {
        const int c = item & 15, dir = (item >> 4) & 1, h = (item >> 5) & 7, b = item >> 8;
        const int hc = h * 64 + lane;
        const float kkw = a.in[I_KK][l * 512 + hc], kaw = a.in[I_KA][l * 512 + hc];
        const float w0b = a.in[I_W0][(l * 2 + dir) * 512 + hc], a0b = a.in[I_A0][(l * 2 + dir) * 512 + hc];
        f32x16 C[2][2];
        if (c == 0) {
#pragma unroll
            for (int tr = 0; tr < 2; ++tr)
#pragma unroll
                for (int tc = 0; tc < 2; ++tc)
#pragma unroll
                    for (int i = 0; i < 16; ++i) C[tr][tc][i] = 0.f;
        } else {
#pragma unroll
            for (int tc = 0; tc < 2; ++tc) { const float* si = LC + ((size_t)(item - 1) * 64 + 32 * tc + l31) * 64 + 4 * hh;
#pragma unroll
                for (int tr = 0; tr < 2; ++tr)
#pragma unroll
                    for (int g = 0; g < 4; ++g) { const f32x4 x = *(const f32x4*)(si + 32 * tr + 8 * g); C[tr][tc][4 * g] = x.x; C[tr][tc][4 * g + 1] = x.y; C[tr][tc][4 * g + 2] = x.z; C[tr][tc][4 * g + 3] = x.w; } } }
        ScanRaw R0, R1; float gam = 1.0f;
        scan_load(a, l, b, h, dir, c * CHL, R0, lane);
        scan_load(a, l, b, h, dir, c * CHL + SG, R1, lane);
#pragma unroll 1
        for (int blk = 0; blk < CHL / BT; ++blk) {
            const int s0 = c * CHL + blk * BT; const bool more = blk + 1 < CHL / BT;
            const bool fold = (blk & 3) == 3 || !more;
            float V[BT]; unsigned kc[4];
            __builtin_amdgcn_sched_barrier(0);
            blk_stage<0>(R0, kkw, kaw, w0b, a0b, wb, lane, fo, gam, V, kc);  scan_load(a, l, b, h, dir, s0 + 2 * SG, R0, lane);
            __builtin_amdgcn_sched_barrier(0);
            blk_stage<4>(R1, kkw, kaw, w0b, a0b, wb, lane, fo, gam, V, kc);  scan_load(a, l, b, h, dir, s0 + 3 * SG, R1, lane);
            __builtin_amdgcn_sched_barrier(0);
            blk_stage<8>(R0, kkw, kaw, w0b, a0b, wb, lane, fo, gam, V, kc);  if (more) scan_load(a, l, b, h, dir, s0 + 4 * SG, R0, lane);
            __builtin_amdgcn_sched_barrier(0);
            blk_stage<12>(R1, kkw, kaw, w0b, a0b, wb, lane, fo, gam, V, kc, fold); if (more) scan_load(a, l, b, h, dir, s0 + 5 * SG, R1, lane);
            __builtin_amdgcn_sched_barrier(0);
            f32x16 out[2];
            blk_stepB(wb, l31, hh);
            blk_stepA(C, wb, l31, hh, out);
            const LAS float* GT = (const LAS float*)(wb + B_GT);
            bf16x8 bv0, bv1, bd0, bd1, a2, a3;
            blk_bfrag(V, 1.0f, bv0, bv1);
            { const LAS float* gp = GT + (l31 ^ 16) * 32 + 8 * hh;
              const int thr = (l31 < 16 ? l31 + 1 : l31 - 16) - 8 * hh, thr3 = (l31 < 16 ? l31 + 1 : 0) - 8 * hh;
              const f32x4 x0 = *(const LAS f32x4*)gp, x1 = *(const LAS f32x4*)(gp + 4), y0 = *(const LAS f32x4*)(gp + 16), y1 = *(const LAS f32x4*)(gp + 20);
              u32x4 w2, w3;
              w2.x = pk2(0 < thr ? x0.x : 0.f, 1 < thr ? x0.y : 0.f); w2.y = pk2(2 < thr ? x0.z : 0.f, 3 < thr ? x0.w : 0.f);
              w2.z = pk2(4 < thr ? x1.x : 0.f, 5 < thr ? x1.y : 0.f); w2.w = pk2(6 < thr ? x1.z : 0.f, 7 < thr ? x1.w : 0.f);
              w3.x = pk2(0 < thr3 ? y0.x : 0.f, 1 < thr3 ? y0.y : 0.f); w3.y = pk2(2 < thr3 ? y0.z : 0.f, 3 < thr3 ? y0.w : 0.f);
              w3.z = pk2(4 < thr3 ? y1.x : 0.f, 5 < thr3 ? y1.y : 0.f); w3.w = pk2(6 < thr3 ? y1.z : 0.f, 7 < thr3 ? y1.w : 0.f);
              a2 = __builtin_bit_cast(bf16x8, w2); a3 = __builtin_bit_cast(bf16x8, w3); }
            out[0] = __builtin_amdgcn_mfma_f32_32x32x16_bf16(a2, bv0, out[0], 0, 0, 0);
            out[1] = __builtin_amdgcn_mfma_f32_32x32x16_bf16(a2, bv1, out[1], 0, 0, 0);
            float D[BT];
            blk_gather(out, 8, D);
#pragma unroll
            for (int t = 1; t < BT; ++t) {
                float acc = D[t];
                f32x4 g2[4];
#pragma unroll
                for (int q = 0; q < 4; ++q) if (4 * q < t) g2[q] = *(const LAS f32x4*)(GT + t * 32 + 16 + 4 * q);
#pragma unroll
                for (int s = 0; s < t; ++s) acc = __builtin_fmaf(D[s], g2[s >> 2][s & 3], acc);
                D[t] = acc;
            }
            blk_bfrag(D, 1.0f, bd0, bd1);
            out[0] = __builtin_amdgcn_mfma_f32_32x32x16_bf16(a3, bd0, out[0], 0, 0, 0);
            out[1] = __builtin_amdgcn_mfma_f32_32x32x16_bf16(a3, bd1, out[1], 0, 0, 0);
            {
                const int pos0 = dir == 0 ? s0 : (s0 < CTXL ? CTXL - 1 - s0 : POSN + CTXL - 1 - s0);
                const int row0 = row_of(b, pos0), dstep = dir == 0 ? 512 : -512;
                bf16* yb = Y + ((size_t)dir * NT + row0) * 512 + h * 64 + l31 + 4 * hh * dstep;
#pragma unroll
                for (int rr = 0; rr < 8; ++rr) {
                    const int tb = (rr & 3) + 8 * (rr >> 2);
                    bf16* yp = yb + tb * dstep;
                    const unsigned yw = pk2(out[0][rr], out[1][rr]); yp[0] = (bf16)(yw & 0xffffu); yp[32] = (bf16)(yw >> 16);
                }
            }
#pragma unroll
            for (int tr = 0; tr < 2; ++tr) {
                const bf16x8 ad = *(const LAS bf16x8*)(wb + B_KMD + (hh * 64 + 32 * tr + l31) * 16), ab = *(const LAS bf16x8*)(wb + B_KMB + (hh * 64 + 32 * tr + l31) * 16);
                C[tr][0] = __builtin_amdgcn_mfma_f32_32x32x16_bf16(ad, bv0, C[tr][0], 0, 0, 0); C[tr][0] = __builtin_amdgcn_mfma_f32_32x32x16_bf16(ab, bd0, C[tr][0], 0, 0, 0);
                C[tr][1] = __builtin_amdgcn_mfma_f32_32x32x16_bf16(ad, bv1, C[tr][1], 0, 0, 0); C[tr][1] = __builtin_amdgcn_mfma_f32_32x32x16_bf16(ab, bd1, C[tr][1], 0, 0, 0);
            }
            if (fold)
            { const LAS f32x4* pg = (const LAS f32x4*)((const LAS float*)(wb + B_GAM) + 4 * hh);
#pragma unroll
              for (int tr = 0; tr < 2; ++tr)
#pragma unroll
                for (int g = 0; g < 4; ++g) { const f32x4 G = pg[8 * tr + 2 * g];
#pragma unroll
                    for (int tc = 0; tc < 2; ++tc)
#pragma unroll
                        for (int i = 0; i < 4; ++i) C[tr][tc][4 * g + i] *= G[i]; } }
        }
    }
}

struct ScanRaw1 { unsigned ka[SG], wv[SG]; float rn[SG]; };
__device__ __forceinline__ void scan_load1(const Args& a, int l, int b, int h, int dir, int s0, ScanRaw1& R, int lane) {
    const __amdgpu_buffer_rsrc_t rK = __builtin_amdgcn_make_buffer_rsrc((void*)(a.ws + WS_K), 0, 0x7ffffffe, 0x00020000), rV = __builtin_amdgcn_make_buffer_rsrc((void*)(a.ws + (l == 0 ? WS_V0 : WS_V1)), 0, 0x7ffffffe, 0x00020000);
    const __amdgpu_buffer_rsrc_t rW = __builtin_amdgcn_make_buffer_rsrc((void*)(a.ws + WS_P), 0, 0x7ffffffe, 0x00020000);
    const float* KN = (const float*)(a.ws + WS_KN);
    const int vo = (h * 64 + lane) * 2;
#pragma unroll
    for (int gi = 0; gi < SG; ++gi) {
        const int s = s0 + gi, pos = dir == 0 ? s : (s < CTXL ? CTXL - 1 - s : POSN + CTXL - 1 - s), row = row_of(b, pos);
        const int o5 = row * 1024, ol = row * (LWC * 2) + dir * 1024;
        R.ka[gi] = (unsigned)(unsigned short)__builtin_amdgcn_raw_buffer_load_b16(rK, vo, o5, 0) | ((unsigned)(unsigned short)__builtin_amdgcn_raw_buffer_load_b16(rW, vo, ol + 2048, 0) << 16);
        R.wv[gi] = (unsigned)(unsigned short)__builtin_amdgcn_raw_buffer_load_b16(rW, vo, ol, 0) | ((unsigned)(unsigned short)__builtin_amdgcn_raw_buffer_load_b16(rV, vo, o5, 0) << 16);
        R.rn[gi] = KN[row * 8 + h];
    }
}
template <int T0> __device__ __forceinline__ void blk_stage1(const ScanRaw1& R, float kkw, float kaw, float w0b, float a0b, LAS unsigned char* wb, int lane, int fo, float& gam, unsigned (&kc)[6], bool fold = true) {
    unsigned lowk[SG], lowb[SG];
    const float w0n = -1.4426950408889634f * w0b, a0n = -1.4426950408889634f * a0b, omk = 1.0f - kaw;
#pragma unroll
    for (int gi = 0; gi < SG; ++gi) {
        const int t = T0 + gi;
        const float kxf = bflo(R.ka[gi]);
        const float wv = __builtin_amdgcn_exp2f(-0.8750387753291099f * sigmoid_nb(bflo(R.wv[gi]), w0n)), av = sigmoid_nb(bfhi(R.ka[gi]), a0n);
        const float kk = kxf * kkw * R.rn[gi];
        const float kd = kxf * __builtin_fmaf(kaw, av, omk), bb = -kk * av;
        const float kks = kk * gam;
        gam *= wv;
        const float ig = __builtin_amdgcn_rcpf(gam);
        const unsigned pkb = pk2(kd * ig, bb * ig);
        ((LAS bf16*)(wb + B_FRD))[t * FRS + fo] = (bf16)(pkb & 0xffffu); ((LAS bf16*)(wb + B_FRB))[t * FRS + fo] = (bf16)(pkb >> 16);
        ((LAS bf16*)(wb + B_FRK))[t * FRS + fo] = f2bf1(kks);
        lowk[gi] = pkb & 0xffffu; lowb[gi] = pkb >> 16;
        if (t == BT - 1 && fold) { ((LAS float*)(wb + B_GAM))[lane] = gam; gam = 1.0f; }
    }
    const unsigned k0 = lowk[0] | (lowk[1] << 16), k1 = lowk[2] | (lowk[3] << 16), b0 = lowb[0] | (lowb[1] << 16), b1 = lowb[2] | (lowb[3] << 16);
    const unsigned v0 = (R.wv[0] >> 16) | (R.wv[1] & 0xffff0000u), v1 = (R.wv[2] >> 16) | (R.wv[3] & 0xffff0000u);
    if ((T0 & 4) == 0) { kc[0] = k0; kc[1] = k1; kc[2] = b0; kc[3] = b1; kc[4] = v0; kc[5] = v1; }
    else { *(LAS u32x4*)(wb + B_KMD + ((T0 >> 3) * 64 + lane) * 16) = (u32x4){kc[0], kc[1], k0, k1}; *(LAS u32x4*)(wb + B_KMB + ((T0 >> 3) * 64 + lane) * 16) = (u32x4){kc[2], kc[3], b0, b1};
           *(LAS u32x4*)(wb + B_FRR + ((T0 >> 3) * 64 + lane) * 16) = (u32x4){kc[4], kc[5], v0, v1}; }
}
__device__ __forceinline__ void blk_d0(const f32x16 (&C)[2][2], LAS unsigned char* wb, int l31, int hh, float (&X)[BT]) {
    f32x16 out[2];
    blk_stepA(C, wb, l31, hh, out);
    blk_gather(out, 8, X);
}
__device__ __forceinline__ void blk_bfrag_lds(const LAS unsigned char* rowp, bf16x8& b0, bf16x8& b1) {
    const u32x4 lo = *(const LAS u32x4*)rowp, hi = *(const LAS u32x4*)(rowp + 1024); u32x4 r0, r1;
#pragma unroll
    for (int d = 0; d < 4; ++d) { const unsigned ul = lo[d], uh = hi[d]; float ra, rb; swap32(__builtin_bit_cast(float, ul), __builtin_bit_cast(float, uh), ra, rb); r0[d] = __builtin_bit_cast(unsigned, ra); r1[d] = __builtin_bit_cast(unsigned, rb); }
    b0 = __builtin_bit_cast(bf16x8, r0); b1 = __builtin_bit_cast(bf16x8, r1);
}
__device__ __forceinline__ void ph_scan1b(const Args& a, int l, LAS unsigned char* lds, int lane, int wave) {
    LAS unsigned char* wb = lds + wave * B_WLDS;
    float* PC = (float*)(a.ws + WS_PC); float* LC = (float*)(a.ws + WS_LC);
    const int gw = blockIdx.x * 8 + wave, NGW = gridDim.x * 8;
    const int l31 = lane & 31, hh = lane >> 5;
    const int fo = ((((lane >> 5) * 2 + ((lane >> 4) & 1)) * 2 + ((lane >> 2) & 1)) * 8) + 4 * ((lane >> 3) & 1) + (lane & 3);
    for (int item = gw; item < 2048; item += NGW) {
        const int c = item & 15, dir = (item >> 4) & 1, h = (item >> 5) & 7, b = item >> 8;
        if (c == NCH - 1) continue;
        const int hc = h * 64 + lane;
        const float kkw = a.in[I_KK][l * 512 + hc], kaw = a.in[I_KA][l * 512 + hc];
        const float w0b = a.in[I_W0][(l * 2 + dir) * 512 + hc], a0b = a.in[I_A0][(l * 2 + dir) * 512 + hc];
        f32x16 CP[2][2], CL[2][2];
        { int ln = lane; asm volatile("" : "+v"(ln));
          const int dg = (ln & 31) - 4 * (ln >> 5);
#pragma unroll
          for (int tr = 0; tr < 2; ++tr)
#pragma unroll
            for (int tc = 0; tc < 2; ++tc)
#pragma unroll
                for (int r = 0; r < 16; ++r) { CP[tr][tc][r] = (tr == tc && dg == (r & 3) + 8 * (r >> 2)) ? 1.0f : 0.0f; CL[tr][tc][r] = 0.f; } }
        ScanRaw1 R0, R1; float gam = 1.0f;
        scan_load1(a, l, b, h, dir, c * CHL, R0, lane);
        scan_load1(a, l, b, h, dir, c * CHL + SG, R1, lane);
#pragma unroll 1
        for (int blk = 0; blk < CHL / BT; ++blk) {
            const int s0 = c * CHL + blk * BT; const bool more = blk + 1 < CHL / BT;
            const bool fold = (blk & 3) == 3 || !more;
            unsigned kc[6];
            __builtin_amdgcn_sched_barrier(0);
            blk_stage1<0>(R0, kkw, kaw, w0b, a0b, wb, lane, fo, gam, kc);  scan_load1(a, l, b, h, dir, s0 + 2 * SG, R0, lane);
            __builtin_amdgcn_sched_barrier(0);
            blk_stage1<4>(R1, kkw, kaw, w0b, a0b, wb, lane, fo, gam, kc);  scan_load1(a, l, b, h, dir, s0 + 3 * SG, R1, lane);
            __builtin_amdgcn_sched_barrier(0);
            blk_stage1<8>(R0, kkw, kaw, w0b, a0b, wb, lane, fo, gam, kc);
            __builtin_amdgcn_sched_barrier(0);
            blk_stage1<12>(R1, kkw, kaw, w0b, a0b, wb, lane, fo, gam, kc, fold);
            __builtin_amdgcn_sched_barrier(0);
            blk_stepB(wb, l31, hh);
            const LAS unsigned char* vrow = wb + B_FRR + lane * 16;
            const LAS float* GT = (const LAS float*)(wb + B_GT);
            bf16x8 bl0, bl1, bp0, bp1;
            {
                float DL[BT];
                { f32x16 out[2];
                  blk_stepA(CL, wb, l31, hh, out);
                  bf16x8 bv0, bv1, a2;
                  blk_bfrag_lds(vrow, bv0, bv1);
                  { const LAS float* gp = GT + (l31 & 15) * 32 + 8 * hh;
                    const int thr = (l31 >= 16 ? l31 - 16 : 0) - 8 * hh;
                    const f32x4 x0 = *(const LAS f32x4*)gp, x1 = *(const LAS f32x4*)(gp + 4);
                    u32x4 w2;
                    w2.x = pk2(0 < thr ? x0.x : 0.f, 1 < thr ? x0.y : 0.f); w2.y = pk2(2 < thr ? x0.z : 0.f, 3 < thr ? x0.w : 0.f);
                    w2.z = pk2(4 < thr ? x1.x : 0.f, 5 < thr ? x1.y : 0.f); w2.w = pk2(6 < thr ? x1.z : 0.f, 7 < thr ? x1.w : 0.f);
                    a2 = __builtin_bit_cast(bf16x8, w2); }
                  out[0] = __builtin_amdgcn_mfma_f32_32x32x16_bf16(a2, bv0, out[0], 0, 0, 0);
                  out[1] = __builtin_amdgcn_mfma_f32_32x32x16_bf16(a2, bv1, out[1], 0, 0, 0);
                  blk_gather(out, 8, DL); }
#pragma unroll
                for (int t = 1; t < BT; ++t) {
                    float accl = DL[t];
#pragma unroll
                    for (int q = 0; q < 4; ++q) if (4 * q < t) { const f32x4 g2 = *(const LAS f32x4*)(GT + t * 32 + 16 + 4 * q);
#pragma unroll
                        for (int i = 0; i < 4; ++i) if (4 * q + i < t) accl = __builtin_fmaf(DL[4 * q + i], g2[i], accl); }
                    DL[t] = accl;
                }
                blk_bfrag(DL, 1.0f, bl0, bl1);
            }
            __builtin_amdgcn_sched_barrier(0);
            {   float DP[BT];
                blk_d0(CP, wb, l31, hh, DP);
#pragma unroll
                for (int t = 1; t < BT; ++t) {
                    float accp = DP[t];
#pragma unroll
                    for (int q = 0; q < 4; ++q) if (4 * q < t) { const f32x4 g2 = *(const LAS f32x4*)(GT + t * 32 + 16 + 4 * q);
#pragma unroll
                        for (int i = 0; i < 4; ++i) if (4 * q + i < t) accp = __builtin_fmaf(DP[4 * q + i], g2[i], accp); }
                    DP[t] = accp;
                }
                blk_bfrag(DP, 1.0f, bp0, bp1);
            }
            __builtin_amdgcn_sched_barrier(0);
            if (more) { scan_load1(a, l, b, h, dir, s0 + 4 * SG, R0, lane); scan_load1(a, l, b, h, dir, s0 + 5 * SG, R1, lane); }
            __builtin_amdgcn_sched_barrier(0);
            bf16x8 bv0, bv1;
            blk_bfrag_lds(vrow, bv0, bv1);
#pragma unroll
            for (int tr = 0; tr < 2; ++tr) {
                const bf16x8 ad = *(const LAS bf16x8*)(wb + B_KMD + (hh * 64 + 32 * tr + l31) * 16), ab = *(const LAS bf16x8*)(wb + B_KMB + (hh * 64 + 32 * tr + l31) * 16);
                CL[tr][0] = __builtin_amdgcn_mfma_f32_32x32x16_bf16(ad, bv0, CL[tr][0], 0, 0, 0); CL[tr][0] = __builtin_amdgcn_mfma_f32_32x32x16_bf16(ab, bl0, CL[tr][0], 0, 0, 0);
                CL[tr][1] = __builtin_amdgcn_mfma_f32_32x32x16_bf16(ad, bv1, CL[tr][1], 0, 0, 0); CL[tr][1] = __builtin_amdgcn_mfma_f32_32x32x16_bf16(ab, bl1, CL[tr][1], 0, 0, 0);
                CP[tr][0] = __builtin_amdgcn_mfma_f32_32x32x16_bf16(ab, bp0, CP[tr][0], 0, 0, 0); CP[tr][1] = __builtin_amdgcn_mfma_f32_32x32x16_bf16(ab, bp1, CP[tr][1], 0, 0, 0);
            }
            if (fold)
            { const LAS f32x4* pg = (const LAS f32x4*)((const LAS float*)(wb + B_GAM) + 4 * hh);
#pragma unroll
              for (int tr = 0; tr < 2; ++tr)
#pragma unroll
                for (int g = 0; g < 4; ++g) { const f32x4 G = pg[8 * tr + 2 * g];
#pragma unroll
                    for (int tc = 0; tc < 2; ++tc)
#pragma unroll
                        for (int i = 0; i < 4; ++i) { CL[tr][tc][4 * g + i] *= G[i]; CP[tr][tc][4 * g + i] *= G[i]; } } }
        }
        int item_o = item; asm volatile("" : "+s"(item_o));
#pragma unroll
        for (int tc = 0; tc < 2; ++tc) { float* po = PC + ((size_t)item_o * 64 + 32 * tc + l31) * 64 + 4 * hh; float* lo = LC + ((size_t)item_o * 64 + 32 * tc + l31) * 64 + 4 * hh;
#pragma unroll
            for (int tr = 0; tr < 2; ++tr)
#pragma unroll
                for (int g = 0; g < 4; ++g) { *(f32x4*)(po + 32 * tr + 8 * g) = (f32x4){CP[tr][tc][4 * g], CP[tr][tc][4 * g + 1], CP[tr][tc][4 * g + 2], CP[tr][tc][4 * g + 3]};
                    *(f32x4*)(lo + 32 * tr + 8 * g) = (f32x4){CL[tr][tc][4 * g], CL[tr][tc][4 * g + 1], CL[tr][tc][4 * g + 2], CL[tr][tc][4 * g + 3]}; } }
    }
}

__device__ __forceinline__ void ph_readout(const Args& a, int l, int lane, int wave) {
    const int gw = blockIdx.x * 8 + wave, NGW = gridDim.x * 8;
    unsigned char* ws = a.ws;
    const bf16* Y = (const bf16*)(ws + WS_Y); const bf16* Rb = (const bf16*)(ws + WS_R); const bf16* Kb = (const bf16*)(ws + WS_K); const bf16* Vb = (const bf16*)(ws + (l == 0 ? WS_V0 : WS_V1));
    const bf16* LW = (const bf16*)(ws + WS_P); bf16* H = (bf16*)(ws + WS_H);
    const int c0 = lane * 8;
    float ka[8], rk[8], lw[8], lb[8], ab0[8], ab1[8];
    { const float* p0 = a.in[I_KA] + l * 512 + c0; const float* p1 = a.in[I_RK] + l * 512 + c0; const float* p2 = a.in[I_LNW] + l * 512 + c0; const float* p3 = a.in[I_LNB] + l * 512 + c0;
      const float* p4 = a.in[I_A0] + l * 1024 + c0;
#pragma unroll
      for (int i = 0; i < 8; ++i) { ka[i] = p0[i]; rk[i] = p1[i]; lw[i] = p2[i]; lb[i] = p3[i]; ab0[i] = p4[i]; ab1[i] = p4[512 + i]; } }
    const int nrows = (l == 1) ? NTL : NT;
    for (int row = gw; row < nrows; row += NGW) {
        float y0[8], y1[8], r[8], k[8], v[8], a0[8], a1[8], g[8];
        unpack8(*(const u32x4*)(Y + (size_t)row * 512 + c0), y0); unpack8(*(const u32x4*)(Y + ((size_t)NT + row) * 512 + c0), y1);
        unpack8(*(const u32x4*)(Rb + (size_t)row * 512 + c0), r); unpack8(*(const u32x4*)(Kb + (size_t)row * 512 + c0), k); unpack8(*(const u32x4*)(Vb + (size_t)row * 512 + c0), v);
        unpack8(*(const u32x4*)(LW + (size_t)row * LWC + 1024 + c0), a0); unpack8(*(const u32x4*)(LW + (size_t)row * LWC + 1536 + c0), a1); unpack8(*(const u32x4*)(LW + (size_t)row * LWC + 2048 + c0), g);
        float s = 0.f, bs = 0.f;
#pragma unroll
        for (int i = 0; i < 8; ++i) { a0[i] = sigmoidf_(a0[i] + ab0[i]); a1[i] = sigmoidf_(a1[i] + ab1[i]); }
#pragma unroll
        for (int i = 0; i < 8; ++i) { y0[i] += y1[i]; s += y0[i];
            const float kd0 = k[i] * (1.0f + (a0[i] - 1.0f) * ka[i]), kd1 = k[i] * (1.0f + (a1[i] - 1.0f) * ka[i]); bs += r[i] * (kd0 + kd1) * rk[i]; }
        s = sum8_(s);
        bs = sum8_(bs);
        const float mu = s * (1.0f / 64.0f); float q = 0.f;
#pragma unroll
        for (int i = 0; i < 8; ++i) { const float d = y0[i] - mu; q += d * d; }
        q = sum8_(q);
        const float rstd = rsqrtf(q * (1.0f / 64.0f) + 64e-5f);
        float o[8];
#pragma unroll
        for (int i = 0; i < 8; ++i) o[i] = ((y0[i] - mu) * rstd * lw[i] + lb[i] + bs * v[i]) * g[i];
        *(u32x4*)(H + (size_t)row * DM + 512 + c0) = pack8(o);
    }
}

template <int VAR> __device__ __forceinline__ void ph_norm2_router(const Args& a, int l, LAS unsigned char* lds, int tid, int lane, int wave) {
    const int gw = blockIdx.x * 8 + wave, NGW = gridDim.x * 8;
    unsigned char* ws = a.ws;
    const float* XC = (const float*)(ws + WS_XC);
    const int nrows = (l == 1) ? NTL : NT;
    f32x4 nv0[4], nv1[4];
#define RT_LOAD(pr_) do { const int row_ = 2 * (pr_); const float* src_ = row_ < NTL ? a.out + (size_t)row_ * DM : XC + (size_t)(row_ - NTL) * DM; \
        _Pragma("unroll") for (int j = 0; j < 4; ++j) { nv0[j] = *(const f32x4*)(src_ + 4 * (lane + 64 * j)); nv1[j] = *(const f32x4*)(src_ + DM + 4 * (lane + 64 * j)); } } while (0)
    if (2 * gw < nrows) RT_LOAD(gw);
    LAS float* rwl = (LAS float*)lds;
    for (int i = tid; i < 16384; i += 512) rwl[(i & 15) * 1024 + (i >> 4)] = a.in[I_RW][i];
    LAS int* wcnt = (LAS int*)(lds + 65536);
    LAS int* woff = wcnt + 128;
    if (tid < 128) wcnt[tid] = 0;
    __syncthreads();
    const float* modv = (const float*)(ws + WS_MODV) + (size_t)l * 9 * 6144; bf16* H = (bf16*)(ws + WS_H);
    unsigned* cnt = (unsigned*)(ws + WS_CTL) + CW_CNT + 64 * l; int* route = (int*)(ws + WS_ROUTE);
    const int lq = lane >> 4, eb = 8 * (lq & 1), rsel = lq >> 1;
    float rb[8];
#pragma unroll
    for (int e = 0; e < 8; ++e) rb[e] = a.in[I_RB][eb + e];
    for (int pr = gw; 2 * pr < nrows; pr += NGW) {
        const int row = 2 * pr;
        const int mr = row < NTL ? (row >> 12) : 8;
        f32x4 v0[4], v1[4], h0[4], h1[4];
#pragma unroll
        for (int j = 0; j < 4; ++j) { v0[j] = nv0[j]; v1[j] = nv1[j]; }
        if (2 * (pr + NGW) < nrows) RT_LOAD(pr + NGW);
        {
            float ss0 = 0.f, ss1 = 0.f;
#pragma unroll
            for (int j = 0; j < 4; ++j) { ss0 += (v0[j].x * v0[j].x + v0[j].y * v0[j].y) + (v0[j].z * v0[j].z + v0[j].w * v0[j].w); ss1 += (v1[j].x * v1[j].x + v1[j].y * v1[j].y) + (v1[j].z * v1[j].z + v1[j].w * v1[j].w); }
            float ra, rbb; swap32(ss0, ss1, ra, rbb); float sq = ra + rbb;
            { float t0, t1; swap16(sq, sq, t0, t1); sq = t0 + t1; }
            sq = dpp_add_(sq, 0); sq = dpp_add_(sq, 1); sq = dpp_add_(sq, 2); sq = dpp_add_(sq, 3);
            const float tot0 = __builtin_bit_cast(float, __builtin_amdgcn_readlane(__builtin_bit_cast(int, sq), 0)), tot1 = __builtin_bit_cast(float, __builtin_amdgcn_readlane(__builtin_bit_cast(int, sq), 32));
            const float rms0 = rsqrtf(tot0 * (1.0f / DM) + 1e-6f), rms1 = rsqrtf(tot1 * (1.0f / DM) + 1e-6f);
            const float* g = a.in[I_NFFN] + l * DM; const float* sc = modv + (size_t)mr * 6144 + 4096; const float* sh = modv + (size_t)mr * 6144 + 3072;
            bf16* o0 = H + (size_t)row * DM;
#pragma unroll
            for (int j = 0; j < 4; ++j) { const int c = 4 * (lane + 64 * j);
                const f32x4 gg = *(const f32x4*)(g + c), s1 = *(const f32x4*)(sc + c), s0 = *(const f32x4*)(sh + c);
                const f32x4 x0 = (v0[j] * rms0 * gg) * (s1 + 1.0f) + s0, x1 = (v1[j] * rms1 * gg) * (s1 + 1.0f) + s0; h0[j] = x0; h1[j] = x1;
                u32x2 w0, w1; w0.x = pk2(x0.x, x0.y); w0.y = pk2(x0.z, x0.w); w1.x = pk2(x1.x, x1.y); w1.y = pk2(x1.z, x1.w);
                if (VAR == 0 || x0.x == 12345.678f) { *(u32x2*)(o0 + c) = w0; *(u32x2*)(o0 + DM + c) = w1; } }
        }
        float lg0[16], lg1[16];
#pragma unroll
        for (int e = 0; e < 16; ++e) { lg0[e] = 0.f; lg1[e] = 0.f; }
#pragma unroll
        for (int e = 0; e < 16; ++e) {
#pragma unroll
            for (int j = 0; j < 4; ++j) { const f32x4 w = *(const LAS f32x4*)(rwl + e * 1024 + 4 * (lane + 64 * j));
                lg0[e] += (h0[j].x * w.x + h0[j].y * w.y) + (h0[j].z * w.z + h0[j].w * w.w); lg1[e] += (h1[j].x * w.x + h1[j].y * w.y) + (h1[j].z * w.z + h1[j].w * w.w); }
            if ((e & 3) == 3) __builtin_amdgcn_sched_barrier(0); }
        float x[16], z[8];
#pragma unroll
        for (int e = 0; e < 16; ++e) { float ra, rbb; swap32(lg0[e], lg1[e], ra, rbb); x[e] = ra + rbb; }
#pragma unroll
        for (int k = 0; k < 8; ++k) { float ra, rbb; swap16(x[k], x[k + 8], ra, rbb); z[k] = ra + rbb; }
#pragma unroll
        for (int k = 0; k < 8; ++k) { z[k] = dpp_add_(z[k], 0); z[k] = dpp_add_(z[k], 1); z[k] = dpp_add_(z[k], 2); z[k] = dpp_add_(z[k], 3); }
        float sc[8], bs[8];
#pragma unroll
        for (int e = 0; e < 8; ++e) { sc[e] = sigmoidf_(z[e]); bs[e] = sc[e] + rb[e]; }
        float gsv[2];
#pragma unroll
        for (int g = 0; g < 2; ++g) { const float x0 = bs[4 * g], x1 = bs[4 * g + 1], x2 = bs[4 * g + 2], x3 = bs[4 * g + 3];
            const float h1 = fmaxf(x0, x1), l1 = fminf(x0, x1), h2 = fmaxf(x2, x3), l2 = fminf(x2, x3);
            gsv[g] = fmaxf(h1, h2) + fmaxf(fminf(h1, h2), fmaxf(l1, l2)); }
        const int lb = gsv[1] > gsv[0] ? 1 : 0; const float lbv = lb ? gsv[1] : gsv[0];
        float ev, od; swap16(lbv, lbv, ev, od);
        const bool mine = (lq & 1) ? (od > ev) : !(od > ev);
        const float g0 = lb ? bs[4] : bs[0], g1 = lb ? bs[5] : bs[1], g2 = lb ? bs[6] : bs[2], g3 = lb ? bs[7] : bs[3];
        const float s0 = lb ? sc[4] : sc[0], s1 = lb ? sc[5] : sc[1], s2 = lb ? sc[6] : sc[2], s3 = lb ? sc[7] : sc[3];
        int i0 = 0; float m0 = g0, t0 = s0;
        if (g1 > m0) { m0 = g1; i0 = 1; t0 = s1; } if (g2 > m0) { m0 = g2; i0 = 2; t0 = s2; } if (g3 > m0) { m0 = g3; i0 = 3; t0 = s3; }
        int i1 = -1; float m1 = 0.f, t1 = 0.f;
        if (i0 != 0) { m1 = g0; i1 = 0; t1 = s0; }
        if (i0 != 1 && (i1 < 0 || g1 > m1)) { m1 = g1; i1 = 1; t1 = s1; }
        if (i0 != 2 && (i1 < 0 || g2 > m1)) { m1 = g2; i1 = 2; t1 = s2; }
        if (i0 != 3 && (i1 < 0 || g3 > m1)) { m1 = g3; i1 = 3; t1 = s3; }
        const bool writer = mine && (lane & 15) == 0 && (VAR == 0 || t0 == 12345.678f);
        const int e0 = eb + lb * 4 + i0, e1 = eb + lb * 4 + i1; const float inv = 1.0f / (t0 + t1);
#pragma unroll
        for (int r = 0; r < 2; ++r)
            if (writer && rsel == r) {
                const int sl0 = wcnt[wave * 16 + e0]; wcnt[wave * 16 + e0] = sl0 + 1;
                const int sl1 = wcnt[wave * 16 + e1]; wcnt[wave * 16 + e1] = sl1 + 1;
                int* rp = route + (size_t)(row + r) * 8;
                rp[0] = e0; rp[1] = e1; rp[2] = sl0; rp[3] = sl1; rp[6] = __float_as_int(t0 * inv); rp[7] = __float_as_int(t1 * inv);
            }
    }
    __syncthreads();
    if (VAR == 0 && tid < 16) {
        int tot = 0;
#pragma unroll
        for (int w = 0; w < 8; ++w) tot += wcnt[w * 16 + tid];
        int run = (int)atomicAdd(cnt + tid, (unsigned)tot);
#pragma unroll
        for (int w = 0; w < 8; ++w) { woff[w * 16 + tid] = run; run += wcnt[w * 16 + tid]; }
    }
    asm volatile("s_waitcnt vmcnt(0)" ::: "memory");
    __syncthreads();
    { const int row = 2 * (gw + (lane >> 1) * NGW) + (lane & 1);
      if (VAR == 0 && row < nrows) { int* rp = route + (size_t)row * 8; const int e0 = rp[0], e1 = rp[1]; rp[2] += woff[wave * 16 + e0]; rp[3] += woff[wave * 16 + e1]; } }
    __syncthreads();
#undef RT_LOAD
}

__device__ __forceinline__ void ph_plan_gather(const Args& a, int l, LAS unsigned char* lds, int tid, int lane, int wave) {
    const int gw = blockIdx.x * 8 + wave, NGW = gridDim.x * 8;
    unsigned char* ws = a.ws;
    const unsigned* cnt = (const unsigned*)(ws + WS_CTL) + CW_CNT + 64 * l; int* plan = (int*)(ws + WS_CTL) + CW_PLAN + 512 * l;
    LAS int* ps = (LAS int*)lds;
    if (tid == 0) {
        int acc = 0;
        for (int e = 0; e < 16; ++e) { const int c = (int)cnt[e], pd = (c + 255) & ~255; ps[e] = acc;
            if (blockIdx.x == 0) { for (int t = acc >> 8; t < (acc + pd) >> 8; ++t) plan[16 + t] = e; plan[320 + e] = acc; }
            acc += pd; }
        if (blockIdx.x == 0) plan[0] = acc >> 8;
    }
    __syncthreads();
    int* route = (int*)(ws + WS_ROUTE); const bf16* H = (const bf16*)(ws + WS_H); bf16* Xs = (bf16*)(ws + WS_XS);
    const int ntok = (l == 1) ? NTL : NT;
    for (int it = gw; it < 2 * ntok; it += NGW) {
        const int tok = it >> 1, k = it & 1; int* rp = route + (size_t)tok * 8;
        const int e = rp[k], sl = rp[2 + k], dest = ps[e] + sl;
        if (lane == 0) rp[4 + k] = dest;
        const u32x4* s = (const u32x4*)(H + (size_t)tok * DM); u32x4* d = (u32x4*)(Xs + (size_t)dest * DM);
        __builtin_nontemporal_store(s[lane], d + lane); __builtin_nontemporal_store(s[lane + 64], d + lane + 64);
    }
    __syncthreads();
}

template <int VAR> __device__ __forceinline__ void ph_combine(const Args& a, int l, int lane, int wave) {
    const int gw = blockIdx.x * 8 + wave, NGW = gridDim.x * 8;
    unsigned char* ws = a.ws;
    const float* modv = (const float*)(ws + WS_MODV); const int* route = (const int*)(ws + WS_ROUTE); const bf16* Y2 = (const bf16*)(ws + WS_XS);
    float* XC = (float*)(ws + WS_XC); bf16* H = (bf16*)(ws + WS_H);
    const int nrows = (l == 1) ? NTL : NT;
    for (int row = gw; row < nrows; row += NGW) {
        float* xr = row < NTL ? a.out + (size_t)row * DM : XC + (size_t)(row - NTL) * DM;
        const int mr = row < NTL ? (row >> 12) : 8;
        const int* rp = route + (size_t)row * 8; const int d0 = rp[4], d1 = rp[5]; const float g0 = __int_as_float(rp[6]), g1 = __int_as_float(rp[7]);
        const float* gf = modv + ((size_t)l * 9 + mr) * 6144 + 5120;
        f32x4 v[4];
#pragma unroll
        for (int j = 0; j < 4; ++j) { const int c = 4 * (lane + 64 * j);
            const f32x4 x = *(const f32x4*)(xr + c), gg = *(const f32x4*)(gf + c);
            const u32x2 w0 = __builtin_nontemporal_load((const u32x2*)(Y2 + (size_t)d0 * DM + c)), w1 = __builtin_nontemporal_load((const u32x2*)(Y2 + (size_t)d1 * DM + c));
            const f32x4 ya = (f32x4){bflo(w0.x), bfhi(w0.x), bflo(w0.y), bfhi(w0.y)}, yb = (f32x4){bflo(w1.x), bfhi(w1.x), bflo(w1.y), bfhi(w1.y)};
            v[j] = x + gg * (ya * g0 + yb * g1); }
        if (l == 0) {
#pragma unroll
            for (int j = 0; j < 4; ++j) if (VAR == 0 || v[j].x == 12345.678f) __builtin_nontemporal_store(v[j], (f32x4*)(xr + 4 * (lane + 64 * j)));
            f32x4 h[4];
            norm_mod_store(v, a.in[I_NMIX] + DM, modv + ((size_t)9 + mr) * 6144 + 1024, modv + ((size_t)9 + mr) * 6144, H + (size_t)row * DM, lane, h, VAR == 0);
        } else {
            float ss = 0.f;
#pragma unroll
            for (int j = 0; j < 4; ++j) ss += (v[j].x * v[j].x + v[j].y * v[j].y) + (v[j].z * v[j].z + v[j].w * v[j].w);
            const float rms = rsqrtf(wave_sum(ss) * (1.0f / DM) + 1e-6f);
#pragma unroll
            for (int j = 0; j < 4; ++j) { const int c = 4 * (lane + 64 * j); const f32x4 ov = v[j] * rms * *(const f32x4*)(a.in[I_FNG] + c); if (VAR == 0 || ov.x == 12345.678f) __builtin_nontemporal_store(ov, (f32x4*)(xr + c)); }
        }
    }
}

#define IN(k) (lo <= (k) && (k) < hi)
#define SEAM(k) do { if ((k) + 1 < hi) xcd_barrier(bar); } while (0)
template <int MASK, int l> __device__ __forceinline__ void layer_phases(const Args& args, LAS unsigned char* lds, const XcdBarrier& bar, int lo, int hi, int tid, int lane, int wave) {
    constexpr int pb = 2 + 13 * l;
    const int G = gridDim.x, cid = blockIdx.x;
    unsigned char* ws = args.ws;

        if (HAS(2) && IN(pb + 0)) {
            pg8::Gemm g{(const bf16*)(ws + WS_H), (const bf16*)(ws + WS_WIN) + (size_t)l * INCP * DM, DM, DM, DM};
            pg8::DenseOrder S; S.init(NT / 256, INCP / 256, G, cid, DM, DM, 0);
            pg8::EpiStore E{(bf16*)(ws + WS_P), INCP};
            for (int rep_ = 0; rep_ < REPS(2); ++rep_) pg8::gemm_phase<pg8::EpiStore, pg8::DenseOrder, true, true>(lds, g, S, E);
            SEAM(pb + 0);
        }
        if (HAS(3) && IN(pb + 1)) { ph_postproj(args, l, lds, tid, lane, wave); if (REPS(3) > 1) ph_postproj(args, l, lds, tid, lane, wave); if (REPS(3) > 2) ph_postproj(args, l, lds, tid, lane, wave); SEAM(pb + 1); }
        if (HAS(4) && IN(pb + 2)) {
            pg8::Gemm g{(const bf16*)(ws + WS_AP), (const bf16*)(ws + WS_WL) + (size_t)l * LWC * 128, APC, 128, 128};
            pg8::DenseOrder S; S.init(NT / 256, LWC / 256, G, cid, APC, 128, 1);
            pg8::EpiStore E{(bf16*)(ws + WS_P), LWC};
            for (int rep_ = 0; rep_ < REPS(4); ++rep_) pg8::gemm_phase<pg8::EpiStore, pg8::DenseOrder, true, true>(lds, g, S, E);
            SEAM(pb + 2);
        }
        if (HAS(5) && IN(pb + 3)) {
#if REPK == 15 || REPK == 16
            if (HAS(15)) for (int rep_ = 0; rep_ < REPS(15); ++rep_) ph_attention(args, l, lane, wave);
            if (HAS(16)) for (int rep_ = 0; rep_ < REPS(16); ++rep_) ph_scan1b(args, l, lds, lane, wave);
#else
            if (wave < 4) { __builtin_amdgcn_s_setprio(1); ph_scan1b(args, l, lds, lane, wave); __builtin_amdgcn_s_setprio(0); __builtin_amdgcn_sched_barrier(0); ph_attention(args, l, lane, wave); }
            else { ph_attention(args, l, lane, wave); __builtin_amdgcn_sched_barrier(0); __builtin_amdgcn_s_setprio(1); ph_scan1b(args, l, lds, lane, wave); __builtin_amdgcn_s_setprio(0); }
#endif
            SEAM(pb + 3); }
        if (HAS(6) && IN(pb + 4)) { ph_scan2<0>(args, lds, tid, lane, wave); for (int rep_ = 1; rep_ < REPS(6); ++rep_) ph_scan2<1>(args, lds, tid, lane, wave); SEAM(pb + 4); }
        if (HAS(7) && IN(pb + 5)) { ph_scan3b(args, l, lds, lane, wave); for (int rep_ = 1; rep_ < REPS(7); ++rep_) ph_scan3b(args, l, lds, lane, wave); SEAM(pb + 5); }
        if (HAS(8) && IN(pb + 6)) { for (int rep_ = 0; rep_ < REPS(8); ++rep_) ph_readout(args, l, lane, wave); SEAM(pb + 6); }
        if (HAS(9) && IN(pb + 7)) {
            pg8::Gemm g{(const bf16*)(ws + WS_H), (const bf16*)(ws + WS_WOUT) + (size_t)l * DM * DM, DM, DM, DM};
            pg8::DenseOrder S; S.init((l == 1 ? NTL : NT) / 256, DM / 256, G, cid, DM, DM, 0);
            pg8::EpiResid E{l == 0 ? args.in[I_X] : args.out, l == 0 ? args.in[I_CTX] : (const float*)(ws + WS_XC), args.out, (float*)(ws + WS_XC), (const float*)(ws + WS_MODV) + (size_t)l * 9 * 6144, 0};
            pg8::gemm_phase<pg8::EpiResid, pg8::DenseOrder, true, true>(lds, g, S, E);
            { const int n3 = (NT / 256) * (DM / 256) - 2 * G;
              if (l == 0 && n3 > 0 && n3 < G && cid >= n3) convert_experts(args, 0, lds, lane, wave, 0, CV_EARLY, (cid - n3) * 8 + wave, (G - n3) * 8);
              else if (l == 0 && !(n3 > 0 && n3 < G)) { if (cid == 0 || true) convert_experts(args, 0, lds, lane, wave, 0, CV_EARLY, cid * 8 + wave, G * 8); } }
            if (REPS(9) > 1) { pg8::EpiResid E2 = E; E2.dummy = 1; pg8::gemm_phase<pg8::EpiResid, pg8::DenseOrder, true, true>(lds, g, S, E2); if (REPS(9) > 2) pg8::gemm_phase<pg8::EpiResid, pg8::DenseOrder, true, true>(lds, g, S, E2); }
            SEAM(pb + 7);
        }
        if (HAS(10) && IN(pb + 8)) { ph_norm2_router<0>(args, l, lds, tid, lane, wave); for (int rep_ = 1; rep_ < REPS(17); ++rep_) ph_norm2_router<1>(args, l, lds, tid, lane, wave); for (int rep_ = 0; rep_ < REPS(10); ++rep_) convert_experts(args, l, lds, lane, wave, l == 0 ? CV_EARLY : 0, CV_ITEMS, blockIdx.x * 8 + wave, gridDim.x * 8); SEAM(pb + 8); }
        if (HAS(11) && IN(pb + 9)) { for (int rep_ = 0; rep_ < REPS(11); ++rep_) ph_plan_gather(args, l, lds, tid, lane, wave); SEAM(pb + 9); }
        if (HAS(12) && IN(pb + 10)) {
            pg8::Gemm g{(const bf16*)(ws + WS_XS), (const bf16*)(ws + WS_WE), DM, DM, DM};
            pg8::MoeOrder S; S.init((const int*)(ws + WS_CTL) + CW_PLAN + 512 * l, 8, G, cid, DM, DM, 2048);
            pg8::EpiGateUp E{(bf16*)(ws + WS_HM)};
            for (int rep_ = 0; rep_ < REPS(12); ++rep_) pg8::gemm_phase<pg8::EpiGateUp, pg8::MoeOrder, true, true>(lds, g, S, E);
            SEAM(pb + 10);
        }
        if (HAS(13) && IN(pb + 11)) {
            pg8::Gemm g{(const bf16*)(ws + WS_HM), (const bf16*)(ws + WS_WE) + (size_t)16 * 2048 * 1024, DM, DM, DM};
            pg8::MoeOrder S; S.init((const int*)(ws + WS_CTL) + CW_PLAN + 512 * l, 4, G, cid, DM, DM, 1024);
            pg8::EpiStore E{(bf16*)(ws + WS_XS), DM};
            for (int rep_ = 0; rep_ < REPS(13); ++rep_) pg8::gemm_phase<pg8::EpiStore, pg8::MoeOrder, true, true>(lds, g, S, E);
            SEAM(pb + 11);
        }
        if (HAS(14) && IN(pb + 12)) { if (REPS(14) > 1) ph_combine<1>(args, l, lane, wave); if (REPS(14) > 2) ph_combine<1>(args, l, lane, wave); ph_combine<0>(args, l, lane, wave); SEAM(pb + 12); }
    }
#undef IN
#undef SEAM

template <int MASK> __global__ void __launch_bounds__(512, 2) __attribute__((target("no-packed-fp32-ops"))) mega_fwd(Args args) {
    extern __shared__ __attribute__((aligned(16))) unsigned char lds_raw[];
    LAS unsigned char* lds = (LAS unsigned char*)lds_raw;
    const int tid = threadIdx.x, lane = tid & 63, wave = __builtin_amdgcn_readfirstlane(tid >> 6);
    const int lo = args.ph_lo, hi = args.ph_hi;
    volatile LAS unsigned* MISC = (volatile LAS unsigned*)(lds + MISC_OFF);
    if (tid < 64) MISC[tid] = 0u;
    __syncthreads();
    unsigned* ctl = (unsigned*)(args.ws + WS_CTL);
    XcdBarrier bar; bar.bar = ctl + CW_BAR; bar.x = 0; bar.st = MISC + 8;
    if (hi - lo > 1) bar = xcd_barrier_post(ctl + CW_BAR, MISC + 8);
#define IN(k) (lo <= (k) && (k) < hi)
#define SEAM(k) do { if ((k) + 1 < hi) xcd_barrier(bar); } while (0)
    const int G = gridDim.x, cid = blockIdx.x;
    unsigned char* ws = args.ws;

    if (HAS(0) && IN(0)) { for (int rep_ = 0; rep_ < REPS(0); ++rep_) { ph_prologue(args, lds, tid, lane, wave); __syncthreads(); } SEAM(0); }
    if (HAS(1) && IN(1)) { for (int rep_ = 0; rep_ < REPS(1); ++rep_) ph_norm1_l0(args, lane, wave); SEAM(1); }
    layer_phases<MASK, 0>(args, lds, bar, lo, hi, tid, lane, wave);
    layer_phases<MASK, 1>(args, lds, bar, lo, hi, tid, lane, wave);
#undef IN
#undef SEAM
}

template <int MASK> static void launch_one(const Args& a, int grid, hipStream_t stream) { hipLaunchKernelGGL(mega_fwd<MASK>, dim3(grid), dim3(512), LDS_BYTES, stream, a); }
template <int MASK> static bool setup_one(int* per_cu) {
    if (hipFuncSetAttribute((const void*)mega_fwd<MASK>, hipFuncAttributeMaxDynamicSharedMemorySize, LDS_BYTES) != hipSuccess) return false;
    int pc = 0; if (hipOccupancyMaxActiveBlocksPerMultiprocessor(&pc, (const void*)mega_fwd<MASK>, 512, LDS_BYTES) != hipSuccess) pc = 0;
    (void)hipGetLastError(); if (pc < *per_cu) *per_cu = pc; return true;
}
static int kind_of_phase(int p) { return p < 2 ? p : 2 + (p - 2) % 13; }

extern "C" void kernel_launch(void* const* d_in, const int* in_sizes, int n_in, void* d_out, int out_size, void* d_ws, size_t ws_size, hipStream_t stream) {
    static int grid = 0;
    if (grid == 0) {
        if (n_in != 32 || out_size != NTL * DM || ws_size < WS_END) { fprintf(stderr, "kernel_launch: unexpected sizes (n_in %d, out %d, ws %zu, need %zu)\n", n_in, out_size, ws_size, (size_t)WS_END); grid = -1; return; }
        int dev = 0, cus = 0, per_cu = 99;
        if (hipGetDevice(&dev) != hipSuccess || hipDeviceGetAttribute(&cus, hipDeviceAttributeMultiprocessorCount, dev) != hipSuccess) { grid = -1; return; }
        bool ok = true;
#if MK_MULTI
        ok = ok && setup_one<1 << 0>(&per_cu) && setup_one<1 << 1>(&per_cu) && setup_one<1 << 2>(&per_cu) && setup_one<1 << 3>(&per_cu) && setup_one<1 << 4>(&per_cu)
                && setup_one<(1 << 5) | (1 << 15)>(&per_cu) && setup_one<(1 << 5) | (1 << 16)>(&per_cu) && setup_one<1 << 6>(&per_cu) && setup_one<1 << 7>(&per_cu) && setup_one<1 << 8>(&per_cu) && setup_one<1 << 9>(&per_cu)
                && setup_one<1 << 10>(&per_cu) && setup_one<1 << 11>(&per_cu) && setup_one<1 << 12>(&per_cu) && setup_one<1 << 13>(&per_cu) && setup_one<1 << 14>(&per_cu);
#else
        ok = ok && setup_one<0x1ffff>(&per_cu);
#endif
        if (!ok) { fprintf(stderr, "kernel_launch: hipFuncSetAttribute failed\n"); grid = -1; return; }
        if (per_cu < 1) fprintf(stderr, "kernel_launch: occupancy query reports %d\n", per_cu);
        grid = cus;
    }
    if (grid < 0) return;
    (void)hipMemsetAsync((char*)d_ws + WS_CTL, 0, 65536, stream);
    Args a{};
    for (int i = 0; i < 32; ++i) a.in[i] = (const float*)d_in[i];
    a.out = (float*)d_out; a.ws = (unsigned char*)d_ws;
#if MK_MULTI
    for (int p = 0; p < NPHASE; ++p) {
        a.ph_lo = p; a.ph_hi = p + 1;
        switch (kind_of_phase(p)) {
            case 0: launch_one<1 << 0>(a, grid, stream); break;   case 1: launch_one<1 << 1>(a, grid, stream); break;
            case 2: launch_one<1 << 2>(a, grid, stream); break;   case 3: launch_one<1 << 3>(a, grid, stream); break;
            case 4: launch_one<1 << 4>(a, grid, stream); break;   case 5: launch_one<(1 << 5) | (1 << 15)>(a, grid, stream); launch_one<(1 << 5) | (1 << 16)>(a, grid, stream); break;
            case 6: launch_one<1 << 6>(a, grid, stream); break;   case 7: launch_one<1 << 7>(a, grid, stream); break;
            case 8: launch_one<1 << 8>(a, grid, stream); break;   case 9: launch_one<1 << 9>(a, grid, stream); break;
            case 10: launch_one<1 << 10>(a, grid, stream); break; case 11: launch_one<1 << 11>(a, grid, stream); break;
            case 12: launch_one<1 << 12>(a, grid, stream); break; case 13: launch_one<1 << 13>(a, grid, stream); break;
            default: launch_one<1 << 14>(a, grid, stream); break;
        }
    }
#else
    a.ph_lo = 0; a.ph_hi = NPHASE;
    launch_one<0x1ffff>(a, grid, stream);
#endif
}
```
